# Optimizing an MI355X kernel written in HIP

```python
import jax, jax.numpy as jnp
from jax import lax
import numpy as np

D_MODEL = 2048
BATCH = 2
SEQ = 4096
DEPTH = 4

GRID_W = 64
CTX_LEN = 256
N_MIXERS = 3
POOL_GROUPS = 4
POOL_WINDOWS = (2, 4, 8, 16)
POOL_GC = D_MODEL // POOL_GROUPS
HEAD_DIM = 128
GQA_HEADS = D_MODEL // HEAD_DIM
GQA_KV_HEADS = 4
GQA_GROUP = GQA_HEADS // GQA_KV_HEADS
Q_BLOCK = 128
ROPE_THETA = 10000.0
ROPE_AXIS_DIM = HEAD_DIM // 2
NAT_HEADS = D_MODEL // HEAD_DIM
NAT_KH = 8
NAT_KW = 16
FFN_HIDDEN = -(-8 * D_MODEL // (3 * 256)) * 256
NORM_EPS = 1e-6

kernel_name = "hybrid_pool_gqa_natten_dit_block"


def _rmsnorm(x, g):
    xf = x.astype(jnp.float32)
    y = xf * lax.rsqrt(jnp.mean(xf * xf, axis=-1, keepdims=True) + NORM_EPS)
    return y.astype(x.dtype) * g


def _modulate(h, shift, scale):
    return h * (1 + scale) + shift


def _ada(cvec, w, b):
    return jnp.split(jax.nn.silu(cvec) @ w + b, 6, axis=-1)


def _swiglu(h, w1, w3, w2):
    return (jax.nn.silu(h @ w1) * (h @ w3)) @ w2


def _centred_window_mean(x, w):
    b, n, ch = x.shape
    cs = lax.cumsum(x.astype(jnp.float32), axis=1)
    cs = jnp.concatenate([jnp.zeros((b, 1, ch), jnp.float32), cs], axis=1)
    t = jnp.arange(n)
    lo = jnp.clip(t - w // 2, 0, n)
    hi = jnp.clip(t + w - w // 2, 0, n)
    cnt = (hi - lo).astype(jnp.float32)
    return ((cs[:, hi] - cs[:, lo]) / cnt[None, :, None]).astype(x.dtype)


def _pool_mixer(h, w, ls):
    b, n, _ = h.shape
    g = h.reshape(b, n, POOL_GROUPS, POOL_GC)
    pooled = jnp.stack([_centred_window_mean(g[:, :, k], POOL_WINDOWS[k]) for k in range(POOL_GROUPS)], axis=2) - g
    return jnp.einsum('bngc,gcd->bngd', pooled, w).reshape(b, n, D_MODEL) * ls


def _axial_rope(n):
    t = jnp.arange(n)
    row = (t // GRID_W).astype(jnp.float32)
    col = (t % GRID_W).astype(jnp.float32)
    inv = ROPE_THETA ** (-jnp.arange(0, ROPE_AXIS_DIM, 2, dtype=jnp.float32) / ROPE_AXIS_DIM)
    ang = jnp.concatenate([row[:, None] * inv, col[:, None] * inv], axis=-1)
    return jnp.cos(ang), jnp.sin(ang)


def _apply_rope(x, cos, sin):
    xf = x.astype(jnp.float32).reshape(x.shape[:-1] + (HEAD_DIM // 2, 2))
    x1, x2 = xf[..., 0], xf[..., 1]
    c = cos[None, :, None]
    s = sin[None, :, None]
    y = jnp.stack([x1 * c - x2 * s, x1 * s + x2 * c], axis=-1)
    return y.reshape(x.shape).astype(x.dtype)


def _gqa_attend(q, k, v):
    s = jnp.einsum('bqkgd,bskd->bkgqs', q, k, preferred_element_type=jnp.float32) * (HEAD_DIM ** -0.5)
    p = jax.nn.softmax(s, axis=-1).astype(v.dtype)
    return jnp.einsum('bkgqs,bskd->bqkgd', p, v)


def _gqa_mixer(h_ctx, h_lat, wq, wk, wv, wo, gq, gk, need_ctx):
    def proj(h):
        b, n, _ = h.shape
        q = _rmsnorm((h @ wq).reshape(b, n, GQA_HEADS, HEAD_DIM), gq)
        k = _rmsnorm((h @ wk).reshape(b, n, GQA_KV_HEADS, HEAD_DIM), gk)
        v = (h @ wv).reshape(b, n, GQA_KV_HEADS, HEAD_DIM)
        return q, k, v

    qc, kc, vc = proj(h_ctx)
    ql, kl, vl = proj(h_lat)
    b, n, _ = h_lat.shape
    cos, sin = _axial_rope(n)
    ql = _apply_rope(ql, cos, sin)
    kl = _apply_rope(kl, cos, sin)
    k_all = jnp.concatenate([kc, kl], axis=1)
    v_all = jnp.concatenate([vc, vl], axis=1)
    nb = n // Q_BLOCK
    qb = ql.reshape(b, nb, Q_BLOCK, GQA_KV_HEADS, GQA_GROUP, HEAD_DIM).transpose(1, 0, 2, 3, 4, 5)
    ob = lax.map(lambda q: _gqa_attend(q, k_all, v_all), qb)
    y_lat = ob.transpose(1, 0, 2, 3, 4, 5).reshape(b, n, D_MODEL) @ wo
    y_ctx = None
    if need_ctx:
        bc, nc, _ = h_ctx.shape
        oc = _gqa_attend(qc.reshape(bc, nc, GQA_KV_HEADS, GQA_GROUP, HEAD_DIM), kc, vc)
        y_ctx = oc.reshape(bc, nc, D_MODEL) @ wo
    return y_ctx, y_lat


def _mha_attend(q, k, v):
    s = jnp.einsum('bqhd,bshd->bhqs', q, k, preferred_element_type=jnp.float32) * (HEAD_DIM ** -0.5)
    p = jax.nn.softmax(s, axis=-1).astype(v.dtype)
    return jnp.einsum('bhqs,bshd->bqhd', p, v)


def _nat_mixer(h_ctx, h_lat, wq, wk, wv, wo, rpb, need_ctx):
    def proj(h):
        b, n, _ = h.shape
        return tuple((h @ w).reshape(b, n, NAT_HEADS, HEAD_DIM) for w in (wq, wk, wv))

    qc, kc, vc = proj(h_ctx)
    ql, kl, vl = proj(h_lat)
    b, n, _ = h_lat.shape
    rows = n // GRID_W
    kh = min(NAT_KH, rows)
    kw = NAT_KW
    nk = kh * kw
    qg = ql.reshape(b, rows, GRID_W, NAT_HEADS, HEAD_DIM)
    kg = kl.reshape(b, rows, GRID_W, NAT_HEADS, HEAD_DIM)
    vg = vl.reshape(b, rows, GRID_W, NAT_HEADS, HEAD_DIM)
    cq = jnp.arange(GRID_W)
    cstart = jnp.clip(cq - kw // 2, 0, GRID_W - kw)
    col_idx = cstart[:, None] + jnp.arange(kw)[None, :]
    dc = col_idx - cq[:, None] + (NAT_KW - 1)
    scale = HEAD_DIM ** -0.5

    def row_fn(args):
        r, q_row = args
        rstart = jnp.clip(r - kh // 2, 0, rows - kh)
        kb = lax.dynamic_slice_in_dim(kg, rstart, kh, axis=1)
        vb = lax.dynamic_slice_in_dim(vg, rstart, kh, axis=1)
        kn = jnp.take(kb, col_idx, axis=2).transpose(0, 2, 1, 3, 4, 5).reshape(b, GRID_W, nk, NAT_HEADS, HEAD_DIM)
        vn = jnp.take(vb, col_idx, axis=2).transpose(0, 2, 1, 3, 4, 5).reshape(b, GRID_W, nk, NAT_HEADS, HEAD_DIM)
        dr = rstart + jnp.arange(kh) - r + (NAT_KH - 1)
        bias = rpb[:, dr[None, :, None], dc[:, None, :]].reshape(NAT_HEADS, GRID_W, nk).astype(jnp.float32)
        s_loc = jnp.einsum('bqhd,bqkhd->bhqk', q_row, kn, preferred_element_type=jnp.float32) * scale + bias[None]
        s_ctx = jnp.einsum('bqhd,bshd->bhqs', q_row, kc, preferred_element_type=jnp.float32) * scale
        p = jax.nn.softmax(jnp.concatenate([s_loc, s_ctx], axis=-1), axis=-1).astype(vn.dtype)
        return (jnp.einsum('bhqk,bqkhd->bqhd', p[..., :nk], vn)
                + jnp.einsum('bhqs,bshd->bqhd', p[..., nk:], vc))

    o = lax.map(row_fn, (jnp.arange(rows), qg.transpose(1, 0, 2, 3, 4)))
    y_lat = o.transpose(1, 0, 2, 3, 4).reshape(b, n, D_MODEL) @ wo
    y_ctx = None
    if need_ctx:
        bc, nc, _ = h_ctx.shape
        y_ctx = _mha_attend(qc, kc, vc).reshape(bc, nc, D_MODEL) @ wo
    return y_ctx, y_lat


def setup_inputs(seed: int = 0) -> dict:
    key = jax.random.key(seed)
    ks = iter(jax.random.split(key, 32))

    def nrm(shape, s):
        return jax.random.normal(next(ks), shape, jnp.float32) * s

    n_a = (DEPTH + 2) // 3
    n_b = (DEPTH + 1) // 3
    n_c = DEPTH // 3
    D, F = D_MODEL, FFN_HIDDEN
    return {
        "x": nrm((BATCH, SEQ, D), 1.0),
        "c": nrm((BATCH, D), 1.0),
        "ctx": nrm((BATCH, CTX_LEN, D), 1.0),
        "c_ctx": nrm((D,), 1.0),
        "ada_w": nrm((DEPTH, D, 6 * D), 0.5 * D ** -0.5),
        "ada_b": nrm((DEPTH, 6 * D), 0.02),
        "norm_g": 1.0 + nrm((DEPTH, 2, D), 0.02),
        "ffn_w1": nrm((DEPTH, D, F), D ** -0.5),
        "ffn_w3": nrm((DEPTH, D, F), D ** -0.5),
        "ffn_w2": nrm((DEPTH, F, D), F ** -0.5),
        "pool_w": nrm((n_a, POOL_GROUPS, POOL_GC, POOL_GC), POOL_GC ** -0.5),
        "pool_ls": 1.0 + nrm((n_a, D), 0.1),
        "gqa_wq": nrm((n_b, D, GQA_HEADS * HEAD_DIM), D ** -0.5),
        "gqa_wk": nrm((n_b, D, GQA_KV_HEADS * HEAD_DIM), D ** -0.5),
        "gqa_wv": nrm((n_b, D, GQA_KV_HEADS * HEAD_DIM), D ** -0.5),
        "gqa_wo": nrm((n_b, GQA_HEADS * HEAD_DIM, D), (GQA_HEADS * HEAD_DIM) ** -0.5),
        "gqa_qn": 1.0 + nrm((n_b, HEAD_DIM), 0.02),
        "gqa_kn": 1.0 + nrm((n_b, HEAD_DIM), 0.02),
        "nat_wq": nrm((n_c, D, NAT_HEADS * HEAD_DIM), D ** -0.5),
        "nat_wk": nrm((n_c, D, NAT_HEADS * HEAD_DIM), D ** -0.5),
        "nat_wv": nrm((n_c, D, NAT_HEADS * HEAD_DIM), D ** -0.5),
        "nat_wo": nrm((n_c, NAT_HEADS * HEAD_DIM, D), (NAT_HEADS * HEAD_DIM) ** -0.5),
        "nat_rpb": nrm((n_c, NAT_HEADS, 2 * NAT_KH - 1, 2 * NAT_KW - 1), 0.5),
        "final_g": 1.0 + nrm((D,), 0.02),
    }


def reference(x, c, ctx, c_ctx, ada_w, ada_b, norm_g, ffn_w1, ffn_w3, ffn_w2, pool_w, pool_ls,
              gqa_wq, gqa_wk, gqa_wv, gqa_wo, gqa_qn, gqa_kn,
              nat_wq, nat_wk, nat_wv, nat_wo, nat_rpb, final_g):
    xl, xc = x, ctx
    for i in range(DEPTH):
        kind, j = i % N_MIXERS, i // N_MIXERS
        need_ctx = i < DEPTH - 1
        sh1l, sc1l, g1l, sh2l, sc2l, g2l = [m[:, None, :] for m in _ada(c, ada_w[i], ada_b[i])]
        sh1c, sc1c, g1c, sh2c, sc2c, g2c = _ada(c_ctx, ada_w[i], ada_b[i])
        hl = _modulate(_rmsnorm(xl, norm_g[i, 0]), sh1l, sc1l)
        hc = _modulate(_rmsnorm(xc, norm_g[i, 0]), sh1c, sc1c)
        if kind == 0:
            yl = _pool_mixer(hl, pool_w[j], pool_ls[j])
            yc = _pool_mixer(hc, pool_w[j], pool_ls[j]) if need_ctx else None
        elif kind == 1:
            yc, yl = _gqa_mixer(hc, hl, gqa_wq[j], gqa_wk[j], gqa_wv[j], gqa_wo[j], gqa_qn[j], gqa_kn[j], need_ctx)
        else:
            yc, yl = _nat_mixer(hc, hl, nat_wq[j], nat_wk[j], nat_wv[j], nat_wo[j], nat_rpb[j], need_ctx)
        xl = xl + g1l * yl
        hl = _modulate(_rmsnorm(xl, norm_g[i, 1]), sh2l, sc2l)
        xl = xl + g2l * _swiglu(hl, ffn_w1[i], ffn_w3[i], ffn_w2[i])
        if need_ctx:
            xc = xc + g1c * yc
            hc = _modulate(_rmsnorm(xc, norm_g[i, 1]), sh2c, sc2c)
            xc = xc + g2c * _swiglu(hc, ffn_w1[i], ffn_w3[i], ffn_w2[i])
    return _rmsnorm(xl, final_g)
```

```cpp
#include <hip/hip_runtime.h>
#include <cstdio>
#include <cstdint>

#ifndef EN
#define EN 0xffff
#endif
#ifndef MK_ONE_LAUNCH
#define MK_ONE_LAUNCH 1
#endif

constexpr int DM = 2048, NB = 2, SEQ = 4096, CTXL = 256, RB = SEQ + CTXL, MROWS = NB * RB, FF = 5632, HD = 128, NH = 16, KVH = 4, DEPTH = 4;
constexpr int PTILES = RB / 256;
constexpr float NORM_EPS = 1e-6f;
static_assert(RB % 256 == 0 && MROWS == 8704, "row layout");

#define GAS __attribute__((address_space(1)))
#define LAS __attribute__((address_space(3)))
typedef unsigned short bf16_t;
typedef float f32x4 __attribute__((ext_vector_type(4)));
typedef float f32x2 __attribute__((ext_vector_type(2)));
typedef unsigned u32x4 __attribute__((ext_vector_type(4)));
typedef unsigned u32x2 __attribute__((ext_vector_type(2)));
typedef short bf16x8 __attribute__((ext_vector_type(8)));
typedef _Float16 h16x2 __attribute__((ext_vector_type(2)));
typedef GAS _Float16 gh16;
__device__ __forceinline__ unsigned pk_h16(float a, float b) { const h16x2 v = {(_Float16)a, (_Float16)b}; return __builtin_bit_cast(unsigned, v); }
__device__ __forceinline__ float h16_lo(unsigned u) { return (float)__builtin_bit_cast(h16x2, u).x; }
__device__ __forceinline__ float h16_hi(unsigned u) { return (float)__builtin_bit_cast(h16x2, u).y; }
typedef GAS float gf32; typedef GAS bf16_t gb16; typedef GAS f32x4 gf32x4; typedef GAS f32x2 gf32x2; typedef GAS u32x4 gu32x4; typedef GAS u32x2 gu32x2; typedef GAS bf16x8 gbf16x8; typedef GAS unsigned gu32;
#define LDS_WAIT() asm volatile("s_waitcnt lgkmcnt(0)" ::: "memory")
#define VM_WAIT() asm volatile("s_waitcnt vmcnt(0)" ::: "memory")
__device__ __forceinline__ unsigned cvt_pk_bf16(float lo, float hi) { unsigned r; asm volatile("v_cvt_pk_bf16_f32 %0, %1, %2" : "=v"(r) : "v"(lo), "v"(hi)); return r; }
__device__ __forceinline__ float bf_lo(unsigned u) { return __uint_as_float(u << 16); }
__device__ __forceinline__ float bf_hi(unsigned u) { return __uint_as_float(u & 0xffff0000u); }
__device__ __forceinline__ int tid_here(int wave) { int l; asm volatile("v_mbcnt_lo_u32_b32 %0, -1, 0\n\tv_mbcnt_hi_u32_b32 %0, -1, %0" : "=v"(l)); return wave * 64 + l; }
__device__ __forceinline__ float wave_sum(float v) {
#pragma unroll
    for (int o = 1; o < 64; o <<= 1) v += __shfl_xor(v, o);
    return v;
}

namespace pg8 {
#define PG8_LAS __attribute__((address_space(3)))
constexpr int BM = 256, BK = 64, HALF = 128, HTB = HALF * BK * 2, STAGE_BYTES = 8 * HTB, NXCD = 8, WGM = 8;
__host__ __device__ __forceinline__ int lds_byte(int r, int c) { const int st = (r >> 4) * 2 + (c >> 5), rr = r & 15, cc = c & 31, ob = rr * 64 + cc * 2; return st * 1024 + (ob ^ (((ob >> 9) & 1) << 5)); }
__host__ __device__ __forceinline__ void stage_rc(int b, int& R, int& C) { const int st = b / 1024, sb = b % 1024, swz = sb ^ (((sb >> 9) & 1) << 5); R = (st >> 1) * 16 + swz / 64; C = (st & 1) * 32 + (swz % 64) / 2; }
__host__ __device__ __forceinline__ int perm32(int rho) { const int n = rho >> 4, i = rho & 15; return 8 * (i >> 2) + 4 * n + (i & 3); }

struct Unit { int pm, pn, srow, kh; };
struct Gemm { const gb16* A; const gb16* Bt; int M, N, K, lda, a_tpg; };

struct StaticOrder {
    static constexpr bool SPLIT = false;
    int nM, nN, nwg, G, c;
    __host__ __device__ void init(int M, int N, int G_, int c_) { nM = M / BM; nN = N / BM; nwg = nM * nN; G = G_; c = c_; }
    __host__ __device__ bool next(int i, Unit& u) const {
        const long L = (long)i * G + c; if (L >= nwg) return false;
        int wgid = (int)L; { const int q = nwg / NXCD, r = nwg % NXCD, xcd = wgid % NXCD, off = wgid / NXCD; wgid = (xcd < r ? xcd * (q + 1) : r * (q + 1) + (xcd - r) * q) + off; }
        const int nig = WGM * nN, gid = wgid / nig, fm = gid * WGM, gsz = (nM - fm) < WGM ? (nM - fm) : WGM;
        u.pm = fm + ((wgid % nig) % gsz); u.pn = (wgid % nig) / gsz; u.srow = 0; u.kh = -1; return true;
    }
    __device__ __forceinline__ void a_ready(const Unit&) const {}
    __device__ __forceinline__ void done(const Unit&) const {}
};
struct LatOrder {
    static constexpr bool SPLIT = false;
    int nN, nwg, G, c;
    __host__ __device__ void init(int N, int G_, int c_) { nN = N / BM; nwg = 32 * nN; G = G_; c = c_; }
    __host__ __device__ bool next(int i, Unit& u) const {
        const long L = (long)i * G + c; if (L >= nwg) return false;
        int wgid = (int)L; { const int q = nwg / NXCD, r = nwg % NXCD, xcd = wgid % NXCD, off = wgid / NXCD; wgid = (xcd < r ? xcd * (q + 1) : r * (q + 1) + (xcd - r) * q) + off; }
        const int nig = WGM * nN, gid = wgid / nig, fm = gid * WGM;
        const int p = fm + ((wgid % nig) % WGM); u.pn = (wgid % nig) / WGM; u.pm = p + 1 + (p >= 16 ? 1 : 0); u.srow = (p >> 4) * RB + (p & 15) * 16; u.kh = -1; return true;
    }
    __device__ __forceinline__ void a_ready(const Unit&) const {}
    __device__ __forceinline__ void done(const Unit&) const {}
};
template <size_t XOFF, size_t FOFF> struct LatOrderSplit {
    static constexpr bool SPLIT = true;
    int nN, nwg, G, c, full, R; GAS unsigned char* wsb; static constexpr size_t xoff = XOFF, foff = FOFF;
    __device__ __forceinline__ void init(int N, int G_, int c_) { nN = N / BM; nwg = 32 * nN; G = G_; c = c_; R = nwg % G; if (R > 0 && 2 * R <= G && R % NXCD == 0) full = nwg - R; else { full = nwg; R = 0; } }
    __device__ __forceinline__ bool next(int i, Unit& u) const {
        const long L = (long)i * G + c; int wgid, kh = -1;
        if (L < full) wgid = (int)L;
        else { if (R == 0 || L >= full + 2 * R) return false; const int t = (int)(L - full); kh = t >= R ? 1 : 0; wgid = full + (t >= R ? t - R : t); }
        { const int q = nwg / NXCD, r = nwg % NXCD, xcd = wgid % NXCD, off = wgid / NXCD; wgid = (xcd < r ? xcd * (q + 1) : r * (q + 1) + (xcd - r) * q) + off; }
        const int nig = WGM * nN, gid = wgid / nig, fm = gid * WGM;
        const int p = fm + ((wgid % nig) % WGM); u.pn = (wgid % nig) / WGM; u.pm = p + 1 + (p >= 16 ? 1 : 0); u.srow = (p >> 4) * RB + (p & 15) * 16; u.kh = kh; return true;
    }
    __device__ __forceinline__ void a_ready(const Unit&) const {}
    __device__ __forceinline__ void done(const Unit&) const {}
};


__device__ __forceinline__ float rstd_of(float ss) { return __builtin_amdgcn_rsqf(ss * (1.0f / DM) + NORM_EPS); }
__device__ __forceinline__ void atomic_add_f32(gf32* p, float v) { (void)__builtin_amdgcn_global_atomic_fadd_f32(p, v); }

struct EpiRes {
    static constexpr bool PERM = true, AFTER_DRAIN = false;
    const gh16* base; gh16* out; const gf32* ada_l; int chunk; const gf32* ls;
    gb16* An; const gf32* gnext; const gf32* ada_n; int sc_chunk; gf32* stats;
    __device__ __forceinline__ void prefetch(const Unit&, PG8_LAS float*, int, int, int) const {}
    __device__ __forceinline__ void operator()(const f32x4 (&acc)[2][2][4][2], const Unit& u, int wr, int wc, int fr, int fq, const PG8_LAS float*) const {
        const int vec = (u.pm % PTILES == 0) ? 2 : (u.pm / PTILES);
        const GAS char* gate = (const GAS char*)(ada_l + (size_t)(vec * 6 + chunk) * DM + u.pn * BM);
        const GAS char* lsp = (const GAS char*)(ls + u.pn * BM);
        const GAS char* gnp = (const GAS char*)(gnext + u.pn * BM);
        const GAS char* scp = (const GAS char*)(ada_n + (size_t)(vec * 6 + sc_chunk) * DM + u.pn * BM);
        const GAS char* bt = (const GAS char*)(base + (size_t)u.pm * BM * DM + u.pn * BM);
        GAS char* ot = (GAS char*)(out + (size_t)u.pm * BM * DM + u.pn * BM);
        GAS char* at = (GAS char*)(An + (size_t)u.pm * BM * DM + u.pn * BM);
        asm volatile("" : "+v"(fr), "+v"(fq));
        const unsigned lo = (unsigned)((wr * 64 + fr) * DM + wc * 32 + 8 * fq) * 2u, co = (unsigned)(wc * 32 + 8 * fq) * 4u;
        const unsigned so = (unsigned)(wr * 64 + fq * 16 + fr) * 4u;
        float ssq[2][4];
#pragma unroll
        for (int ai = 0; ai < 2; ++ai)
#pragma unroll
            for (int m = 0; m < 4; ++m) ssq[ai][m] = 0.f;
#pragma unroll
        for (int bj = 0; bj < 2; ++bj) {
            f32x4 gv[2], gm[2];
#pragma unroll
            for (int n = 0; n < 2; ++n) { const unsigned c = co + (unsigned)(bj * HALF + n * 4) * 4u;
                gv[n] = *(const gf32x4*)(gate + c); if (ls) gv[n] = gv[n] * *(const gf32x4*)(lsp + c);
                gm[n] = An ? *(const gf32x4*)(gnp + c) * (*(const gf32x4*)(scp + c) + 1.0f) : (f32x4){0.f, 0.f, 0.f, 0.f}; }
            u32x4 bs[2][4];
#pragma unroll
            for (int ai = 0; ai < 2; ++ai)
#pragma unroll
                for (int m = 0; m < 4; ++m) { const unsigned o = lo + (unsigned)((ai * HALF + m * 16) * DM + bj * HALF) * 2u; bs[ai][m] = *(const gu32x4*)(bt + o); }
            asm volatile("" ::: "memory");
#pragma unroll
            for (int ai = 0; ai < 2; ++ai)
#pragma unroll
                for (int m = 0; m < 4; ++m) { const unsigned o = lo + (unsigned)((ai * HALF + m * 16) * DM + bj * HALF) * 2u; const u32x4 b = bs[ai][m];
                    const f32x4 x0 = (f32x4){h16_lo(b.x), h16_hi(b.x), h16_lo(b.y), h16_hi(b.y)} + acc[ai][bj][m][0] * gv[0], x1 = (f32x4){h16_lo(b.z), h16_hi(b.z), h16_lo(b.w), h16_hi(b.w)} + acc[ai][bj][m][1] * gv[1];
                    { u32x4 w; w.x = pk_h16(x0.x, x0.y); w.y = pk_h16(x0.z, x0.w); w.z = pk_h16(x1.x, x1.y); w.w = pk_h16(x1.z, x1.w); *(gu32x4*)(ot + o) = w; }
                    ssq[ai][m] += (x0.x * x0.x + x0.y * x0.y) + (x0.z * x0.z + x0.w * x0.w) + (x1.x * x1.x + x1.y * x1.y) + (x1.z * x1.z + x1.w * x1.w);
                    if (An) { const f32x4 y0 = x0 * gm[0], y1 = x1 * gm[1]; u32x4 w; w.x = cvt_pk_bf16(y0.x, y0.y); w.y = cvt_pk_bf16(y0.z, y0.w); w.z = cvt_pk_bf16(y1.x, y1.y); w.w = cvt_pk_bf16(y1.z, y1.w); *(gu32x4*)(at + o) = w; } }
            asm volatile("" ::: "memory");
        }
        if (stats) {
#pragma unroll
            for (int ai = 0; ai < 2; ++ai) {
#pragma unroll
                for (int m = 0; m < 4; ++m) { ssq[ai][m] += __shfl_xor(ssq[ai][m], 16); ssq[ai][m] += __shfl_xor(ssq[ai][m], 32); }
                const float v = fq == 0 ? ssq[ai][0] : fq == 1 ? ssq[ai][1] : fq == 2 ? ssq[ai][2] : ssq[ai][3];
                atomic_add_f32((gf32*)((GAS char*)(stats + u.pm * BM + ai * HALF) + so), v); }
        }
    }
    __device__ __forceinline__ void strip(const f32x4 (&accS)[2], const Unit& u, int wr, int wc, int fr, int fq) const {
        const GAS char* gate = (const GAS char*)(ada_l + (size_t)(2 * 6 + chunk) * DM + u.pn * BM);
        const GAS char* lsp = (const GAS char*)(ls + u.pn * BM);
        const GAS char* gnp = (const GAS char*)(gnext + u.pn * BM);
        const GAS char* scp = (const GAS char*)(ada_n + (size_t)(2 * 6 + sc_chunk) * DM + u.pn * BM);
        const GAS char* bt = (const GAS char*)(base + (size_t)u.srow * DM + u.pn * BM);
        GAS char* ot = (GAS char*)(out + (size_t)u.srow * DM + u.pn * BM);
        GAS char* at = (GAS char*)(An + (size_t)u.srow * DM + u.pn * BM);
        asm volatile("" : "+v"(fr), "+v"(fq));
        const unsigned co = (unsigned)(wc * 32 + 8 * fq + 4 * wr) * 4u, lo = (unsigned)(fr * DM) * 2u + (co >> 1), so = (unsigned)fr * 4u;
        float q = 0.f;
#pragma unroll
        for (int bj = 0; bj < 2; ++bj) { const unsigned c = co + (unsigned)(bj * HALF) * 4u, o = lo + (unsigned)(bj * HALF) * 2u;
            f32x4 gv = *(const gf32x4*)(gate + c); if (ls) gv = gv * *(const gf32x4*)(lsp + c);
            const u32x2 b = *(const gu32x2*)(bt + o);
            const f32x4 x0 = (f32x4){h16_lo(b.x), h16_hi(b.x), h16_lo(b.y), h16_hi(b.y)} + accS[bj] * gv; { u32x2 w; w.x = pk_h16(x0.x, x0.y); w.y = pk_h16(x0.z, x0.w); *(gu32x2*)(ot + o) = w; }
            q += (x0.x * x0.x + x0.y * x0.y) + (x0.z * x0.z + x0.w * x0.w);
            if (An) { const f32x4 y0 = x0 * (*(const gf32x4*)(gnp + c) * (*(const gf32x4*)(scp + c) + 1.0f));
                u32x2 w; w.x = cvt_pk_bf16(y0.x, y0.y); w.y = cvt_pk_bf16(y0.z, y0.w); *(gu32x2*)(at + o) = w; } }
        if (stats) { q += __shfl_xor(q, 16); q += __shfl_xor(q, 32); if (fq == 0) atomic_add_f32((gf32*)((GAS char*)(stats + u.srow) + so), q); }
    }
};
struct EpiFinal {
    static constexpr bool PERM = true, AFTER_DRAIN = false;
    const gh16* base; const gf32* ada_l; int chunk; gf32* stats; const gf32* fg; gf32* out; unsigned* cnt;
    __device__ __forceinline__ void prefetch(const Unit&, PG8_LAS float*, int, int, int) const {}
    __device__ __forceinline__ void operator()(f32x4 (&acc)[2][2][4][2], const Unit& u, int wr, int wc, int fr, int fq, const PG8_LAS float*) const {
        const int b = u.pm / PTILES;
        const GAS char* gate = (const GAS char*)(ada_l + (size_t)(b * 6 + chunk) * DM + u.pn * BM);
        const GAS char* bt = (const GAS char*)(base + (size_t)u.pm * BM * DM + u.pn * BM);
        asm volatile("" : "+v"(fr), "+v"(fq));
        const unsigned lo = (unsigned)((wr * 64 + fr) * DM + wc * 32 + 8 * fq) * 2u, co = (unsigned)(wc * 32 + 8 * fq) * 4u;
        const unsigned so = (unsigned)(wr * 64 + fq * 16 + fr) * 4u;
        float ssq[2][4];
#pragma unroll
        for (int ai = 0; ai < 2; ++ai)
#pragma unroll
            for (int m = 0; m < 4; ++m) ssq[ai][m] = 0.f;
#pragma unroll
        for (int bj = 0; bj < 2; ++bj) {
            f32x4 gv[2];
#pragma unroll
            for (int n = 0; n < 2; ++n) gv[n] = *(const gf32x4*)(gate + co + (unsigned)(bj * HALF + n * 4) * 4u);
            u32x4 bs[2][4];
#pragma unroll
            for (int ai = 0; ai < 2; ++ai)
#pragma unroll
                for (int m = 0; m < 4; ++m) bs[ai][m] = *(const gu32x4*)(bt + lo + (unsigned)((ai * HALF + m * 16) * DM + bj * HALF) * 2u);
            asm volatile("" ::: "memory");
#pragma unroll
            for (int ai = 0; ai < 2; ++ai)
#pragma unroll
                for (int m = 0; m < 4; ++m) { const u32x4 bb = bs[ai][m];
                    const f32x4 x0 = (f32x4){h16_lo(bb.x), h16_hi(bb.x), h16_lo(bb.y), h16_hi(bb.y)} + acc[ai][bj][m][0] * gv[0], x1 = (f32x4){h16_lo(bb.z), h16_hi(bb.z), h16_lo(bb.w), h16_hi(bb.w)} + acc[ai][bj][m][1] * gv[1];
                    acc[ai][bj][m][0] = x0; acc[ai][bj][m][1] = x1;
                    ssq[ai][m] += (x0.x * x0.x + x0.y * x0.y) + (x0.z * x0.z + x0.w * x0.w) + (x1.x * x1.x + x1.y * x1.y) + (x1.z * x1.z + x1.w * x1.w); }
        }
#pragma unroll
        for (int ai = 0; ai < 2; ++ai) {
#pragma unroll
            for (int m = 0; m < 4; ++m) { ssq[ai][m] += __shfl_xor(ssq[ai][m], 16); ssq[ai][m] += __shfl_xor(ssq[ai][m], 32); }
            const float v = fq == 0 ? ssq[ai][0] : fq == 1 ? ssq[ai][1] : fq == 2 ? ssq[ai][2] : ssq[ai][3];
            atomic_add_f32((gf32*)((GAS char*)(stats + u.pm * BM + ai * HALF) + so), v); }
        asm volatile("s_waitcnt vmcnt(0)" ::: "memory"); __builtin_amdgcn_s_barrier();
        if ((wr | wc | fr | fq) == 0) { unsigned* cp = cnt + u.pm * 16; (void)__hip_atomic_fetch_add(cp, 1u, __ATOMIC_RELAXED, __HIP_MEMORY_SCOPE_AGENT);
            unsigned sp = 0; while (__hip_atomic_load(cp, __ATOMIC_RELAXED, __HIP_MEMORY_SCOPE_AGENT) < (unsigned)(DM / BM)) { __builtin_amdgcn_s_sleep(1); if (++sp > (1u << 22)) break; } }
        __builtin_amdgcn_s_barrier(); asm volatile("" ::: "memory");
        float rs[2][4];
#pragma unroll
        for (int ai = 0; ai < 2; ++ai)
#pragma unroll
            for (int m = 0; m < 4; ++m) rs[ai][m] = rstd_of(__hip_atomic_load(stats + u.pm * BM + ai * HALF + wr * 64 + m * 16 + fr, __ATOMIC_RELAXED, __HIP_MEMORY_SCOPE_AGENT));
        GAS char* ob = (GAS char*)(out + ((size_t)b * SEQ + (size_t)(u.pm % PTILES - 1) * BM) * DM + u.pn * BM);
        const unsigned oo = (unsigned)((wr * 64 + fr) * DM + wc * 32 + 8 * fq) * 4u;
#pragma unroll
        for (int bj = 0; bj < 2; ++bj) {
            const f32x4 f0 = *(const gf32x4*)((const GAS char*)(fg + u.pn * BM) + co + (unsigned)(bj * HALF) * 4u), f1 = *(const gf32x4*)((const GAS char*)(fg + u.pn * BM) + co + (unsigned)(bj * HALF + 4) * 4u);
#pragma unroll
            for (int ai = 0; ai < 2; ++ai)
#pragma unroll
                for (int m = 0; m < 4; ++m) { const unsigned o = oo + (unsigned)((ai * HALF + m * 16) * DM + bj * HALF) * 4u;
                    *(gf32x4*)(ob + o) = (acc[ai][bj][m][0] * rs[ai][m]) * f0; *(gf32x4*)(ob + o + 16) = (acc[ai][bj][m][1] * rs[ai][m]) * f1; }
        }
    }
};
template <bool PF> struct EpiQKV {
    static constexpr bool PERM = true, AFTER_DRAIN = false;
    gb16* P0; gb16* P1; gb16* P2; int n0, n1, ld0, ld1; const gf32* stats; const gf32* bias; int nb; float qscale;
    const gf32* gk; const gf32* rope; PG8_LAS float* xk;
    __device__ __forceinline__ void prefetch(const Unit& u, PG8_LAS float* area, int lane, int wr, int wc) const {
        if constexpr (!PF) return;
        asm volatile("" : "+v"(lane));
        const int vec = (u.pm % PTILES == 0) ? 2 : (u.pm / PTILES);
        const gf32* sp = stats + u.pm * BM + wr * 64 + lane;
        __builtin_amdgcn_global_load_lds((const GAS unsigned*)sp, (PG8_LAS unsigned*)area, 4, 0, 0);
        __builtin_amdgcn_global_load_lds((const GAS unsigned*)(sp + HALF), (PG8_LAS unsigned*)(area + 64), 4, 0, 0);
        __builtin_amdgcn_global_load_lds((const GAS unsigned*)(bias + (size_t)vec * nb + u.pn * BM + (lane >> 5) * HALF + wc * 32 + (lane & 31)), (PG8_LAS unsigned*)(area + 128), 4, 0, 0);
    }
    __device__ __forceinline__ void operator()(const f32x4 (&acc)[2][2][4][2], const Unit& u, int wr, int wc, int fr, int fq, const PG8_LAS float* area, int aim = 3, int flip = 0) const {
        asm volatile("" : "+v"(fr), "+v"(fq));
        const int row0 = u.pm * BM + wr * 64 + fr;
        int colt = u.pn * BM; gb16* base = P0; int ldc = ld0; float qs = qscale;
        if (colt >= n0 + n1) { base = P2; ldc = ld1; colt -= n0 + n1; qs = 1.f; } else if (colt >= n0) { base = P1; ldc = ld1; colt -= n0; qs = 1.f; }
        const int col0 = colt + wc * 32 + 8 * fq;
        if (gk && base == P1) { ktile(acc, u, wr, wc, fr, fq, area, P1 + (size_t)row0 * ld1 + col0, aim, flip); return; }
        f32x4 bv[2][2];
#pragma unroll
        for (int bj = 0; bj < 2; ++bj)
#pragma unroll
            for (int n = 0; n < 2; ++n) bv[bj][n] = PF ? *(const PG8_LAS f32x4*)(area + 128 + bj * 32 + 8 * fq + 4 * n) : *(const gf32x4*)(bias + (size_t)((u.pm % PTILES == 0) ? 2 : (u.pm / PTILES)) * nb + u.pn * BM + wc * 32 + 8 * fq + bj * HALF + 4 * n);
#pragma unroll
        for (int ai = 0; ai < 2; ++ai) { if (!((aim >> ai) & 1)) continue; const int h = ai ^ flip;
#pragma unroll
            for (int m = 0; m < 4; ++m) { const int row = row0 + h * HALF + m * 16; const float rs = rstd_of(PF ? area[h * 64 + m * 16 + fr] : stats[row]); gb16* rowp = base + (size_t)row * ldc + col0;
#pragma unroll
                for (int bj = 0; bj < 2; ++bj) { const f32x4 v0 = (acc[ai][bj][m][0] * rs + bv[bj][0]) * qs, v1 = (acc[ai][bj][m][1] * rs + bv[bj][1]) * qs;
                    u32x4 w; w.x = cvt_pk_bf16(v0[0], v0[1]); w.y = cvt_pk_bf16(v0[2], v0[3]); w.z = cvt_pk_bf16(v1[0], v1[1]); w.w = cvt_pk_bf16(v1[2], v1[3]);
                    *(gu32x4*)(rowp + bj * HALF) = w; } } }
    }
    __device__ __forceinline__ void ktile(const f32x4 (&acc)[2][2][4][2], const Unit& u, int wr, int wc, int fr, int fq, const PG8_LAS float* area, gb16* rowp0, int aim, int flip) const {
        f32x4 bv[2][2];
#pragma unroll
        for (int bj = 0; bj < 2; ++bj)
#pragma unroll
            for (int n = 0; n < 2; ++n) bv[bj][n] = *(const PG8_LAS f32x4*)(area + 128 + bj * 32 + 8 * fq + 4 * n);
        float rs[2][4];
#pragma unroll
        for (int ai = 0; ai < 2; ++ai) { if (!((aim >> ai) & 1)) continue; const int h = ai ^ flip;
#pragma unroll
            for (int m = 0; m < 4; ++m) { rs[ai][m] = rstd_of(area[h * 64 + m * 16 + fr]);
#pragma unroll
                for (int bj = 0; bj < 2; ++bj) { const f32x4 v0 = acc[ai][bj][m][0] * rs[ai][m] + bv[bj][0], v1 = acc[ai][bj][m][1] * rs[ai][m] + bv[bj][1];
                    float q = (v0.x * v0.x + v0.y * v0.y) + (v0.z * v0.z + v0.w * v0.w) + (v1.x * v1.x + v1.y * v1.y) + (v1.z * v1.z + v1.w * v1.w);
                    q += __shfl_xor(q, 16); q += __shfl_xor(q, 32);
                    if (fq == 0) xk[(bj * BM + h * HALF + wr * 64 + m * 16 + fr) * 4 + wc] = q; } } }
        asm volatile("s_waitcnt lgkmcnt(0)" ::: "memory"); __builtin_amdgcn_s_barrier(); asm volatile("" ::: "memory");
        const f32x4 g0 = *(const gf32x4*)(gk + wc * 32 + 8 * fq), g1 = *(const gf32x4*)(gk + wc * 32 + 8 * fq + 4);
        const bool lat = (u.pm % PTILES) != 0;
        const int f0 = 16 * (wc & 1) + 4 * fq;
#pragma unroll
        for (int ai = 0; ai < 2; ++ai) { if (!((aim >> ai) & 1)) continue;
#pragma unroll
            for (int m = 0; m < 4; ++m) { const int rl = (ai ^ flip) * HALF + wr * 64 + m * 16 + fr; const int t = ((u.pm % PTILES) - 1) * BM + rl; const int pos = wc < 2 ? (t >> 6) : (t & 63);
                f32x4 t0 = {1.f, 0.f, 1.f, 0.f}, t1 = t0;
                if (lat) { t0 = *(const gf32x4*)(rope + 2 * (pos * 32 + f0)); t1 = *(const gf32x4*)(rope + 2 * (pos * 32 + f0 + 2)); }
#pragma unroll
                for (int bj = 0; bj < 2; ++bj) { const f32x4 pq = *(const PG8_LAS f32x4*)(xk + (bj * BM + rl) * 4);
                    const float rh = __builtin_amdgcn_rsqf(((pq.x + pq.y) + (pq.z + pq.w)) * (1.0f / 128.0f) + NORM_EPS);
                    const f32x4 y0 = (acc[ai][bj][m][0] * rs[ai][m] + bv[bj][0]) * rh * g0, y1 = (acc[ai][bj][m][1] * rs[ai][m] + bv[bj][1]) * rh * g1;
                    u32x4 w; w.x = cvt_pk_bf16(y0.x * t0.x - y0.y * t0.y, y0.x * t0.y + y0.y * t0.x); w.y = cvt_pk_bf16(y0.z * t0.z - y0.w * t0.w, y0.z * t0.w + y0.w * t0.z);
                    w.z = cvt_pk_bf16(y1.x * t1.x - y1.y * t1.y, y1.x * t1.y + y1.y * t1.x); w.w = cvt_pk_bf16(y1.z * t1.z - y1.w * t1.w, y1.z * t1.w + y1.w * t1.z);
                    *(gu32x4*)(rowp0 + (size_t)((ai ^ flip) * HALF + m * 16) * ld1 + bj * HALF) = w; } } }
    }
    __device__ __forceinline__ void strip(const f32x4 (&accS)[2], const Unit& u, int wr, int wc, int fr, int fq) const {
        asm volatile("" : "+v"(fr), "+v"(fq));
        int colt = u.pn * BM; gb16* base = P0; int ldc = ld0; float qs = qscale;
        if (colt >= n0 + n1) { base = P2; ldc = ld1; colt -= n0 + n1; qs = 1.f; } else if (colt >= n0) { base = P1; ldc = ld1; colt -= n0; qs = 1.f; }
        const int row = u.srow + fr; const float rs = rstd_of(stats[row]);
        gb16* rowp = base + (size_t)row * ldc + colt + wc * 32 + 8 * fq + 4 * wr; const gf32* bp = bias + (size_t)2 * nb + u.pn * BM + wc * 32 + 8 * fq + 4 * wr;
        if (gk && base == P1) {
            f32x4 v[2];
            __builtin_amdgcn_s_barrier();
#pragma unroll
            for (int bj = 0; bj < 2; ++bj) { v[bj] = accS[bj] * rs + *(const gf32x4*)(bp + bj * HALF);
                float q = (v[bj].x * v[bj].x + v[bj].y * v[bj].y) + (v[bj].z * v[bj].z + v[bj].w * v[bj].w); q += __shfl_xor(q, 16); q += __shfl_xor(q, 32);
                if (fq == 0) xk[(bj * 16 + fr) * 8 + wr * 4 + wc] = q; }
            asm volatile("s_waitcnt lgkmcnt(0)" ::: "memory"); __builtin_amdgcn_s_barrier(); asm volatile("" ::: "memory");
            const f32x4 g = *(const gf32x4*)(gk + wc * 32 + 8 * fq + 4 * wr);
#pragma unroll
            for (int bj = 0; bj < 2; ++bj) { const f32x4 p0 = *(const PG8_LAS f32x4*)(xk + (bj * 16 + fr) * 8), p1 = *(const PG8_LAS f32x4*)(xk + (bj * 16 + fr) * 8 + 4);
                const float rh = __builtin_amdgcn_rsqf((((p0.x + p0.y) + (p0.z + p0.w)) + ((p1.x + p1.y) + (p1.z + p1.w))) * (1.0f / 128.0f) + NORM_EPS);
                const f32x4 y = v[bj] * rh * g; u32x2 w; w.x = cvt_pk_bf16(y[0], y[1]); w.y = cvt_pk_bf16(y[2], y[3]); *(gu32x2*)(rowp + bj * HALF) = w; }
            return; }
#pragma unroll
        for (int bj = 0; bj < 2; ++bj) { const f32x4 v = (accS[bj] * rs + *(const gf32x4*)(bp + bj * HALF)) * qs; u32x2 w; w.x = cvt_pk_bf16(v[0], v[1]); w.y = cvt_pk_bf16(v[2], v[3]); *(gu32x2*)(rowp + bj * HALF) = w; }
    }
};
__device__ __forceinline__ float silu_mul(float g, float u) { return g * u * __builtin_amdgcn_rcpf(1.0f + __builtin_amdgcn_exp2f(-1.4426950408889634f * g)); }
__device__ __forceinline__ unsigned silu_mul_pk(f32x2 g, f32x2 u) {
    const f32x2 t = g * (-1.4426950408889634f); f32x2 e; e.x = __builtin_amdgcn_exp2f(t.x); e.y = __builtin_amdgcn_exp2f(t.y);
    const f32x2 d = e + 1.0f; f32x2 r; r.x = __builtin_amdgcn_rcpf(d.x); r.y = __builtin_amdgcn_rcpf(d.y);
    const f32x2 o = (g * u) * r; return cvt_pk_bf16(o.x, o.y);
}
struct EpiSwiGLU {
    static constexpr bool PERM = true, AFTER_DRAIN = false;
    gb16* U; const gf32* stats; const gf32* bias;
    __device__ __forceinline__ void prefetch(const Unit& u, PG8_LAS float* area, int lane, int wr, int wc) const {
        asm volatile("" : "+v"(lane));
        const int vec = (u.pm % PTILES == 0) ? 2 : (u.pm / PTILES);
        const gf32* sp = stats + u.pm * BM + wr * 64 + lane;
        __builtin_amdgcn_global_load_lds((const GAS unsigned*)sp, (PG8_LAS unsigned*)area, 4, 0, 0);
        __builtin_amdgcn_global_load_lds((const GAS unsigned*)(sp + HALF), (PG8_LAS unsigned*)(area + 64), 4, 0, 0);
        __builtin_amdgcn_global_load_lds((const GAS unsigned*)(bias + (size_t)vec * (2 * FF) + u.pn * BM + (lane >> 5) * HALF + wc * 32 + (lane & 31)), (PG8_LAS unsigned*)(area + 128), 4, 0, 0);
    }
    __device__ __forceinline__ void operator()(const f32x4 (&acc)[2][2][4][2], const Unit& u, int wr, int wc, int fr, int fq, const PG8_LAS float* area, int aim = 3, int flip = 0) const {
        asm volatile("" : "+v"(fr), "+v"(fq));
        const int row0 = u.pm * BM + wr * 64 + fr;
        const int col0 = u.pn * HALF + wc * 32 + 8 * fq;
        const f32x4 bg0 = *(const PG8_LAS f32x4*)(area + 128 + 8 * fq), bg1 = *(const PG8_LAS f32x4*)(area + 128 + 8 * fq + 4), bu0 = *(const PG8_LAS f32x4*)(area + 160 + 8 * fq), bu1 = *(const PG8_LAS f32x4*)(area + 160 + 8 * fq + 4);
#pragma unroll
        for (int ai = 0; ai < 2; ++ai) { if (!((aim >> ai) & 1)) continue;
#pragma unroll
            for (int m = 0; m < 4; ++m) { const int h = ai ^ flip; const int row = row0 + h * HALF + m * 16; const float rs = rstd_of(area[h * 64 + m * 16 + fr]); gb16* rowp = U + (size_t)row * FF + col0;
                const f32x4 g0 = acc[ai][0][m][0] * rs + bg0, g1 = acc[ai][0][m][1] * rs + bg1, u0 = acc[ai][1][m][0] * rs + bu0, u1 = acc[ai][1][m][1] * rs + bu1;
                u32x4 w; w.x = silu_mul_pk((f32x2){g0[0], g0[1]}, (f32x2){u0[0], u0[1]}); w.y = silu_mul_pk((f32x2){g0[2], g0[3]}, (f32x2){u0[2], u0[3]});
                w.z = silu_mul_pk((f32x2){g1[0], g1[1]}, (f32x2){u1[0], u1[1]}); w.w = silu_mul_pk((f32x2){g1[2], g1[3]}, (f32x2){u1[2], u1[3]});
                *(gu32x4*)rowp = w; } }
    }
};

template <class Epi, class Sched, bool ALIGN_EPI = false, bool SP2 = false>
__device__ __forceinline__ void gemm_phase(PG8_LAS unsigned char* lds, PG8_LAS unsigned char* pf, const Gemm g, const Sched& S, const Epi& E, int wv) {
    const int tid = tid_here(wv), wid = wv, lane = tid & 63, wr = wid >> 2, wc = wid & 3, fr = lane & 15, fq = lane >> 4;
    const int K = g.K, nt = K / BK, lda = g.lda;
    unsigned voffA[2], voffB[2];
#pragma unroll
    for (int i = 0; i < 2; ++i) { int R, C; stage_rc(tid * 16 + i * 8192, R, C); const int Rb = Epi::PERM ? ((R & ~31) + perm32(R & 31)) : R;
        voffA[i] = (unsigned)(R * lda + C) * 2u; voffB[i] = (unsigned)(Rb * K + C) * 2u; }
    const size_t kstep = (size_t)(BK * 2);
    const size_t hstepA = (size_t)HALF * lda * 2, hstepB = (size_t)HALF * K * 2;
    const size_t tstepA = 2 * hstepA, tstepB = 2 * hstepB;
    const unsigned ldsw = (unsigned)wid * 1024u;
    const int aoff = lds_byte(wr * 64 + fr, fq * 8), boff = lds_byte(wc * 32 + fr, fq * 8);
#define PG8_SA(b, h) (((b) * 2 + (h)) * HTB)
#define PG8_SB(b, h) ((4 + (b) * 2 + (h)) * HTB)
#define PG8_STAGE(bufoff, gbase, voff) do { _Pragma("unroll") for (int _i = 0; _i < 2; ++_i) \
        __builtin_amdgcn_global_load_lds((const GAS unsigned*)((const GAS char*)(gbase) + (voff)[_i]), (PG8_LAS unsigned*)(lds + (bufoff) + ldsw + _i * 8192), 16, 0, 0); } while (0)
#define PG8_LDA(dst, b, h) do { _Pragma("unroll") for (int m = 0; m < 4; ++m) _Pragma("unroll") for (int k = 0; k < 2; ++k) dst[m][k] = *(const PG8_LAS bf16x8*)(lds + PG8_SA(b, h) + aoff + m * 2048 + k * 1024); } while (0)
#define PG8_LDB(dst, b, h) do { _Pragma("unroll") for (int n = 0; n < 2; ++n) _Pragma("unroll") for (int k = 0; k < 2; ++k) dst[n][k] = *(const PG8_LAS bf16x8*)(lds + PG8_SB(b, h) + boff + n * 2048 + k * 1024); } while (0)
#define PG8_MMA(ai, bj, At, Bt) do { __builtin_amdgcn_s_setprio(1); _Pragma("unroll") for (int m = 0; m < 4; ++m) _Pragma("unroll") for (int n = 0; n < 2; ++n) _Pragma("unroll") for (int k = 0; k < 2; ++k) \
        acc[ai][bj][m][n] = __builtin_amdgcn_mfma_f32_16x16x32_bf16(Bt[n][k], At[m][k], acc[ai][bj][m][n], 0, 0, 0); __builtin_amdgcn_s_setprio(0); } while (0)
#define PG8_WAIT_V(n) asm volatile("s_waitcnt vmcnt(" #n ")" ::: "memory")
#define PG8_WAIT_L(n) asm volatile("s_waitcnt lgkmcnt(" #n ")" ::: "memory")
#define PG8_BAR __builtin_amdgcn_s_barrier()
#define PG8_SCHED __builtin_amdgcn_sched_barrier(0)
#define PG8_KOFF(u) ((Sched::SPLIT && (u).kh > 0) ? (size_t)K : (size_t)0)
#define PG8_ABASE(u) ((const GAS char*)g.A + (size_t)(u).pm * tstepA + (size_t)((u).pn / g.a_tpg) * (size_t)K * 2 + PG8_KOFF(u))
#define PG8_BBASE(u) ((const GAS char*)g.Bt + (size_t)(u).pn * tstepB + PG8_KOFF(u))
    Unit cur, nxt; int ui = 0;
    if (!S.next(0, cur)) return;
    f32x4 acc[2][2][4][2];
#pragma unroll
    for (int a = 0; a < 2; ++a)
#pragma unroll
        for (int b = 0; b < 2; ++b)
#pragma unroll
            for (int m = 0; m < 4; ++m)
#pragma unroll
                for (int n = 0; n < 2; ++n) acc[a][b][m][n] = (f32x4){0.f, 0.f, 0.f, 0.f};
    bf16x8 At[4][2], B0[2][2], B1[2][2];
    const GAS char* cA = PG8_ABASE(cur); const GAS char* cB = PG8_BBASE(cur);
    long hsA = (long)hstepA;
    if constexpr (Sched::SPLIT) { if (cur.kh > 0) { cA += hstepA; hsA = -(long)hstepA; } }
    S.a_ready(cur);
    int par = 0;
    E.prefetch(cur, (PG8_LAS float*)(pf + wid * 1024), lane, wr, wc);
    if constexpr (SP2) {
        PG8_STAGE(PG8_SB(0, 0), cB, voffB); PG8_STAGE(PG8_SB(0, 1), cB + hstepB, voffB); PG8_STAGE(PG8_SA(0, 0), cA, voffA); PG8_STAGE(PG8_SA(0, 1), cA + (Sched::SPLIT ? hsA : (long)hstepA), voffA);
        if (wr == 1) PG8_BAR;
        PG8_WAIT_V(2); PG8_BAR;
        PG8_STAGE(PG8_SB(1, 0), cB + kstep, voffB); PG8_STAGE(PG8_SA(1, 0), cA + kstep, voffA); PG8_STAGE(PG8_SB(1, 1), cB + hstepB + kstep, voffB);
        PG8_WAIT_V(6); PG8_BAR;
    } else {
        PG8_STAGE(PG8_SB(0, 0), cB, voffB); PG8_STAGE(PG8_SA(0, 0), cA, voffA); PG8_STAGE(PG8_SB(0, 1), cB + hstepB, voffB); PG8_STAGE(PG8_SA(0, 1), cA + hstepA, voffA);
        if (wr == 1) PG8_BAR;
        PG8_WAIT_V(4); PG8_BAR;
        PG8_STAGE(PG8_SB(1, 0), cB + kstep, voffB); PG8_STAGE(PG8_SA(1, 0), cA + kstep, voffA); PG8_STAGE(PG8_SB(1, 1), cB + hstepB + kstep, voffB);
        PG8_WAIT_V(6); PG8_BAR;
    }
    for (;;) {
        const bool has_next = S.next(ui + 1, nxt);
        const GAS char* nA = has_next ? PG8_ABASE(nxt) : cA; const GAS char* nB = has_next ? PG8_BBASE(nxt) : cB;
        if constexpr (Sched::SPLIT) { if (has_next && nxt.kh > 0) nA += hstepA; }
        int ntu = nt; if constexpr (Sched::SPLIT) { if (cur.kh >= 0) ntu = nt >> 1; }
        asm volatile(".p2align 8");
        for (int t = 0; t < ntu; t += 2) {
            const bool last = (t == ntu - 2);
            const GAS char* a1 = cA + (size_t)(t + 1) * kstep;
            const GAS char* a2 = last ? nA : cA + (size_t)(t + 2) * kstep; const GAS char* b2 = last ? nB : cB + (size_t)(t + 2) * kstep;
            const GAS char* a3 = a2 + kstep; const GAS char* b3 = b2 + kstep;
            if (last && has_next) S.a_ready(nxt);
            if constexpr (SP2) {
            PG8_LDB(B0, 0, 0); PG8_LDB(B1, 0, 1); PG8_SCHED; PG8_LDA(At, 0, 0); PG8_STAGE(PG8_SA(1, 1), a1 + (Sched::SPLIT ? hsA : (long)hstepA), voffA);
            PG8_WAIT_V(8); PG8_WAIT_L(0); PG8_BAR; PG8_MMA(0, 0, At, B0); PG8_MMA(0, 1, At, B1); PG8_BAR; PG8_SCHED;
            PG8_LDA(At, 0, 1); PG8_STAGE(PG8_SB(0, 0), b2, voffB); PG8_STAGE(PG8_SB(0, 1), b2 + hstepB, voffB); PG8_STAGE(PG8_SA(0, 0), a2, voffA);
            PG8_WAIT_V(8); PG8_WAIT_L(0); PG8_BAR; PG8_MMA(1, 0, At, B0); PG8_MMA(1, 1, At, B1); PG8_BAR; PG8_SCHED;
            PG8_LDB(B0, 1, 0); PG8_LDB(B1, 1, 1); PG8_SCHED; PG8_LDA(At, 1, 0); PG8_STAGE(PG8_SA(0, 1), a2 + (Sched::SPLIT ? ((last && has_next) ? (nxt.kh > 0 ? -(long)hstepA : (long)hstepA) : hsA) : (long)hstepA), voffA);
            PG8_WAIT_V(8); PG8_WAIT_L(0); PG8_BAR; PG8_MMA(0, 0, At, B0); PG8_MMA(0, 1, At, B1); PG8_BAR; PG8_SCHED;
            PG8_LDA(At, 1, 1); PG8_STAGE(PG8_SB(1, 0), b3, voffB); PG8_STAGE(PG8_SB(1, 1), b3 + hstepB, voffB); PG8_STAGE(PG8_SA(1, 0), a3, voffA);
            PG8_WAIT_V(8); PG8_WAIT_L(0); PG8_BAR; PG8_MMA(1, 0, At, B0); PG8_MMA(1, 1, At, B1); PG8_BAR; PG8_SCHED;
            } else {
            PG8_LDB(B0, 0, 0); PG8_SCHED; PG8_LDA(At, 0, 0); PG8_STAGE(PG8_SA(1, 1), a1 + hstepA, voffA);
            PG8_WAIT_L(8); PG8_BAR; PG8_WAIT_L(0); PG8_MMA(0, 0, At, B0); PG8_BAR; PG8_SCHED;
            PG8_LDB(B1, 0, 1); PG8_STAGE(PG8_SB(0, 0), b2, voffB);
            PG8_BAR; PG8_WAIT_L(0); PG8_MMA(0, 1, At, B1); PG8_BAR;
            PG8_LDA(At, 0, 1); PG8_STAGE(PG8_SA(0, 0), a2, voffA);
            PG8_BAR; PG8_WAIT_L(0); PG8_MMA(1, 0, At, B0); PG8_BAR; PG8_SCHED;
            PG8_STAGE(PG8_SB(0, 1), b2 + hstepB, voffB);
            PG8_WAIT_V(6); PG8_BAR; PG8_MMA(1, 1, At, B1); PG8_BAR;
            PG8_LDB(B0, 1, 0); PG8_SCHED; PG8_LDA(At, 1, 0); PG8_STAGE(PG8_SA(0, 1), a2 + hstepA, voffA);
            PG8_WAIT_L(8); PG8_BAR; PG8_WAIT_L(0); PG8_MMA(0, 0, At, B0); PG8_BAR; PG8_SCHED;
            PG8_LDB(B1, 1, 1); PG8_STAGE(PG8_SB(1, 0), b3, voffB);
            PG8_BAR; PG8_WAIT_L(0); PG8_MMA(0, 1, At, B1); PG8_BAR;
            PG8_LDA(At, 1, 1); PG8_STAGE(PG8_SA(1, 0), a3, voffA);
            PG8_BAR; PG8_WAIT_L(0); PG8_MMA(1, 0, At, B0); PG8_BAR; PG8_SCHED;
            PG8_STAGE(PG8_SB(1, 1), b3 + hstepB, voffB);
            PG8_WAIT_V(6); PG8_BAR; PG8_MMA(1, 1, At, B1); PG8_BAR;
            }
        }
        if constexpr (ALIGN_EPI) { if (wr == 0) PG8_BAR; }
        if constexpr (Sched::SPLIT) {
            int aim = 3, flip = 0;
            if (cur.kh >= 0) {
                const int kh = cur.kh, pair = S.c % S.R;
                const __amdgpu_buffer_rsrc_t rw = __builtin_amdgcn_make_buffer_rsrc((void*)(unsigned char*)(S.wsb + S.xoff + (size_t)(pair * 2 + (1 - kh)) * 131072), 0, 131072, 0x00020000);
                const __amdgpu_buffer_rsrc_t rr = __builtin_amdgcn_make_buffer_rsrc((void*)(unsigned char*)(S.wsb + S.xoff + (size_t)(pair * 2 + kh) * 131072), 0, 131072, 0x00020000);
                int tl = tid; asm volatile("" : "+v"(tl)); const int vo = tl * 16;
#pragma unroll
                for (int j = 0; j < 16; ++j) __builtin_amdgcn_raw_buffer_store_b128(__builtin_bit_cast(u32x4, acc[1][j >> 3][(j >> 1) & 3][j & 1]), rw, vo, j * 8192, 16);
                PG8_WAIT_V(0); PG8_BAR;
                if (tl == 0) { (void)__hip_atomic_fetch_add(&((unsigned*)(S.wsb + S.foff))[(pair * 2 + kh) * 16], 1u, __ATOMIC_RELAXED, __HIP_MEMORY_SCOPE_AGENT);
                    unsigned sp = 0; while (__hip_atomic_load(&((unsigned*)(S.wsb + S.foff))[(pair * 2 + (1 - kh)) * 16], __ATOMIC_RELAXED, __HIP_MEMORY_SCOPE_AGENT) == 0u) { __builtin_amdgcn_s_sleep(1); if (++sp > (1u << 22)) break; } }
                PG8_BAR;
#pragma unroll
                for (int j = 0; j < 16; ++j) acc[0][j >> 3][(j >> 1) & 3][j & 1] += __builtin_bit_cast(f32x4, __builtin_amdgcn_raw_buffer_load_b128(rr, vo, j * 8192, 16));
                aim = 1; flip = kh;
            }
            E(acc, cur, wr, wc, fr, fq, (const PG8_LAS float*)(pf + par * 8192 + wid * 1024), aim, flip); S.done(cur);
        } else
        if constexpr (!Epi::AFTER_DRAIN) { E(acc, cur, wr, wc, fr, fq, (const PG8_LAS float*)(pf + par * 8192 + wid * 1024)); S.done(cur); }
        if (!has_next) break;
#pragma unroll
        for (int a = 0; a < 2; ++a)
#pragma unroll
            for (int b = 0; b < 2; ++b)
#pragma unroll
                for (int m = 0; m < 4; ++m)
#pragma unroll
                    for (int n = 0; n < 2; ++n) acc[a][b][m][n] = (f32x4){0.f, 0.f, 0.f, 0.f};
        cur = nxt; cA = nA; cB = nB; if constexpr (Sched::SPLIT) hsA = cur.kh > 0 ? -(long)hstepA : (long)hstepA; ++ui; par ^= 1;
        E.prefetch(cur, (PG8_LAS float*)(pf + par * 8192 + wid * 1024), lane, wr, wc);
        if constexpr (ALIGN_EPI) { if (wr == 1) PG8_BAR; }
    }
    PG8_WAIT_V(0);
    if constexpr (!ALIGN_EPI) { if (wr == 0) PG8_BAR; }
    PG8_BAR;
#undef PG8_SA
#undef PG8_SB
#undef PG8_STAGE
#undef PG8_LDA
#undef PG8_LDB
#undef PG8_MMA
#undef PG8_WAIT_V
#undef PG8_WAIT_L
#undef PG8_BAR
#undef PG8_SCHED
#undef PG8_KOFF
#undef PG8_ABASE
#undef PG8_BBASE
}

template <class Epi, class Sched>
__device__ __forceinline__ void gemm_phase_strip(PG8_LAS unsigned char* lds, PG8_LAS unsigned char* slds, PG8_LAS unsigned char* pf, const Gemm g, const Sched& S, const Epi& E, int wv) {
    const int tid = tid_here(wv), wid = wv, lane = tid & 63, wr = wid >> 2, wc = wid & 3, fr = lane & 15, fq = lane >> 4;
    const int K = g.K, nt = K / BK, lda = g.lda;
    unsigned voffA[2], voffB[2], voffS;
#pragma unroll
    for (int i = 0; i < 2; ++i) { int R, C; stage_rc(tid * 16 + i * 8192, R, C); const int Rb = Epi::PERM ? ((R & ~31) + perm32(R & 31)) : R;
        voffA[i] = (unsigned)(R * lda + C) * 2u; voffB[i] = (unsigned)(Rb * K + C) * 2u; }
    { const int d = wid * 64 + lane, P = d >> 2, sub = d & 3, r = P >> 3, c = (P & 7) ^ (r & 7); voffS = (unsigned)(r * lda + c * 8 + sub * 2) * 2u; }
    const size_t kstep = (size_t)(BK * 2);
    const size_t hstepA = (size_t)HALF * lda * 2, hstepB = (size_t)HALF * K * 2;
    const size_t tstepA = 2 * hstepA, tstepB = 2 * hstepB;
    const unsigned ldsw = (unsigned)wid * 1024u, ldss = (unsigned)wid * 256u;
    const int aoff = lds_byte(wr * 64 + fr, fq * 8), boff = lds_byte(wc * 32 + fr, fq * 8);
#define PG8_SA(b, h) (((b) * 2 + (h)) * HTB)
#define PG8_SB(b, h) ((4 + (b) * 2 + (h)) * HTB)
#define PG8_STAGE(bufoff, gbase, voff) do { _Pragma("unroll") for (int _i = 0; _i < 2; ++_i) \
        __builtin_amdgcn_global_load_lds((const GAS unsigned*)((const GAS char*)(gbase) + (voff)[_i]), (PG8_LAS unsigned*)(lds + (bufoff) + ldsw + _i * 8192), 16, 0, 0); } while (0)
#define PG8_STAGE_S(b, gbase) __builtin_amdgcn_global_load_lds((const GAS unsigned*)((const GAS char*)(gbase) + voffS), (PG8_LAS unsigned*)(slds + (b) * 2048 + ldss), 4, 0, 0)
#define PG8_LDA(dst, b, h) do { _Pragma("unroll") for (int m = 0; m < 4; ++m) _Pragma("unroll") for (int k = 0; k < 2; ++k) dst[m][k] = *(const PG8_LAS bf16x8*)(lds + PG8_SA(b, h) + aoff + m * 2048 + k * 1024); } while (0)
#define PG8_LDB(dst, b, h) do { _Pragma("unroll") for (int n = 0; n < 2; ++n) _Pragma("unroll") for (int k = 0; k < 2; ++k) dst[n][k] = *(const PG8_LAS bf16x8*)(lds + PG8_SB(b, h) + boff + n * 2048 + k * 1024); } while (0)
#define PG8_LDS_S(dst, b) do { int _l = lane; asm volatile("" : "+v"(_l)); const int _fr = _l & 15, _fq = _l >> 4, _s0 = _fr * 128 + ((_fq ^ (_fr & 7)) << 4), _s1 = _fr * 128 + (((4 + _fq) ^ (_fr & 7)) << 4);        \
        dst[0] = *(const PG8_LAS bf16x8*)(slds + (b) * 2048 + _s0); dst[1] = *(const PG8_LAS bf16x8*)(slds + (b) * 2048 + _s1); } while (0)
#define PG8_MMA(ai, bj, At, Bt) do { __builtin_amdgcn_s_setprio(1); _Pragma("unroll") for (int m = 0; m < 4; ++m) _Pragma("unroll") for (int n = 0; n < 2; ++n) _Pragma("unroll") for (int k = 0; k < 2; ++k) \
        acc[ai][bj][m][n] = __builtin_amdgcn_mfma_f32_16x16x32_bf16(Bt[n][k], At[m][k], acc[ai][bj][m][n], 0, 0, 0); __builtin_amdgcn_s_setprio(0); } while (0)
#define PG8_MMA_S() do { __builtin_amdgcn_s_setprio(1); if (wr == 0) { _Pragma("unroll") for (int k = 0; k < 2; ++k) { accS[0] = __builtin_amdgcn_mfma_f32_16x16x32_bf16(B0[0][k], As[k], accS[0], 0, 0, 0); accS[1] = __builtin_amdgcn_mfma_f32_16x16x32_bf16(B1[0][k], As[k], accS[1], 0, 0, 0); } } \
        else { _Pragma("unroll") for (int k = 0; k < 2; ++k) { accS[0] = __builtin_amdgcn_mfma_f32_16x16x32_bf16(B0[1][k], As[k], accS[0], 0, 0, 0); accS[1] = __builtin_amdgcn_mfma_f32_16x16x32_bf16(B1[1][k], As[k], accS[1], 0, 0, 0); } } __builtin_amdgcn_s_setprio(0); } while (0)
#define PG8_WAIT_V(n) asm volatile("s_waitcnt vmcnt(" #n ")" ::: "memory")
#define PG8_WAIT_L(n) asm volatile("s_waitcnt lgkmcnt(" #n ")" ::: "memory")
#define PG8_BAR __builtin_amdgcn_s_barrier()
#define PG8_SCHED __builtin_amdgcn_sched_barrier(0)
#define PG8_KOFF(u) ((Sched::SPLIT && (u).kh > 0) ? (size_t)K : (size_t)0)
#define PG8_ABASE(u) ((const GAS char*)g.A + (size_t)(u).pm * tstepA + (size_t)((u).pn / g.a_tpg) * (size_t)K * 2 + PG8_KOFF(u))
#define PG8_BBASE(u) ((const GAS char*)g.Bt + (size_t)(u).pn * tstepB + PG8_KOFF(u))
#define PG8_SBASE(u) ((const GAS char*)g.A + (size_t)(u).srow * (size_t)lda * 2 + (size_t)((u).pn / g.a_tpg) * (size_t)K * 2 + PG8_KOFF(u))
#define PG8_HS (Sched::SPLIT ? hsA : (long)hstepA)
    Unit cur, nxt; int ui = 0;
    if (!S.next(0, cur)) return;
    f32x4 acc[2][2][4][2]; f32x4 accS[2];
#pragma unroll
    for (int a = 0; a < 2; ++a)
#pragma unroll
        for (int b = 0; b < 2; ++b)
#pragma unroll
            for (int m = 0; m < 4; ++m)
#pragma unroll
                for (int n = 0; n < 2; ++n) acc[a][b][m][n] = (f32x4){0.f, 0.f, 0.f, 0.f};
    accS[0] = (f32x4){0.f, 0.f, 0.f, 0.f}; accS[1] = (f32x4){0.f, 0.f, 0.f, 0.f};
    bf16x8 At[4][2], B0[2][2], B1[2][2], As[2];
    const GAS char* cA = PG8_ABASE(cur); const GAS char* cB = PG8_BBASE(cur); const GAS char* cS = PG8_SBASE(cur);
    long hsA = (long)hstepA;
    if constexpr (Sched::SPLIT) { if (cur.kh > 0) { cA += hstepA; hsA = -(long)hstepA; } }
    int par = 0;
    E.prefetch(cur, (PG8_LAS float*)(pf + wid * 1024), lane, wr, wc);
    PG8_STAGE(PG8_SB(0, 0), cB, voffB); PG8_STAGE(PG8_SB(0, 1), cB + hstepB, voffB); PG8_STAGE(PG8_SA(0, 0), cA, voffA); PG8_STAGE(PG8_SA(0, 1), cA + PG8_HS, voffA); PG8_STAGE_S(0, cS);
    if (wr == 1) PG8_BAR;
    PG8_WAIT_V(3); PG8_BAR;
    PG8_STAGE(PG8_SB(1, 0), cB + kstep, voffB); PG8_STAGE(PG8_SA(1, 0), cA + kstep, voffA); PG8_STAGE(PG8_SB(1, 1), cB + hstepB + kstep, voffB);
    PG8_WAIT_V(6); PG8_BAR;
    for (;;) {
        const bool has_next = S.next(ui + 1, nxt);
        const GAS char* nA = has_next ? PG8_ABASE(nxt) : cA; const GAS char* nB = has_next ? PG8_BBASE(nxt) : cB; const GAS char* nS = has_next ? PG8_SBASE(nxt) : cS;
        if constexpr (Sched::SPLIT) { if (has_next && nxt.kh > 0) nA += hstepA; }
        int ntu = nt; if constexpr (Sched::SPLIT) { if (cur.kh >= 0) ntu = nt >> 1; }
        asm volatile(".p2align 8");
        for (int t = 0; t < ntu; t += 2) {
            const bool last = (t == ntu - 2);
            const GAS char* a1 = cA + (size_t)(t + 1) * kstep; const GAS char* s1 = cS + (size_t)(t + 1) * kstep;
            const GAS char* a2 = last ? nA : cA + (size_t)(t + 2) * kstep; const GAS char* b2 = last ? nB : cB + (size_t)(t + 2) * kstep; const GAS char* s2 = last ? nS : cS + (size_t)(t + 2) * kstep;
            const GAS char* a3 = a2 + kstep; const GAS char* b3 = b2 + kstep;
            PG8_LDB(B0, 0, 0); PG8_LDB(B1, 0, 1); PG8_SCHED; PG8_LDA(At, 0, 0); PG8_STAGE(PG8_SA(1, 1), a1 + PG8_HS, voffA); PG8_STAGE_S(1, s1);
            PG8_WAIT_V(9); PG8_WAIT_L(0); PG8_BAR; PG8_MMA(0, 0, At, B0); PG8_MMA(0, 1, At, B1); PG8_BAR; PG8_SCHED;
            PG8_LDA(At, 0, 1); PG8_LDS_S(As, 0); PG8_STAGE(PG8_SB(0, 0), b2, voffB); PG8_STAGE(PG8_SB(0, 1), b2 + hstepB, voffB); PG8_STAGE(PG8_SA(0, 0), a2, voffA);
            PG8_WAIT_V(9); PG8_WAIT_L(0); PG8_BAR; PG8_MMA(1, 0, At, B0); PG8_MMA(1, 1, At, B1); PG8_MMA_S(); PG8_BAR; PG8_SCHED;
            PG8_LDB(B0, 1, 0); PG8_LDB(B1, 1, 1); PG8_SCHED; PG8_LDA(At, 1, 0); PG8_STAGE(PG8_SA(0, 1), a2 + (Sched::SPLIT ? ((last && has_next) ? (nxt.kh > 0 ? -(long)hstepA : (long)hstepA) : hsA) : (long)hstepA), voffA); PG8_STAGE_S(0, s2);
            PG8_WAIT_V(9); PG8_WAIT_L(0); PG8_BAR; PG8_MMA(0, 0, At, B0); PG8_MMA(0, 1, At, B1); PG8_BAR; PG8_SCHED;
            PG8_LDA(At, 1, 1); PG8_LDS_S(As, 1); PG8_STAGE(PG8_SB(1, 0), b3, voffB); PG8_STAGE(PG8_SB(1, 1), b3 + hstepB, voffB); PG8_STAGE(PG8_SA(1, 0), a3, voffA);
            PG8_WAIT_V(9); PG8_WAIT_L(0); PG8_BAR; PG8_MMA(1, 0, At, B0); PG8_MMA(1, 1, At, B1); PG8_MMA_S(); PG8_BAR; PG8_SCHED;
        }
        if (wr == 0) PG8_BAR;
        if constexpr (Sched::SPLIT) {
            int aim = 3, flip = 0;
            if (cur.kh >= 0) {
                const int kh = cur.kh, pair = S.c % S.R;
                const __amdgpu_buffer_rsrc_t rw = __builtin_amdgcn_make_buffer_rsrc((void*)(unsigned char*)(S.wsb + S.xoff + (size_t)(pair * 2 + (1 - kh)) * 147456), 0, 147456, 0x00020000);
                const __amdgpu_buffer_rsrc_t rr = __builtin_amdgcn_make_buffer_rsrc((void*)(unsigned char*)(S.wsb + S.xoff + (size_t)(pair * 2 + kh) * 147456), 0, 147456, 0x00020000);
                int tl = tid; asm volatile("" : "+v"(tl)); const int vo = tl * 16;
#pragma unroll
                for (int j = 0; j < 16; ++j) __builtin_amdgcn_raw_buffer_store_b128(__builtin_bit_cast(u32x4, acc[1][j >> 3][(j >> 1) & 3][j & 1]), rw, vo, j * 8192, 16);
                __builtin_amdgcn_raw_buffer_store_b128(__builtin_bit_cast(u32x4, accS[0]), rw, vo, 16 * 8192, 16); __builtin_amdgcn_raw_buffer_store_b128(__builtin_bit_cast(u32x4, accS[1]), rw, vo, 17 * 8192, 16);
                PG8_WAIT_V(0); PG8_BAR;
                if (tl == 0) { (void)__hip_atomic_fetch_add(&((unsigned*)(S.wsb + S.foff))[(pair * 2 + kh) * 16], 1u, __ATOMIC_RELAXED, __HIP_MEMORY_SCOPE_AGENT);
                    unsigned sp = 0; while (__hip_atomic_load(&((unsigned*)(S.wsb + S.foff))[(pair * 2 + (1 - kh)) * 16], __ATOMIC_RELAXED, __HIP_MEMORY_SCOPE_AGENT) == 0u) { __builtin_amdgcn_s_sleep(1); if (++sp > (1u << 22)) break; } }
                PG8_BAR;
#pragma unroll
                for (int j = 0; j < 16; ++j) acc[0][j >> 3][(j >> 1) & 3][j & 1] += __builtin_bit_cast(f32x4, __builtin_amdgcn_raw_buffer_load_b128(rr, vo, j * 8192, 16));
                accS[0] += __builtin_bit_cast(f32x4, __builtin_amdgcn_raw_buffer_load_b128(rr, vo, 16 * 8192, 16)); accS[1] += __builtin_bit_cast(f32x4, __builtin_amdgcn_raw_buffer_load_b128(rr, vo, 17 * 8192, 16));
                aim = 1; flip = kh;
            }
            E(acc, cur, wr, wc, fr, fq, (const PG8_LAS float*)(pf + par * 8192 + wid * 1024), aim, flip); if (cur.kh <= 0) E.strip(accS, cur, wr, wc, fr, fq);
        } else {
        E(acc, cur, wr, wc, fr, fq, (const PG8_LAS float*)(pf + par * 8192 + wid * 1024)); E.strip(accS, cur, wr, wc, fr, fq); }
        if (!has_next) break;
#pragma unroll
        for (int a = 0; a < 2; ++a)
#pragma unroll
            for (int b = 0; b < 2; ++b)
#pragma unroll
                for (int m = 0; m < 4; ++m)
#pragma unroll
                    for (int n = 0; n < 2; ++n) acc[a][b][m][n] = (f32x4){0.f, 0.f, 0.f, 0.f};
        accS[0] = (f32x4){0.f, 0.f, 0.f, 0.f}; accS[1] = (f32x4){0.f, 0.f, 0.f, 0.f};
        cur = nxt; cA = nA; cB = nB; cS = nS; if constexpr (Sched::SPLIT) hsA = cur.kh > 0 ? -(long)hstepA : (long)hstepA; ++ui; par ^= 1;
        E.prefetch(cur, (PG8_LAS float*)(pf + par * 8192 + wid * 1024), lane, wr, wc);
        if (wr == 1) PG8_BAR;
    }
    PG8_WAIT_V(0);
    PG8_BAR;
#undef PG8_SA
#undef PG8_SB
#undef PG8_STAGE
#undef PG8_STAGE_S
#undef PG8_LDA
#undef PG8_LDB
#undef PG8_LDS_S
#undef PG8_MMA
#undef PG8_MMA_S
#undef PG8_WAIT_V
#undef PG8_WAIT_L
#undef PG8_BAR
#undef PG8_SCHED
#undef PG8_ABASE
#undef PG8_BBASE
#undef PG8_SBASE
#undef PG8_KOFF
#undef PG8_HS
}
}

namespace att {
using s16x4  = __attribute__((ext_vector_type(4))) short;
using f32x16 = __attribute__((ext_vector_type(16))) float;
constexpr int D = 128, NW = 8, QBLK = 32, KVBLK = 64;
constexpr float SCALE = 0.088388347648318440f;
constexpr float THR = 8.f;
constexpr int SHM_V = KVBLK * D * 2, SHM_K = KVBLK * D * 2, SHM_WS = 2 * SHM_V + 2 * SHM_K, SHM_BIAS = SHM_WS + NW * 64 * 4, SHM_ATTN = SHM_BIAS + 2560, OST_HI = 71680  ;
constexpr int NBIAS = 15 * 31, BIAS_PAD = 48;
#define KSWZ(row, colB) ((row) * 256 + ((colB) ^ (((row) & 7) << 4)))
#define SBAR() __builtin_amdgcn_sched_barrier(0)
__device__ __forceinline__ int crow(int r, int hi) { return (r & 3) + 8 * (r >> 2) + 4 * hi; }
__device__ __forceinline__ unsigned cvtpk(float lo, float hi) { unsigned r; asm volatile("v_cvt_pk_bf16_f32 %0, %1, %2" : "=v"(r) : "v"(lo), "v"(hi)); return r; }

constexpr float QSCALE = SCALE * 1.4426950408889634f;
template <bool FIRST>
__device__ __forceinline__ void partialSM(f32x16& p0, f32x16& p1, float& m_reg, float& alpha) {
  constexpr float THRL = THR * 1.4426950408889634f;
  float pmax = p0[0];
#pragma unroll
  for (int r = 1; r < 16; ++r) pmax = fmaxf(pmax, p0[r]);
#pragma unroll
  for (int r = 0; r < 16; ++r) pmax = fmaxf(pmax, p1[r]);
  { auto rr = __builtin_amdgcn_permlane32_swap(__float_as_uint(pmax), __float_as_uint(pmax), false, false);
    pmax = fmaxf(__uint_as_float(rr[0]), __uint_as_float(rr[1])); }
  if (!FIRST && __builtin_expect(__all(pmax <= THRL), 1)) { alpha = 1.f; }
  else { const float delta = FIRST ? pmax : fmaxf(pmax, 0.f); alpha = FIRST ? 1.f : __builtin_amdgcn_exp2f(-delta); m_reg += delta;
#pragma unroll
    for (int r = 0; r < 16; ++r) { p0[r] -= delta; p1[r] -= delta; } }
#pragma unroll
  for (int r = 0; r < 16; ++r) p0[r] = __builtin_amdgcn_exp2f(p0[r]);
}
__device__ __forceinline__ void finishSM(f32x16& p0, f32x16& p1, float alpha, float& l_reg, bf16x8& pa0, bf16x8& pa1, bf16x8& pa2, bf16x8& pa3) {
#pragma unroll
  for (int r = 0; r < 16; ++r) p1[r] = __builtin_amdgcn_exp2f(p1[r]);
  float ps = 0;
#pragma unroll
  for (int r = 0; r < 16; ++r) ps += p0[r];
#pragma unroll
  for (int r = 0; r < 16; ++r) ps += p1[r];
  { auto rr = __builtin_amdgcn_permlane32_swap(__float_as_uint(ps), __float_as_uint(ps), false, false);
    ps = __uint_as_float(rr[0]) + __uint_as_float(rr[1]); }
  l_reg = l_reg * alpha + ps;
#define PK4(P, BASE, OUT) do { unsigned a0 = cvtpk(P[BASE + 0], P[BASE + 1]), a1 = cvtpk(P[BASE + 2], P[BASE + 3]);   \
    unsigned b0 = cvtpk(P[BASE + 4], P[BASE + 5]), b1 = cvtpk(P[BASE + 6], P[BASE + 7]);                              \
    auto r0 = __builtin_amdgcn_permlane32_swap(a0, b0, false, false); auto r1 = __builtin_amdgcn_permlane32_swap(a1, b1, false, false); \
    u32x4 w = {r0[0], r1[0], r0[1], r1[1]}; OUT = *reinterpret_cast<bf16x8*>(&w); } while (0)
  PK4(p0, 0, pa0); PK4(p0, 8, pa1); PK4(p1, 0, pa2); PK4(p1, 8, pa3);
#undef PK4
}
__device__ __forceinline__ void qkt(f32x16& p0, f32x16& p1, const char* Ks, const bf16x8* qr, int r32, int hi, float negm) {
#pragma unroll
  for (int r = 0; r < 16; ++r) { p0[r] = negm; p1[r] = negm; }
#pragma unroll
  for (int d0 = 0; d0 < 8; ++d0) { int cb = (d0 * 16 + hi * 8) * 2;
    bf16x8 b0 = *reinterpret_cast<const bf16x8*>(Ks + KSWZ(r32, cb));
    bf16x8 b1 = *reinterpret_cast<const bf16x8*>(Ks + KSWZ(32 + r32, cb));
    p0 = __builtin_amdgcn_mfma_f32_32x32x16_bf16(b0, qr[d0], p0, 0, 0, 0);
    p1 = __builtin_amdgcn_mfma_f32_32x32x16_bf16(b1, qr[d0], p1, 0, 0, 0); }
}
__device__ __forceinline__ int v_st(int k, int c) { const int kk = (k & ~0xC) | ((k & 4) << 1) | ((k & 8) >> 1); return ((kk >> 3) * 4 + (c >> 5)) * 512 + ((kk & 7) * 32 + (c & 31)) * 2; }
__device__ __forceinline__ int v_rd_base(int lane) { return ((lane & 3) << 3) | (((lane >> 2) & 3) << 6) | (((lane >> 4) & 1) << 5) | (((lane >> 5) & 1) << 8); }
constexpr int v_rd_off(int d0, int ks, int half) { return d0 * 512 + ks * 4096 + half * 2048; }
template <int OFF> __device__ __forceinline__ s16x4 tr_read(int vb) {
  s16x4 r; asm volatile("ds_read_b64_tr_b16 %0, %1 offset:%2" : "=&v"(r) : "v"(vb), "i"(OFF) : "memory"); return r;
}
template <int D0> __device__ __forceinline__ void pv_one(f32x16& od, int vb, bf16x8 pa0, bf16x8 pa1, bf16x8 pa2, bf16x8 pa3) {
  const s16x4 l0 = tr_read<v_rd_off(D0, 0, 0)>(vb), h0 = tr_read<v_rd_off(D0, 0, 1)>(vb), l1 = tr_read<v_rd_off(D0, 1, 0)>(vb), h1 = tr_read<v_rd_off(D0, 1, 1)>(vb);
  const s16x4 l2 = tr_read<v_rd_off(D0, 2, 0)>(vb), h2 = tr_read<v_rd_off(D0, 2, 1)>(vb), l3 = tr_read<v_rd_off(D0, 3, 0)>(vb), h3 = tr_read<v_rd_off(D0, 3, 1)>(vb);
  asm volatile("s_waitcnt lgkmcnt(0)" ::: "memory"); SBAR();
#define PK(L, H) (bf16x8){L[0], L[1], L[2], L[3], H[0], H[1], H[2], H[3]}
  od = __builtin_amdgcn_mfma_f32_32x32x16_bf16(pa0, PK(l0, h0), od, 0, 0, 0);
  od = __builtin_amdgcn_mfma_f32_32x32x16_bf16(pa1, PK(l1, h1), od, 0, 0, 0);
  od = __builtin_amdgcn_mfma_f32_32x32x16_bf16(pa2, PK(l2, h2), od, 0, 0, 0);
  od = __builtin_amdgcn_mfma_f32_32x32x16_bf16(pa3, PK(l3, h3), od, 0, 0, 0);
#undef PK
}
__device__ __forceinline__ void pv_d0(f32x16* o, int vb, bf16x8 pa0, bf16x8 pa1, bf16x8 pa2, bf16x8 pa3) {
  pv_one<0>(o[0], vb, pa0, pa1, pa2, pa3); pv_one<1>(o[1], vb, pa0, pa1, pa2, pa3); pv_one<2>(o[2], vb, pa0, pa1, pa2, pa3); pv_one<3>(o[3], vb, pa0, pa1, pa2, pa3);
}
__device__ __forceinline__ void nat_mask(f32x16& p0, f32x16& p1, const float* blp, unsigned mlo, unsigned mhi) {
#pragma unroll
  for (int r = 0; r < 16; ++r) {
    const int c = (r & 3) + 8 * (r >> 2);
    const float b0 = blp[c], b1 = blp[c + 32];
    p0[r] = ((mlo >> c) & 1u) ? p0[r] + b0 : -1e30f;
    p1[r] = ((mhi >> c) & 1u) ? p1[r] + b1 : -1e30f;
  }
}
template <bool NATM, int QN>
__device__ __forceinline__ void attn_unit(const gb16* __restrict__ Qb, const gb16* __restrict__ Kh, const gb16* __restrict__ Vh, gb16* __restrict__ Ob,
                                          int ldq, int ldk, int ldo, int n1, int off2, int NT, char* lds, int qrow0, int kr_lo, const gf32* qg, const gf32* rope, int qtok0, int wv) {
  const int tid = tid_here(wv), wid = wv, lane = tid & 63, r32 = lane & 31, hi = lane >> 5;
  char* V_lds = lds; char* K_lds = lds + 2 * SHM_V;
  float* ws = (float*)(lds + SHM_WS) + wid * 64; float* li_l = ws; float* al_l = ws + 32;
  const float* bl = (const float*)(lds + SHM_BIAS);
  float m_reg = 0.f, l_reg = 0; f32x16 o[4] = {}; bf16x8 qr[8];
  unsigned kso[2], vso[2];
#pragma unroll
  for (int i = 0; i < 2; ++i) { const int B = i * 8 + wid;
    const int row = 4 * B + (lane >> 4); kso[i] = (unsigned)(row * ldk + (((lane & 15) ^ (row & 7)) << 3)) * 2u;
    const int S = 2 * B + (lane >> 5), kk = (S >> 2) * 8 + ((lane >> 2) & 7), kt = (kk & ~0xC) | ((kk & 4) << 1) | ((kk & 8) >> 1), c = (S & 3) * 32 + (lane & 3) * 8; vso[i] = (unsigned)(kt * ldk + c) * 2u; }
#define KROW(j) ((j) < n1 ? (j) * KVBLK : off2 + ((j) - n1) * KVBLK)
#define KDMA(b, k0) do { const GAS char* _g = (const GAS char*)Kh + (size_t)(k0) * (size_t)ldk * 2; _Pragma("unroll") for (int _i = 0; _i < 2; ++_i) \
    __builtin_amdgcn_global_load_lds((const GAS unsigned*)(_g + kso[_i]), (LAS unsigned*)(K_lds + (b) * SHM_K + (_i * 8 + wid) * 1024), 16, 0, 0); } while (0)
#define VDMA(b, k0) do { const GAS char* _g = (const GAS char*)Vh + (size_t)(k0) * (size_t)ldk * 2; _Pragma("unroll") for (int _i = 0; _i < 2; ++_i) \
    __builtin_amdgcn_global_load_lds((const GAS unsigned*)(_g + vso[_i]), (LAS unsigned*)(V_lds + (b) * SHM_V + (_i * 8 + wid) * 1024), 16, 0, 0); } while (0)
  KDMA(0, KROW(0)); VDMA(0, KROW(0)); KDMA(1, KROW(1));
  const gb16* Qw = Qb + (long)(wid * QBLK + r32) * ldq + hi * 8;
#pragma unroll
  for (int d0 = 0; d0 < 8; ++d0) qr[d0] = *(const gbf16x8*)(Qw + d0 * 16);
  if constexpr (QN != 0) {
    float ss = 0.f;
#pragma unroll
    for (int d0 = 0; d0 < 8; ++d0) { const u32x4 w = *reinterpret_cast<const u32x4*>(&qr[d0]);
      ss += (bf_lo(w.x) * bf_lo(w.x) + bf_hi(w.x) * bf_hi(w.x)) + (bf_lo(w.y) * bf_lo(w.y) + bf_hi(w.y) * bf_hi(w.y)) + (bf_lo(w.z) * bf_lo(w.z) + bf_hi(w.z) * bf_hi(w.z)) + (bf_lo(w.w) * bf_lo(w.w) + bf_hi(w.w) * bf_hi(w.w)); }
    { auto rr = __builtin_amdgcn_permlane32_swap(__float_as_uint(ss), __float_as_uint(ss), false, false); ss = __uint_as_float(rr[0]) + __uint_as_float(rr[1]); }
    const float rstd = QSCALE * __builtin_amdgcn_rsqf(ss * (1.0f / D) + NORM_EPS);
    const int tok = qtok0 + wid * QBLK + r32, pr = tok >> 6, pc = tok & 63;
#pragma unroll
    for (int d0 = 0; d0 < 8; ++d0) { const u32x4 w = *reinterpret_cast<const u32x4*>(&qr[d0]);
      const f32x4 g0 = *(const gf32x4*)(qg + d0 * 16 + hi * 8), g1 = *(const gf32x4*)(qg + d0 * 16 + hi * 8 + 4);
      float y[8] = {bf_lo(w.x) * rstd * g0.x, bf_hi(w.x) * rstd * g0.y, bf_lo(w.y) * rstd * g0.z, bf_hi(w.y) * rstd * g0.w, bf_lo(w.z) * rstd * g1.x, bf_hi(w.z) * rstd * g1.y, bf_lo(w.w) * rstd * g1.z, bf_hi(w.w) * rstd * g1.w};
      if constexpr (QN == 2) { const int pos = d0 < 4 ? pr : pc, f0 = (d0 & 3) * 8 + hi * 4;
        const f32x4 t0 = *(const gf32x4*)(rope + 2 * (pos * 32 + f0)), t1 = *(const gf32x4*)(rope + 2 * (pos * 32 + f0) + 4);
        const float a0 = y[0] * t0.x - y[1] * t0.y, b0 = y[0] * t0.y + y[1] * t0.x, a1 = y[2] * t0.z - y[3] * t0.w, b1 = y[2] * t0.w + y[3] * t0.z;
        const float a2 = y[4] * t1.x - y[5] * t1.y, b2 = y[4] * t1.y + y[5] * t1.x, a3 = y[6] * t1.z - y[7] * t1.w, b3 = y[6] * t1.w + y[7] * t1.z;
        y[0] = a0; y[1] = b0; y[2] = a1; y[3] = b1; y[4] = a2; y[5] = b2; y[6] = a3; y[7] = b3; }
      u32x4 o4; o4.x = cvtpk(y[0], y[1]); o4.y = cvtpk(y[2], y[3]); o4.z = cvtpk(y[4], y[5]); o4.w = cvtpk(y[6], y[7]); qr[d0] = *reinterpret_cast<bf16x8*>(&o4); }
  }
  const int vb0 = (int)(uintptr_t)V_lds + v_rd_base(lane);
  const int nq_row = qrow0 + (wid >> 1), nq_col = 32 * (wid & 1) + r32, nrs = min(max(nq_row - 4, 0), 56);
  const unsigned long long nwin = (0xFFFFull << min(max(nq_col - 8, 0), 48)) >> (4 * hi);
  const unsigned nmlo = (unsigned)nwin, nmhi = (unsigned)(nwin >> 32);
  const float* nbl = bl + BIAS_PAD + 15 - nq_col + 4 * hi;
#define LANDED() do { asm volatile("s_waitcnt vmcnt(0)" ::: "memory"); __syncthreads(); } while (0)
#define RESC(a) do { if (__any((a) < 1.f)) { if (hi == 0) al_l[r32] = (a); asm volatile("s_waitcnt lgkmcnt(0)" ::: "memory"); \
    _Pragma("unroll") for (int d = 0; d < 4; ++d) _Pragma("unroll") for (int r = 0; r < 16; ++r) o[d][r] *= al_l[crow(r, hi)]; } } while (0)
#define NMASK(P0, P1, j) do { if (NATM) { if ((j) >= n1) { const int _kr = kr_lo + ((j) - n1); const bool _ok = (_kr >= nrs) && (_kr < nrs + 8); const int _dr = min(max(_kr - nq_row + 7, 0), 14); \
    nat_mask(P0, P1, nbl + _dr * 31, _ok ? nmlo : 0u, _ok ? nmhi : 0u); } } } while (0)
  f32x16 pA0, pA1, pB0, pB1; float alA, alB; bf16x8 pa0, pa1, pa2, pa3;
  LANDED();
  qkt(pA0, pA1, K_lds, qr, r32, hi, 0.f); NMASK(pA0, pA1, 0); partialSM<true>(pA0, pA1, m_reg, alA);
  __syncthreads();
#define OKT(j) (!NATM || (j) < n1 || (kr_lo + ((j) - n1) >= nrs && kr_lo + ((j) - n1) < nrs + 8))
  bool okA = true, okB;
  for (int j = 1; j + 1 < NT; j += 2) {
    KDMA(0, KROW(j + 1)); VDMA(1, KROW(j));
    okB = OKT(j);
    SBAR(); if (okB) qkt(pB0, pB1, K_lds + SHM_K, qr, r32, hi, -m_reg);
    if (okA) { finishSM(pA0, pA1, alA, l_reg, pa0, pa1, pa2, pa3); SBAR();
      pv_d0(o, vb0, pa0, pa1, pa2, pa3); }
    if (okB) { NMASK(pB0, pB1, j); partialSM<false>(pB0, pB1, m_reg, alB); RESC(alB); }
    LANDED();
    if (j + 2 < NT) KDMA(1, KROW(j + 2)); VDMA(0, KROW(j + 1));
    okA = OKT(j + 1);
    SBAR(); if (okA) qkt(pA0, pA1, K_lds, qr, r32, hi, -m_reg);
    if (okB) { finishSM(pB0, pB1, alB, l_reg, pa0, pa1, pa2, pa3); SBAR();
      pv_d0(o, vb0 + SHM_V, pa0, pa1, pa2, pa3); }
    if (okA) { NMASK(pA0, pA1, j + 1); partialSM<false>(pA0, pA1, m_reg, alA); RESC(alA); }
    LANDED();
  }
  VDMA(1, KROW(NT - 1));
  okB = OKT(NT - 1);
  SBAR(); if (okB) qkt(pB0, pB1, K_lds + SHM_K, qr, r32, hi, -m_reg);
  if (okA) { finishSM(pA0, pA1, alA, l_reg, pa0, pa1, pa2, pa3); SBAR();
    pv_d0(o, vb0, pa0, pa1, pa2, pa3); }
  if (okB) { NMASK(pB0, pB1, NT - 1); partialSM<false>(pB0, pB1, m_reg, alB); RESC(alB); }
  LANDED();
  if (okB) { finishSM(pB0, pB1, alB, l_reg, pa0, pa1, pa2, pa3); SBAR();
    pv_d0(o, vb0 + SHM_V, pa0, pa1, pa2, pa3); }
  if (hi == 0) li_l[r32] = l_reg; asm volatile("s_waitcnt lgkmcnt(0)" ::: "memory");
  float rli[16];
#pragma unroll
  for (int r = 0; r < 16; ++r) rli[r] = __builtin_amdgcn_rcpf(li_l[crow(r, hi)]);
  gb16* Ow = Ob + (long)(wid * QBLK) * ldo;
  { bf16_t* stg = (bf16_t*)(lds + (wid < 4 ? 2 * SHM_V + wid * 8192 : OST_HI + (wid - 4) * 8192));
#pragma unroll
    for (int r = 0; r < 16; ++r) { const int orow = crow(r, hi);
#pragma unroll
      for (int d0 = 0; d0 < 4; ++d0) { const unsigned pk = cvtpk(o[d0][r] * rli[r], 0.f); stg[orow * 128 + d0 * 32 + r32] = (bf16_t)(pk & 0xffffu); } }
    asm volatile("s_waitcnt lgkmcnt(0)" ::: "memory");
#pragma unroll
    for (int i = 0; i < 8; ++i) { const int row = i * 4 + (lane >> 4), ch = lane & 15; const u32x4 v = *(const u32x4*)(stg + row * 128 + ch * 8); *(gu32x4*)(Ow + (long)row * ldo + ch * 8) = v; } }
#undef OKT
#undef KROW
#undef KDMA
#undef VDMA
#undef LANDED
#undef RESC
#undef NMASK
}
}

constexpr size_t MiB = 1u << 20;
constexpr size_t WS_CTL = 0, CTL_ZERO_BYTES = 2 * MiB;
constexpr size_t WS_STATS = 64 * 1024;
constexpr size_t WS_BUP = 384 * 1024;
constexpr size_t WS_BQKV = 912 * 1024;
constexpr size_t WS_ADA = 2 * MiB;
constexpr size_t WS_ROPE = 3 * MiB;
constexpr size_t WS_XS = 4 * MiB;
constexpr size_t WS_H = 72 * MiB;
constexpr size_t WS_PO = 106 * MiB;
constexpr size_t WS_Q = 140 * MiB, WS_K = 174 * MiB, WS_V = 208 * MiB;
constexpr size_t WS_U = 242 * MiB;
constexpr size_t WS_W13 = 336 * MiB;
constexpr size_t WS_W2 = 512 * MiB;
constexpr size_t WS_PW = 600 * MiB;
constexpr size_t WS_GQKV = 604 * MiB, WS_GWO = 616 * MiB, WS_NQKV = 624 * MiB, WS_NWO = 648 * MiB, WS_END = 656 * MiB;
static_assert(WS_STATS + (size_t)9 * MROWS * 4 <= WS_BUP && WS_BUP + (size_t)4 * 3 * 2 * FF * 4 <= WS_BQKV && WS_BQKV + (size_t)2 * 3 * 6144 * 4 <= CTL_ZERO_BYTES, "ctl map");
static_assert(WS_XS + (size_t)MROWS * DM * 4 <= WS_H && WS_U + (size_t)MROWS * FF * 2 <= WS_W13 && WS_W13 + (size_t)4 * 2 * FF * DM * 2 <= WS_W2 && WS_W2 + (size_t)4 * DM * FF * 2 <= WS_PW, "ws map");
constexpr size_t CTL_FINAL_CNT = 49152;
constexpr size_t CTL_SPLIT_FLAGS2 = 0;
constexpr size_t CTL_SPLIT_FLAGS = 32768;
constexpr int CW_BAR = 4096;

constexpr int RING_BYTES = 131072, LDSCTL_OFF = RING_BYTES, MISC_OFF = LDSCTL_OFF + 320, STRIP_OFF = LDSCTL_OFF + 4096  , PF_OFF = 139264  , XK_OFF = 155648  , LDS_BYTES = 163840;

#define XB_TMO      128
#define XB_XCNT(j)  (256  + 64 * (j))
#define XB_XSUB(j)  (1280 + 64 * (j))
#define XB_XGEN(j)  (2304 + 64 * (j))
#define XB_TOP      3328
#define XB_TOPGEN   3392
#define XCD_BAR_WORDS 3456
#define XB_SPIN_CAP (1u << 18)
__device__ __forceinline__ unsigned xb_ld(unsigned* p)              { return __hip_atomic_load(p, __ATOMIC_RELAXED, __HIP_MEMORY_SCOPE_AGENT); }
__device__ __forceinline__ unsigned xb_add(unsigned* p, unsigned v) { return __hip_atomic_fetch_add(p, v, __ATOMIC_RELAXED, __HIP_MEMORY_SCOPE_AGENT); }
__device__ __forceinline__ unsigned xb_xcc_id() { return (unsigned)__builtin_amdgcn_s_getreg((3 << 11) | 20) & 0xFu; }
#define XB_SPIN(cond, bar) do { unsigned _sp = 0; while (cond) { __builtin_amdgcn_s_sleep(1); \
    if ((++_sp & 255u) == 0u) { if (xb_ld(&(bar)[XB_TMO])) break; if (_sp > XB_SPIN_CAP) { atomicAdd(&(bar)[XB_TMO], 1u); break; } } } } while (0)
struct XcdBarrier { unsigned* bar; unsigned x; volatile LAS unsigned* st; };
__device__ __forceinline__ XcdBarrier xcd_barrier_post(unsigned* bar, volatile LAS unsigned* st) {
    XcdBarrier b; b.bar = bar; b.x = xb_xcc_id(); b.st = st;
    if (threadIdx.x == 0) (void)xb_add(&bar[XB_XCNT(b.x)], 1u);
    return b;
}
__device__ __forceinline__ void xcd_barrier_complete(unsigned* bar, unsigned x, unsigned& nloc, unsigned& nx) {
    const unsigned G = gridDim.x * gridDim.y * gridDim.z;
    unsigned sum, cnt, mine, sp = 0u;
    for (;;) {
        sum = 0u; cnt = 0u; mine = 0u;
#pragma unroll
        for (unsigned j = 0; j < 16; ++j) { const unsigned c = xb_ld(&bar[XB_XCNT(j)]); sum += c; cnt += (c > 0u) ? 1u : 0u; mine = (j == x) ? c : mine; }
        if (sum == G) break;
        __builtin_amdgcn_s_sleep(1);
        if ((++sp & 255u) == 0u) { if (xb_ld(&bar[XB_TMO])) break; if (sp > XB_SPIN_CAP) { atomicAdd(&bar[XB_TMO], 1u); break; } }
    }
    nloc = mine > 0u ? mine : 1u; nx = cnt > 0u ? cnt : 1u;
}
__device__ __forceinline__ void xcd_barrier(const XcdBarrier& b, int tid) {
    asm volatile("s_waitcnt vmcnt(0)" ::: "memory");
    __syncthreads();
    if (tid == 0) {
        unsigned* bar = b.bar;
        __builtin_amdgcn_s_waitcnt(0);
        unsigned nloc = b.st[0], nx = b.st[1];
        if (nloc == 0u) { xcd_barrier_complete(bar, b.x, nloc, nx); b.st[0] = nloc; b.st[1] = nx; }
        const unsigned old = xb_add(&bar[XB_XSUB(b.x)], 1u);
        const unsigned gen = old / nloc;
        if (old + 1u == (gen + 1u) * nloc) {
            __builtin_amdgcn_fence(__ATOMIC_RELEASE, "agent");
            asm volatile("s_waitcnt vmcnt(0)" ::: "memory");
            const unsigned og = xb_add(&bar[XB_TOP], 1u);
            const unsigned tg = og / nx;
            if (og + 1u == (tg + 1u) * nx) xb_add(&bar[XB_TOPGEN], 1u);
            else XB_SPIN(xb_ld(&bar[XB_TOPGEN]) == tg, bar);
            __builtin_amdgcn_fence(__ATOMIC_ACQUIRE, "agent");
            xb_add(&bar[XB_XGEN(b.x)], 1u);
            asm volatile("s_waitcnt vmcnt(0)" ::: "memory");
        } else {
            XB_SPIN(xb_ld(&bar[XB_XGEN(b.x)]) == gen, bar);
            __builtin_amdgcn_fence(__ATOMIC_ACQUIRE, "agent");
            asm volatile("s_waitcnt vmcnt(0)" ::: "memory");
        }
    }
    __syncthreads();
}

struct Frame { LAS unsigned char* lds; GAS unsigned char* ws; gf32* out; int tid, lane, wave, vcu, G, bid; };
enum { I_X = 0, I_C, I_CTX, I_CCTX, I_ADAW, I_ADAB, I_NORMG, I_W1, I_W3, I_W2, I_POOLW, I_POOLLS, I_GWQ, I_GWK, I_GWV, I_GWO, I_GQN, I_GKN, I_NWQ, I_NWK, I_NWV, I_NWO, I_RPB, I_FINALG, I_COUNT };
constexpr int PTR_OFF = LDSCTL_OFF + 1024;
__device__ __forceinline__ const gf32* inp(const Frame& F, int k) {
    const unsigned long long v = ((volatile LAS unsigned long long*)(F.lds + PTR_OFF))[k];
    const unsigned lo = __builtin_amdgcn_readfirstlane((unsigned)v), hi = __builtin_amdgcn_readfirstlane((unsigned)(v >> 32));
    return (const gf32*)(((unsigned long long)hi << 32) | lo);
}
#define WSF(off) ((gf32*)(F.ws + (off)))
#define WSB(off) ((gb16*)(F.ws + (off)))
#define WSH(off) ((gh16*)(F.ws + (off)))

struct TrItem { const gf32* src; gb16* dst; int N, K, k0, n0, drow0; const gf32* sh; gf32* bias; int nb; };
__device__ __forceinline__ void tr_load(const TrItem& d, int ks, f32x4 (&a)[8], f32x4 (&b)[8], int lane) {
    const int q = lane >> 4, c = lane & 15;
#pragma unroll
    for (int it = 0; it < 8; ++it) { const int k = ks * 64 + 8 * it + 2 * q;
        a[it] = __builtin_nontemporal_load((const gf32x4*)(d.src + (size_t)(d.k0 + k) * d.N + d.n0 + 4 * c)); b[it] = __builtin_nontemporal_load((const gf32x4*)(d.src + (size_t)(d.k0 + k + 1) * d.N + d.n0 + 4 * c)); }
}
__device__ __forceinline__ void tr_half(const TrItem& d, int ks, const f32x4 (&a)[8], const f32x4 (&b)[8], LAS unsigned char* T, LAS float* SH, int lane) {
    const int q = lane >> 4, c = lane & 15;
    if (d.sh) {
        const gf32* shp = d.sh + ks * 64;
        SH[lane] = shp[lane]; SH[64 + lane] = shp[6 * DM + lane]; SH[128 + lane] = shp[12 * DM + lane];
        LDS_WAIT(); asm volatile("" ::: "memory");
        f32x4 p0 = {0.f, 0.f, 0.f, 0.f}, p1 = p0, p2 = p0;
#pragma unroll
        for (int it = 0; it < 8; ++it) { const f32x2 s0 = *(const LAS f32x2*)(SH + 8 * it + 2 * q), s1 = *(const LAS f32x2*)(SH + 64 + 8 * it + 2 * q), s2 = *(const LAS f32x2*)(SH + 128 + 8 * it + 2 * q);
            p0 += a[it] * s0.x + b[it] * s0.y; p1 += a[it] * s1.x + b[it] * s1.y; p2 += a[it] * s2.x + b[it] * s2.y; }
#pragma unroll
        for (int i = 0; i < 4; ++i) { p0[i] += __shfl_xor(p0[i], 16); p0[i] += __shfl_xor(p0[i], 32); p1[i] += __shfl_xor(p1[i], 16); p1[i] += __shfl_xor(p1[i], 32); p2[i] += __shfl_xor(p2[i], 16); p2[i] += __shfl_xor(p2[i], 32); }
        const float v0 = q == 0 ? p0[0] : q == 1 ? p0[1] : q == 2 ? p0[2] : p0[3], v1 = q == 0 ? p1[0] : q == 1 ? p1[1] : q == 2 ? p1[2] : p1[3], v2 = q == 0 ? p2[0] : q == 1 ? p2[1] : q == 2 ? p2[2] : p2[3];
        gf32* bp = d.bias + d.drow0 + 4 * c + q;
        pg8::atomic_add_f32(bp, v0); pg8::atomic_add_f32(bp + d.nb, v1); pg8::atomic_add_f32(bp + 2 * d.nb, v2);
        asm volatile("" ::: "memory");
    }
#pragma unroll
    for (int it = 0; it < 8; ++it) {
#pragma unroll
        for (int i = 0; i < 4; ++i) { const int n = 4 * c + i; const int byte = n * 256 + (((ks * 8 + it) ^ c) << 4) + q * 4;
            *(LAS unsigned*)(T + byte) = cvt_pk_bf16(a[it][i], b[it][i]); } }
}
__device__ __forceinline__ void tr_flush(const TrItem& d, LAS unsigned char* T, int lane) {
    LDS_WAIT(); asm volatile("" ::: "memory");
#pragma unroll
    for (int it2 = 0; it2 < 16; ++it2) { const int n = 4 * it2 + (lane >> 4), j = lane & 15;
        const u32x4 v = *(const LAS u32x4*)(T + n * 256 + ((j ^ ((n >> 2) & 15)) << 4));
        *(gu32x4*)(d.dst + (size_t)(d.drow0 + n) * d.K + d.k0 + 8 * j) = v; }
    LDS_WAIT(); asm volatile("" ::: "memory");
}
constexpr int TR_I_FF = (DM / 128) * (FF / 64);
constexpr int TR_N_FFN = 12 * TR_I_FF, TR_N_POOL = 8 * 32, TR_N_G = 512 + 128 + 128 + 512, TR_N_N = 4 * 512, TR_NITEMS = TR_N_FFN + TR_N_POOL + TR_N_G + TR_N_N;
__device__ __forceinline__ TrItem tr_decode(Frame& F, int it) {
    TrItem d; int r = it; d.sh = nullptr; d.bias = nullptr; d.nb = 0;
    if (r < TR_N_FFN) { const int m = r / TR_I_FF, rr = r % TR_I_FF, l = m / 3, wch = m % 3;
        if (wch < 2) { const int kb = rr / 88, nb = rr % 88, n0 = nb * 64;
            d.src = inp(F, wch == 0 ? I_W1 : I_W3) + (size_t)l * DM * FF; d.N = FF; d.dst = WSB(WS_W13) + (size_t)l * 2 * FF * DM; d.K = DM; d.k0 = kb * 128; d.n0 = n0; d.drow0 = (n0 / 128) * 256 + (n0 % 128) + wch * 128;
            d.sh = WSF(WS_ADA) + (size_t)(l * 3 * 6 + 3) * DM + d.k0; d.bias = WSF(WS_BUP) + (size_t)l * 3 * 2 * FF; d.nb = 2 * FF; }
        else { const int kb = rr / 32, nb = rr % 32;
            d.src = inp(F, I_W2) + (size_t)l * FF * DM; d.N = DM; d.dst = WSB(WS_W2) + (size_t)l * DM * FF; d.K = FF; d.k0 = kb * 128; d.n0 = nb * 64; d.drow0 = nb * 64; }
        return d; }
    r -= TR_N_FFN;
    if (r < TR_N_POOL) { const int jg = r / 32, rr = r % 32, j = jg / 4, gg = jg % 4, kb = rr / 8, nb = rr % 8;
        d.src = inp(F, I_POOLW) + (size_t)jg * 512 * 512; d.N = 512; d.dst = WSB(WS_PW) + (size_t)j * DM * 512; d.K = 512; d.k0 = kb * 128; d.n0 = nb * 64; d.drow0 = gg * 512 + nb * 64; return d; }
    r -= TR_N_POOL;
    if (r < TR_N_G) {
        if (r < 512) { d.src = inp(F, I_GWQ); d.N = DM; d.dst = WSB(WS_GQKV); d.K = DM; d.k0 = (r / 32) * 128; d.n0 = (r % 32) * 64; d.drow0 = d.n0; d.sh = WSF(WS_ADA) + (size_t)(1 * 3 * 6) * DM + d.k0; d.bias = WSF(WS_BQKV); d.nb = 6144; return d; } r -= 512;
        if (r < 128) { d.src = inp(F, I_GWK); d.N = 512; d.dst = WSB(WS_GQKV); d.K = DM; d.k0 = (r / 8) * 128; d.n0 = (r % 8) * 64; d.drow0 = 2048 + d.n0; d.sh = WSF(WS_ADA) + (size_t)(1 * 3 * 6) * DM + d.k0; d.bias = WSF(WS_BQKV); d.nb = 6144; return d; } r -= 128;
        if (r < 128) { d.src = inp(F, I_GWV); d.N = 512; d.dst = WSB(WS_GQKV); d.K = DM; d.k0 = (r / 8) * 128; d.n0 = (r % 8) * 64; d.drow0 = 2560 + d.n0; d.sh = WSF(WS_ADA) + (size_t)(1 * 3 * 6) * DM + d.k0; d.bias = WSF(WS_BQKV); d.nb = 6144; return d; } r -= 128;
        d.src = inp(F, I_GWO); d.N = DM; d.dst = WSB(WS_GWO); d.K = DM; d.k0 = (r / 32) * 128; d.n0 = (r % 32) * 64; d.drow0 = d.n0; return d; }
    r -= TR_N_G;
    { const int which = r / 512, rr = r % 512; d.N = DM; d.K = DM; d.k0 = (rr / 32) * 128; d.n0 = (rr % 32) * 64;
      if (which == 0) { d.src = inp(F, I_NWQ); d.dst = WSB(WS_NQKV); d.drow0 = d.n0; }
      else if (which == 1) { d.src = inp(F, I_NWK); d.dst = WSB(WS_NQKV); d.drow0 = 2048 + d.n0; }
      else if (which == 2) { d.src = inp(F, I_NWV); d.dst = WSB(WS_NQKV); d.drow0 = 4096 + d.n0; }
      else { d.src = inp(F, I_NWO); d.dst = WSB(WS_NWO); d.drow0 = d.n0; }
      if (which < 3) { d.sh = WSF(WS_ADA) + (size_t)(2 * 3 * 6) * DM + d.k0; d.bias = WSF(WS_BQKV) + (size_t)3 * 6144; d.nb = 6144; } }
    return d;
}

__device__ __forceinline__ void p0a_prologue(Frame& F) {
    {
        const gf32* cvec = inp(F, I_C); const gf32* cctx = inp(F, I_CCTX); const gf32* ada_w = inp(F, I_ADAW); const gf32* ada_b = inp(F, I_ADAB); gf32* ada = WSF(WS_ADA);
        LAS float* S = (LAS float*)(F.lds);
        LAS float* red0 = (LAS float*)(F.lds + 24576);
        int rpar = 0;
        for (int i = F.tid; i < 3 * DM; i += 512) { const int v = i / DM, k = i % DM; const float cv = v < 2 ? cvec[v * DM + k] : cctx[k]; S[i] = cv / (1.0f + __expf(-cv)); }
        __syncthreads();
        const int kq = F.lane >> 4, cq = F.lane & 15;
        for (int u = F.bid; u < DEPTH * 192; u += F.G) {
            const int l = u / 192, n0 = (u % 192) * 64;
            const gf32* Wp = ada_w + (size_t)l * DM * 6 * DM + n0 + 4 * cq;
            f32x4 a0 = {0.f, 0.f, 0.f, 0.f}, a1 = a0, a2 = a0;
            f32x4 wA[8], wB[8];
            const int kb0 = F.wave * 256 + kq;
#define ADA_LD(dst, g) do { _Pragma("unroll") for (int i = 0; i < 8; ++i) dst[i] = __builtin_nontemporal_load((const gf32x4*)(Wp + (size_t)(kb0 + 4 * (8 * (g) + i)) * (6 * DM))); } while (0)
#define ADA_FMA(src, g) do { _Pragma("unroll") for (int i = 0; i < 8; ++i) { const int k = kb0 + 4 * (8 * (g) + i); a0 += src[i] * S[k]; a1 += src[i] * S[DM + k]; a2 += src[i] * S[2 * DM + k]; } } while (0)
            ADA_LD(wA, 0);
#pragma unroll 1
            for (int g = 0; g < 8; g += 2) { ADA_LD(wB, g + 1); ADA_FMA(wA, g); if (g + 2 < 8) ADA_LD(wA, g + 2); ADA_FMA(wB, g + 1); }
#undef ADA_LD
#undef ADA_FMA
#pragma unroll
            for (int i = 0; i < 4; ++i) { a0[i] += __shfl_xor(a0[i], 16); a0[i] += __shfl_xor(a0[i], 32); a1[i] += __shfl_xor(a1[i], 16); a1[i] += __shfl_xor(a1[i], 32); a2[i] += __shfl_xor(a2[i], 16); a2[i] += __shfl_xor(a2[i], 32); }
            LAS float* red = red0 + rpar * 1536; rpar ^= 1;
            if (kq == 0) {
#pragma unroll
                for (int i = 0; i < 4; ++i) { red[(F.wave * 3 + 0) * 64 + 4 * cq + i] = a0[i]; red[(F.wave * 3 + 1) * 64 + 4 * cq + i] = a1[i]; red[(F.wave * 3 + 2) * 64 + 4 * cq + i] = a2[i]; } }
            __syncthreads();
            if (F.tid < 192) { const int v = F.tid / 64, cc = F.tid % 64; float s = ada_b[l * 6 * DM + n0 + cc];
#pragma unroll
                for (int w = 0; w < 8; ++w) s += red[(w * 3 + v) * 64 + cc];
                ada[(size_t)(l * 3 + v) * 6 * DM + n0 + cc] = s; }
        }
    }
    {
        const size_t gt = (size_t)F.bid * 512 + F.tid, NT = (size_t)F.G * 512;
        gf32* rope = WSF(WS_ROPE);
        for (size_t i = gt; i < 64 * 32; i += NT) { const int p = (int)i / 32, j = (int)i % 32; const float inv = powf(10000.0f, -(float)(2 * j) / 64.0f); const float ang = (float)p * inv;
            rope[2 * i] = cosf(ang); rope[2 * i + 1] = sinf(ang); }
    }
}
__device__ __forceinline__ void p0b_prologue(Frame& F) {
    const int gw = F.vcu * 8 + F.wave, NGW = F.G * 8;
    {
        LAS unsigned char* T = F.lds + F.wave * 16384; LAS float* SH = (LAS float*)(F.lds + 139264 + F.wave * 1024);
        for (int it = gw; it < TR_NITEMS; it += NGW) {
            const TrItem d = tr_decode(F, it);
            f32x4 a0[8], b0[8], a1[8], b1[8];
            tr_load(d, 0, a0, b0, F.lane); tr_load(d, 1, a1, b1, F.lane);
            tr_half(d, 0, a0, b0, T, SH, F.lane); tr_half(d, 1, a1, b1, T, SH, F.lane);
            tr_flush(d, T, F.lane);
        }
    }
    {
        const gf32* g = inp(F, I_NORMG); const gf32* xin = inp(F, I_X); const gf32* cin = inp(F, I_CTX); const gf32* adab = WSF(WS_ADA); gb16* H = WSB(WS_H); gf32* stats = WSF(WS_STATS);
        const int gwb = F.bid * 8 + F.wave;
        for (int row = gwb; row < MROWS; row += NGW) {
            const int b = row / RB, rr = row % RB, vec = rr < CTXL ? 2 : b;
            const gf32* sc = adab + (size_t)(vec * 6 + 1) * DM;
            const gf32* xrow = rr < CTXL ? cin + ((size_t)b * CTXL + rr) * DM : xin + ((size_t)b * SEQ + (rr - CTXL)) * DM;
            const gf32x4* xr = (const gf32x4*)xrow + F.lane;
            f32x4 v[8]; float ss = 0.f;
#pragma unroll
            for (int j = 0; j < 8; ++j) { v[j] = xr[64 * j]; ss += (v[j].x * v[j].x + v[j].y * v[j].y) + (v[j].z * v[j].z + v[j].w * v[j].w); }
            ss = wave_sum(ss); if (F.lane == 0) stats[row] = ss;
            gu32x2* x8 = (gu32x2*)(WSH(WS_XS) + (size_t)row * DM) + F.lane;
#pragma unroll
            for (int j = 0; j < 8; ++j) {
                u32x2 xw; xw.x = pk_h16(v[j].x, v[j].y); xw.y = pk_h16(v[j].z, v[j].w); x8[64 * j] = xw; }
        }
    }
}

constexpr int POOL_R = 18, POOL_RL = (SEQ + POOL_R - 1) / POOL_R, POOL_RC = (CTXL + POOL_R - 1) / POOL_R;
template <int HW>
__device__ __forceinline__ void pool_task(const gh16* __restrict__ H, gb16* __restrict__ PO, const gf32* __restrict__ stats, const gf32* __restrict__ gng, const gf32* __restrict__ gsc, int seq0, int n, int t0, int len, int c, int lane) {
    constexpr int NR = POOL_R + 2 * HW;
    const unsigned colb = (unsigned)(c * 64 + lane) * 16u;
    u32x4 v[NR];
#pragma unroll
    for (int i = 0; i < NR; ++i) { const int tt = min(max(t0 - HW + i, 0), n - 1);
        const GAS char* rb = (const GAS char*)(H + (size_t)(seq0 + tt) * DM);
        asm volatile("s_nop 4\n\tglobal_load_dwordx4 %0, %1, %2" : "=v"(v[i]) : "v"(colb), "s"(rb) : "memory"); }
    asm volatile("s_waitcnt vmcnt(0)" ::: "memory");
#pragma unroll
    for (int i = 0; i < NR; ++i) asm volatile("" : "+v"(v[i]));
    float rl = 0.f;
    { const int tt = t0 - HW + lane; if (lane < NR && tt >= 0 && tt < n) rl = pg8::rstd_of(stats[seq0 + tt]); }
    float gmv[8];
    { const f32x4 g0 = *(const gf32x4*)(gng + c * 512 + lane * 8), g1 = *(const gf32x4*)(gng + c * 512 + lane * 8 + 4), s0 = *(const gf32x4*)(gsc + c * 512 + lane * 8), s1 = *(const gf32x4*)(gsc + c * 512 + lane * 8 + 4);
      gmv[0] = g0.x * (s0.x + 1.0f); gmv[1] = g0.y * (s0.y + 1.0f); gmv[2] = g0.z * (s0.z + 1.0f); gmv[3] = g0.w * (s0.w + 1.0f); gmv[4] = g1.x * (s1.x + 1.0f); gmv[5] = g1.y * (s1.y + 1.0f); gmv[6] = g1.z * (s1.z + 1.0f); gmv[7] = g1.w * (s1.w + 1.0f); }
    float a[8];
#pragma unroll
    for (int e = 0; e < 8; ++e) a[e] = 0.f;
#define POOL_ACC(i, sgn) do { const float _r = (sgn) * __uint_as_float(__builtin_amdgcn_readlane(__float_as_uint(rl), (i))); u32x4 _t = v[i]; asm volatile("" : "+v"(_t)); a[0] += _r * h16_lo(_t.x); a[1] += _r * h16_hi(_t.x); a[2] += _r * h16_lo(_t.y); a[3] += _r * h16_hi(_t.y); \
        a[4] += _r * h16_lo(_t.z); a[5] += _r * h16_hi(_t.z); a[6] += _r * h16_lo(_t.w); a[7] += _r * h16_hi(_t.w); } while (0)
#pragma unroll
    for (int i = 0; i < 2 * HW; ++i) POOL_ACC(i, 1.0f);
#pragma unroll
    for (int k = 0; k < POOL_R; ++k) {
        if (k < len) { const int t = t0 + k; const int lo = max(t - HW, 0), hi = min(t + HW, n); const float rc = __builtin_amdgcn_rcpf((float)(hi - lo)), ro = __uint_as_float(__builtin_amdgcn_readlane(__float_as_uint(rl), k + HW));
            u32x4 own = v[k + HW]; asm volatile("" : "+v"(own));
            u32x4 w; w.x = cvt_pk_bf16((a[0] * rc - ro * h16_lo(own.x)) * gmv[0], (a[1] * rc - ro * h16_hi(own.x)) * gmv[1]); w.y = cvt_pk_bf16((a[2] * rc - ro * h16_lo(own.y)) * gmv[2], (a[3] * rc - ro * h16_hi(own.y)) * gmv[3]);
            w.z = cvt_pk_bf16((a[4] * rc - ro * h16_lo(own.z)) * gmv[4], (a[5] * rc - ro * h16_hi(own.z)) * gmv[5]); w.w = cvt_pk_bf16((a[6] * rc - ro * h16_lo(own.w)) * gmv[6], (a[7] * rc - ro * h16_hi(own.w)) * gmv[7]);
            GAS char* ob = (GAS char*)(PO + (size_t)(seq0 + t) * DM); asm volatile("s_nop 4\n\tglobal_store_dwordx4 %0, %1, %2\n\ts_nop 1" :: "v"(colb), "v"(w), "s"(ob) : "memory"); }
        if (k + 1 < POOL_R) { POOL_ACC(k + 2 * HW, 1.0f); POOL_ACC(k, -1.0f); }
    }
#undef POOL_ACC
}
__device__ __forceinline__ void phase_pool(Frame& F, const gf32* stats, bool lat_only, int layer) {
    const gh16* H = WSH(WS_XS); gb16* PO = WSB(WS_PO);
    const gf32* gng = inp(F, I_NORMG) + (size_t)(layer * 2) * DM; const gf32* ada1 = WSF(WS_ADA) + (size_t)layer * 3 * 6 * DM + DM;
    const int gw = F.bid * 8 + F.wave, NGW = F.G * 8;
    const int ntask = (2 * POOL_RL + (lat_only ? 0 : 2 * POOL_RC)) * 4;
    for (int task = gw; task < ntask; task += NGW) {
        const int c = task & 3; int ridx = task >> 2; int seq0, n, t0;
        int vec;
        if (ridx < 2 * POOL_RL) { const int b = ridx / POOL_RL; seq0 = b * RB + CTXL; n = SEQ; t0 = (ridx % POOL_RL) * POOL_R; vec = b; }
        else { ridx -= 2 * POOL_RL; const int b = ridx / POOL_RC; seq0 = b * RB; n = CTXL; t0 = (ridx % POOL_RC) * POOL_R; vec = 2; }
        const gf32* gsc = ada1 + (size_t)vec * 6 * DM;
        const int len = min(POOL_R, n - t0);
        int ln = F.lane; asm volatile("" : "+v"(ln));
        if (c == 0) pool_task<1>(H, PO, stats, gng, gsc, seq0, n, t0, len, c, ln);
        else if (c == 1) pool_task<2>(H, PO, stats, gng, gsc, seq0, n, t0, len, c, ln);
        else if (c == 2) pool_task<4>(H, PO, stats, gng, gsc, seq0, n, t0, len, c, ln);
        else pool_task<8>(H, PO, stats, gng, gsc, seq0, n, t0, len, c, ln);
    }
}
__device__ __forceinline__ void phase_krope(Frame& F) {
    const int gw = F.bid * 8 + F.wave, NGW = F.G * 8;
    const f32x2 gk = *(const gf32x2*)(inp(F, I_GKN) + 2 * F.lane);
    gb16* Kp = WSB(WS_K); const gf32* rope = WSF(WS_ROPE);
    for (int row = gw; row < MROWS; row += NGW) {
        const int rr = row % RB; const bool lat = rr >= CTXL; const int t = rr - CTXL;
        float cs = 1.f, sn = 0.f;
        if (lat) { const int pos = F.lane < 32 ? (t >> 6) : (t & 63); const f32x2 r2 = *(const gf32x2*)(rope + 2 * (pos * 32 + (F.lane & 31))); cs = r2.x; sn = r2.y; }
        unsigned u[KVH];
#pragma unroll
        for (int hh = 0; hh < KVH; ++hh) u[hh] = *((const gu32*)(Kp + (size_t)row * 512 + hh * HD) + F.lane);
#pragma unroll
        for (int hh = 0; hh < KVH; ++hh) { const float x1 = bf_lo(u[hh]), x2 = bf_hi(u[hh]);
            const float rstd = __builtin_amdgcn_rsqf(wave_sum(x1 * x1 + x2 * x2) * (1.0f / HD) + NORM_EPS);
            const float y1 = x1 * rstd * gk.x, y2 = x2 * rstd * gk.y;
            *((gu32*)(Kp + (size_t)row * 512 + hh * HD) + F.lane) = cvt_pk_bf16(y1 * cs - y2 * sn, y1 * sn + y2 * cs); }
    }
}
__device__ __forceinline__ void phase_final(Frame& F) {
    const gh16* xs = WSH(WS_XS); const gf32* fg = inp(F, I_FINALG);
    const int gw = F.bid * 8 + F.wave, NGW = F.G * 8;
    for (int r = gw; r < NB * SEQ; r += NGW) {
        const int b = r / SEQ, t = r % SEQ; const int row = b * RB + CTXL + t;
        const gu32x4* xr = (const gu32x4*)(xs + (size_t)row * DM) + F.lane;
        f32x4 v[8]; float s = 0.f;
#pragma unroll
        for (int j = 0; j < 4; ++j) { const u32x4 h = xr[64 * j]; v[2 * j] = (f32x4){h16_lo(h.x), h16_hi(h.x), h16_lo(h.y), h16_hi(h.y)}; v[2 * j + 1] = (f32x4){h16_lo(h.z), h16_hi(h.z), h16_lo(h.w), h16_hi(h.w)};
            s += (v[2 * j].x * v[2 * j].x + v[2 * j].y * v[2 * j].y) + (v[2 * j].z * v[2 * j].z + v[2 * j].w * v[2 * j].w) + (v[2 * j + 1].x * v[2 * j + 1].x + v[2 * j + 1].y * v[2 * j + 1].y) + (v[2 * j + 1].z * v[2 * j + 1].z + v[2 * j + 1].w * v[2 * j + 1].w); }
        const float rstd = __builtin_amdgcn_rsqf(wave_sum(s) * (1.0f / DM) + NORM_EPS);
        gf32x4* o = (gf32x4*)(F.out + (size_t)r * DM) + 2 * F.lane;
#pragma unroll
        for (int j = 0; j < 4; ++j) { const int d = (F.lane + 64 * j) * 8;
            o[128 * j] = (v[2 * j] * rstd) * *(const gf32x4*)(fg + d); o[128 * j + 1] = (v[2 * j + 1] * rstd) * *(const gf32x4*)(fg + d + 4); }
    }
}
__device__ __forceinline__ void phase_attn_gqa(Frame& F, char* lds) {
    const gb16* Q = WSB(WS_Q); const gb16* Kp = WSB(WS_K); const gb16* Vp = WSB(WS_V); gb16* PO = WSB(WS_PO); const gf32* gqn = inp(F, I_GQN); const gf32* rope = WSF(WS_ROPE);
    for (int u = F.vcu; u < 512 + 32; u += F.G) {
        __syncthreads();
        if (u < 512) { const int b = u >> 8, rem = u & 255, kvh = rem >> 6, gq = (rem >> 4) & 3, qb = rem & 15, h = kvh * 4 + gq;
            const size_t qrow = (size_t)b * RB + CTXL + (size_t)qb * 256;
            att::attn_unit<false, 2>(Q + qrow * DM + h * HD, Kp + (size_t)b * RB * 512 + kvh * HD, Vp + (size_t)b * RB * 512 + kvh * HD, PO + qrow * DM + h * HD, DM, 512, DM, RB / 64, 0, RB / 64, lds, 0, 0, gqn, rope, qb * 256, F.wave); }
        else { const int v = u - 512, b = v >> 4, h = v & 15, kvh = h >> 2; const size_t qrow = (size_t)b * RB;
            att::attn_unit<false, 1>(Q + qrow * DM + h * HD, Kp + (size_t)b * RB * 512 + kvh * HD, Vp + (size_t)b * RB * 512 + kvh * HD, PO + qrow * DM + h * HD, DM, 512, DM, CTXL / 64, 0, CTXL / 64, lds, 0, 0, gqn, rope, 0, F.wave); }
    }
}
__device__ __forceinline__ void phase_attn_nat(Frame& F, char* lds) {
    const gb16* Q = WSB(WS_Q); const gb16* Kp = WSB(WS_K); const gb16* Vp = WSB(WS_V); gb16* PO = WSB(WS_PO); const gf32* rpb = inp(F, I_RPB);
    for (int u = F.vcu; u < 512; u += F.G) {
        __syncthreads();
        { const int b = u >> 8, h = (u >> 4) & 15, qb = u & 15, r0 = 4 * qb;
            const int kr_lo = min(max(r0 - 4, 0), 56), kr_hi = min(max(r0 + 3 - 4, 0), 56) + 8; int n2 = kr_hi - kr_lo; n2 += (n2 & 1);
            { int bt = F.tid; asm volatile("" : "+v"(bt));
              if (bt < att::NBIAS) ((float*)(lds + att::SHM_BIAS))[att::BIAS_PAD + bt] = rpb[h * att::NBIAS + bt] * 1.4426950408889634f; }
            const size_t qrow = (size_t)b * RB + CTXL + (size_t)qb * 256;
            att::attn_unit<true, 0>(Q + qrow * DM + h * HD, Kp + (size_t)b * RB * DM + h * HD, Vp + (size_t)b * RB * DM + h * HD, PO + qrow * DM + h * HD, DM, DM, DM, CTXL / 64, CTXL + kr_lo * 64, CTXL / 64 + n2, lds, r0, kr_lo, nullptr, nullptr, 0, F.wave); }
    }
    int v, vstep;
    if (F.G == 256) { const int e = F.vcu & 15; v = (e == 0 || e == 15) ? (F.vcu >> 4) * 2 + (e == 15 ? 1 : 0) : 32; vstep = 32; } else { v = F.vcu; vstep = F.G; }
    for (; v < 32; v += vstep) {
        __syncthreads();
        const int b = v >> 4, h = v & 15; const size_t qrow = (size_t)b * RB;
        att::attn_unit<false, 0>(Q + qrow * DM + h * HD, Kp + (size_t)b * RB * DM + h * HD, Vp + (size_t)b * RB * DM + h * HD, PO + qrow * DM + h * HD, DM, DM, DM, CTXL / 64, 0, CTXL / 64, lds, 0, 0, nullptr, nullptr, 0, F.wave);
    }
}

struct Args { const float* in[24]; float* out; unsigned char* ws; int gp_lo, gp_hi; };
static_assert(sizeof(Args) == 24 * 8 + 8 + 8 + 8, "Args has no padding");
constexpr int GP_END = 35;

__global__ void __launch_bounds__(512, 2) fwd_kernel(Args args) {
    extern __shared__ __attribute__((aligned(16))) unsigned char lds[];
    Frame F;
    F.lds = (LAS unsigned char*)lds;
    F.tid = threadIdx.x; F.lane = F.tid & 63; F.wave = __builtin_amdgcn_readfirstlane(F.tid >> 6);
    F.G = gridDim.x; { const int bx = blockIdx.x; F.vcu = (F.G % 8 == 0) ? (bx % 8) * (F.G / 8) + bx / 8 : bx; }
    F.out = (gf32*)args.out; F.ws = (GAS unsigned char*)args.ws;
    unsigned char* ws = args.ws;
    for (int u = F.tid; u < (LDS_BYTES - LDSCTL_OFF) / 4; u += 512) ((LAS unsigned*)(F.lds + LDSCTL_OFF))[u] = 0u;
    __syncthreads();
    if (F.tid < I_COUNT) ((LAS unsigned long long*)(F.lds + PTR_OFF))[F.tid] = ((const unsigned long long*)__builtin_amdgcn_kernarg_segment_ptr())[F.tid];
    __syncthreads();
    const int lo = args.gp_lo, hi = args.gp_hi;
    unsigned* barw = (unsigned*)(ws + WS_CTL) + CW_BAR;
    XcdBarrier bar; bar.bar = barw; bar.x = 0; bar.st = nullptr;
    if (hi - lo > 1) bar = xcd_barrier_post(barw, (volatile LAS unsigned*)(F.lds + MISC_OFF) + 8);
    bool first = true;
#define PH_BEGIN(gp) if (lo <= (gp) && (gp) < hi) { if (!first) xcd_barrier(bar, tid_here(F.wave)); first = false; F.bid = blockIdx.x; asm volatile("" : "+s"(F.ws), "+s"(F.G), "+s"(F.vcu), "+s"(F.bid), "+s"(F.wave)); F.tid = tid_here(F.wave); F.lane = F.tid & 63;
#define PH_END }
    constexpr bool AL = true, SP = true;

    PH_BEGIN(0) if (EN & 1) p0a_prologue(F); PH_END
    PH_BEGIN(1) if (EN & 1) p0b_prologue(F); PH_END

    for (int layer = 0; layer < DEPTH; ++layer) {
        const int kind = layer % 3, j = layer / 3, gp0 = 2 + 8 * layer;
        const bool need_ctx = layer < DEPTH - 1;
        const gf32* ada_l = WSF(WS_ADA) + (size_t)layer * 3 * 6 * DM;
        gf32* st1 = WSF(WS_STATS) + (size_t)(2 * layer) * MROWS;
        gf32* st2 = st1 + MROWS;
        if (kind == 0) {
            PH_BEGIN(gp0 + 1) if (EN & 4) phase_pool(F, st1, !need_ctx, layer); PH_END
            PH_BEGIN(gp0 + 2) if (EN & 8) {
                pg8::Gemm g{WSB(WS_PO), WSB(WS_PW) + (size_t)j * DM * 512, MROWS, DM, 512, DM, 2};
                pg8::EpiRes E{WSH(WS_XS), WSH(WS_XS), ada_l, 2, inp(F, I_POOLLS) + (size_t)j * DM, WSB(WS_H), inp(F, I_NORMG) + (size_t)(layer * 2 + 1) * DM, ada_l, 4, st2};
                pg8::LatOrder S; S.init(DM, F.G, F.bid);
                if (need_ctx) pg8::gemm_phase_strip<pg8::EpiRes, pg8::LatOrder>(F.lds, F.lds + STRIP_OFF, F.lds + PF_OFF, g, S, E, F.wave);
                else pg8::gemm_phase<pg8::EpiRes, pg8::LatOrder, AL, SP>(F.lds, F.lds + PF_OFF, g, S, E, F.wave); } PH_END
        } else if (kind == 1) {
            PH_BEGIN(gp0 + 1) if (EN & 16) {
                pg8::Gemm g{WSB(WS_H), WSB(WS_GQKV), MROWS, 3072, DM, DM, 1 << 20}; typedef pg8::LatOrderSplit<WS_U, WS_CTL + CTL_SPLIT_FLAGS2> SplitQKV; SplitQKV S; S.init(3072, F.G, F.bid); S.wsb = F.ws;
                pg8::EpiQKV<true> E{WSB(WS_Q), WSB(WS_K), WSB(WS_V), 2048, 512, DM, 512, st1, WSF(WS_BQKV), 6144, 1.0f, inp(F, I_GKN), WSF(WS_ROPE), (LAS float*)(F.lds + XK_OFF)};
                pg8::gemm_phase_strip<pg8::EpiQKV<true>, SplitQKV>(F.lds, F.lds + STRIP_OFF, F.lds + PF_OFF, g, S, E, F.wave); } PH_END
            PH_BEGIN(gp0 + 3) if (EN & 64) phase_attn_gqa(F, (char*)lds); PH_END
        } else {
            PH_BEGIN(gp0 + 1) if (EN & 256) {
                pg8::Gemm g{WSB(WS_H), WSB(WS_NQKV), MROWS, 6144, DM, DM, 1 << 20}; pg8::LatOrder S; S.init(6144, F.G, F.bid);
                pg8::EpiQKV<true> E{WSB(WS_Q), WSB(WS_K), WSB(WS_V), 2048, 2048, DM, DM, st1, WSF(WS_BQKV) + 3 * 6144, 6144, att::QSCALE, nullptr, nullptr, nullptr};
                pg8::gemm_phase_strip<pg8::EpiQKV<true>, pg8::LatOrder>(F.lds, F.lds + STRIP_OFF, F.lds + PF_OFF, g, S, E, F.wave); } PH_END
            PH_BEGIN(gp0 + 3) if (EN & 512) phase_attn_nat(F, (char*)lds); PH_END
        }
        if (kind != 0) {
            PH_BEGIN(gp0 + 4) if (EN & 128) {
                pg8::Gemm g{WSB(WS_PO), kind == 1 ? WSB(WS_GWO) : WSB(WS_NWO), MROWS, DM, DM, DM, 1 << 20}; pg8::LatOrder S; S.init(DM, F.G, F.bid);
                pg8::EpiRes E{WSH(WS_XS), WSH(WS_XS), ada_l, 2, nullptr, WSB(WS_H), inp(F, I_NORMG) + (size_t)(layer * 2 + 1) * DM, ada_l, 4, st2};
                pg8::gemm_phase_strip<pg8::EpiRes, pg8::LatOrder>(F.lds, F.lds + STRIP_OFF, F.lds + PF_OFF, g, S, E, F.wave); } PH_END
        }
        PH_BEGIN(gp0 + 6) if (EN & 2048) {
            pg8::Gemm g{WSB(WS_H), WSB(WS_W13) + (size_t)layer * 2 * FF * DM, MROWS, 2 * FF, DM, DM, 1 << 20};
            pg8::EpiSwiGLU E{WSB(WS_U), st2, WSF(WS_BUP) + (size_t)layer * 3 * 2 * FF};
            if (need_ctx) { pg8::StaticOrder S; S.init(MROWS, 2 * FF, F.G, F.bid); pg8::gemm_phase<pg8::EpiSwiGLU, pg8::StaticOrder, AL, SP>(F.lds, F.lds + PF_OFF, g, S, E, F.wave); }
            else { typedef pg8::LatOrderSplit<WS_PO, WS_CTL + CTL_SPLIT_FLAGS> SplitUp; SplitUp S; S.init(2 * FF, F.G, F.bid); S.wsb = F.ws;
                pg8::gemm_phase<pg8::EpiSwiGLU, SplitUp, AL, SP>(F.lds, F.lds + PF_OFF, g, S, E, F.wave); } } PH_END
        if (need_ctx) {
            PH_BEGIN(gp0 + 7) if (EN & 4096) {
                pg8::Gemm g{WSB(WS_U), WSB(WS_W2) + (size_t)layer * DM * FF, MROWS, DM, FF, FF, 1 << 20}; pg8::LatOrder S; S.init(DM, F.G, F.bid);
                pg8::EpiRes E{WSH(WS_XS), WSH(WS_XS), ada_l, 5, nullptr, (layer + 1) % 3 == 0 ? (gb16*)nullptr : WSB(WS_H)  , inp(F, I_NORMG) + (size_t)((layer + 1) * 2) * DM, ada_l + (size_t)3 * 6 * DM, 1, st2 + MROWS};
                pg8::gemm_phase_strip<pg8::EpiRes, pg8::LatOrder>(F.lds, F.lds + STRIP_OFF, F.lds + PF_OFF, g, S, E, F.wave); } PH_END
        } else {
            PH_BEGIN(gp0 + 7) if (EN & 4096) {
                pg8::Gemm g{WSB(WS_U), WSB(WS_W2) + (size_t)layer * DM * FF, MROWS, DM, FF, FF, 1 << 20}; pg8::LatOrder S; S.init(DM, F.G, F.bid);
                if (F.G == 256) {
                    pg8::EpiFinal E{WSH(WS_XS), ada_l, 5, WSF(WS_STATS) + (size_t)8 * MROWS, inp(F, I_FINALG), F.out, (unsigned*)(ws + WS_CTL + CTL_FINAL_CNT)};
                    pg8::gemm_phase<pg8::EpiFinal, pg8::LatOrder, AL, SP>(F.lds, F.lds + PF_OFF, g, S, E, F.wave);
                } else {
                pg8::EpiRes E{WSH(WS_XS), WSH(WS_XS), ada_l, 5, nullptr, nullptr, nullptr, nullptr, 1, nullptr};
                pg8::gemm_phase<pg8::EpiRes, pg8::LatOrder, AL, SP>(F.lds, F.lds + PF_OFF, g, S, E, F.wave); } } PH_END
        }
    }
    if (F.G != 256) { PH_BEGIN(34) if (EN & 8192) phase_final(F); PH_END }
#undef PH_BEGIN
#undef PH_END
}

static bool phase_active(int gp) {
    if (gp <= 1 || gp == 34) return true;
    const int layer = (gp - 2) / 8, s = (gp - 2) % 8, kind = layer % 3;
    if (s == 0 || s == 5) return false;
    if (kind == 0) return s == 1 || s == 2 || s >= 6;
    return s != 2;
}
extern "C" void kernel_launch(void* const* d_in, const int* in_sizes, int n_in, void* d_out, int out_size, void* d_ws, size_t ws_size, hipStream_t stream) {
    static int grid = 0;
    if (grid == 0) {
        if (n_in != 24 || in_sizes[0] != NB * SEQ * DM || out_size != NB * SEQ * DM || ws_size < WS_END) {
            fprintf(stderr, "kernel_launch: shape mismatch: n_in %d in0 %d out %d ws %zu (need %zu)\n", n_in, n_in > 0 ? in_sizes[0] : -1, out_size, ws_size, (size_t)WS_END); grid = -1; return; }
        int dev = 0, cus = 0, per_cu = 0;
        if (hipGetDevice(&dev) != hipSuccess || hipDeviceGetAttribute(&cus, hipDeviceAttributeMultiprocessorCount, dev) != hipSuccess) { fprintf(stderr, "kernel_launch: device query failed\n"); grid = -1; return; }
        if (hipFuncSetAttribute((const void*)fwd_kernel, hipFuncAttributeMaxDynamicSharedMemorySize, LDS_BYTES) != hipSuccess) { fprintf(stderr, "kernel_launch: hipFuncSetAttribute failed\n"); grid = -1; return; }
        if (hipOccupancyMaxActiveBlocksPerMultiprocessor(&per_cu, (const void*)fwd_kernel, 512, LDS_BYTES) != hipSuccess || per_cu < 1)
            fprintf(stderr, "kernel_launch: note: occupancy query reports %d workgroups per CU\n", per_cu);
        (void)hipGetLastError();
        grid = cus;
    }
    if (grid < 0) return;
    if (hipMemsetAsync((char*)d_ws + WS_CTL, 0, CTL_ZERO_BYTES, stream) != hipSuccess) { fprintf(stderr, "kernel_launch: memset failed\n"); return; }
    Args a{};
    for (int i = 0; i < 24; ++i) a.in[i] = (const float*)d_in[i];
    a.out = (float*)d_out; a.ws = (unsigned char*)d_ws;
#if MK_ONE_LAUNCH
    a.gp_lo = 0; a.gp_hi = GP_END;
    hipLaunchKernelGGL(fwd_kernel, dim3(grid), dim3(512), LDS_BYTES, stream, a);
#else
    for (int gp = 0; gp < GP_END; ++gp) { if (!phase_active(gp)) continue;
        a.gp_lo = gp; a.gp_hi = gp + 1;
        hipLaunchKernelGGL(fwd_kernel, dim3(grid), dim3(512), LDS_BYTES, stream, a); }
#endif
    const hipError_t le = hipPeekAtLastError();
    if (le != hipSuccess) fprintf(stderr, "kernel_launch: launch failed: %s\n", hipGetErrorName(le));
}
```

```cpp
#include <hip/hip_runtime.h>
#include <cstdio>
#include <cstdint>

#ifndef EN
#define EN 0xffff
#endif
#ifndef MK_ONE_LAUNCH
#define MK_ONE_LAUNCH 1
#endif

constexpr int DM = 2048, NB = 2, SEQ = 4096, CTXL = 256, RB = SEQ + CTXL, MROWS = NB * RB, FF = 5632, HD = 128, NH = 16, KVH = 4, DEPTH = 4;
constexpr int PTILES = RB / 256;
constexpr float NORM_EPS = 1e-6f;
static_assert(RB % 256 == 0 && MROWS == 8704, "row layout");

#define GAS __attribute__((address_space(1)))
#define LAS __attribute__((address_space(3)))
typedef unsigned short bf16_t;
typedef float f32x4 __attribute__((ext_vector_type(4)));
typedef float f32x2 __attribute__((ext_vector_type(2)));
typedef unsigned u32x4 __attribute__((ext_vector_type(4)));
typedef unsigned u32x2 __attribute__((ext_vector_type(2)));
typedef short bf16x8 __attribute__((ext_vector_type(8)));
typedef _Float16 h16x2 __attribute__((ext_vector_type(2)));
typedef GAS _Float16 gh16;
__device__ __forceinline__ unsigned pk_h16(float a, float b) { const h16x2 v = {(_Float16)a, (_Float16)b}; return __builtin_bit_cast(unsigned, v); }
__device__ __forceinline__ float h16_lo(unsigned u) { return (float)__builtin_bit_cast(h16x2, u).x; }
__device__ __forceinline__ float h16_hi(unsigned u) { return (float)__builtin_bit_cast(h16x2, u).y; }
typedef GAS float gf32; typedef GAS bf16_t gb16; typedef GAS f32x4 gf32x4; typedef GAS f32x2 gf32x2; typedef GAS u32x4 gu32x4; typedef GAS u32x2 gu32x2; typedef GAS bf16x8 gbf16x8; typedef GAS unsigned gu32;
#define LDS_WAIT() asm volatile("s_waitcnt lgkmcnt(0)" ::: "memory")
#define VM_WAIT() asm volatile("s_waitcnt vmcnt(0)" ::: "memory")
__device__ __forceinline__ unsigned cvt_pk_bf16(float lo, float hi) { unsigned r; asm volatile("v_cvt_pk_bf16_f32 %0, %1, %2" : "=v"(r) : "v"(lo), "v"(hi)); return r; }
__device__ __forceinline__ float bf_lo(unsigned u) { return __uint_as_float(u << 16); }
__device__ __forceinline__ float bf_hi(unsigned u) { return __uint_as_float(u & 0xffff0000u); }
__device__ __forceinline__ int tid_here(int wave) { int l; asm volatile("v_mbcnt_lo_u32_b32 %0, -1, 0\n\tv_mbcnt_hi_u32_b32 %0, -1, %0" : "=v"(l)); return wave * 64 + l; }
__device__ __forceinline__ float wave_sum(float v) {
#pragma unroll
    for (int o = 1; o < 64; o <<= 1) v += __shfl_xor(v, o);
    return v;
}

namespace pg8 {
#define PG8_LAS __attribute__((address_space(3)))
constexpr int BM = 256, BK = 64, HALF = 128, HTB = HALF * BK * 2, STAGE_BYTES = 8 * HTB, NXCD = 8, WGM = 8;
__host__ __device__ __forceinline__ int lds_byte(int r, int c) { const int st = (r >> 4) * 2 + (c >> 5), rr = r & 15, cc = c & 31, ob = rr * 64 + cc * 2; return st * 1024 + (ob ^ (((ob >> 9) & 1) << 5)); }
__host__ __device__ __forceinline__ void stage_rc(int b, int& R, int& C) { const int st = b / 1024, sb = b % 1024, swz = sb ^ (((sb >> 9) & 1) << 5); R = (st >> 1) * 16 + swz / 64; C = (st & 1) * 32 + (swz % 64) / 2; }
__host__ __device__ __forceinline__ int perm32(int rho) { const int n = rho >> 4, i = rho & 15; return 8 * (i >> 2) + 4 * n + (i & 3); }

struct Unit { int pm, pn, srow, kh; };
struct Gemm { const gb16* A; const gb16* Bt; int M, N, K, lda, a_tpg; };

struct StaticOrder {
    static constexpr bool SPLIT = false;
    int nM, nN, nwg, G, c;
    __host__ __device__ void init(int M, int N, int G_, int c_) { nM = M / BM; nN = N / BM; nwg = nM * nN; G = G_; c = c_; }
    __host__ __device__ bool next(int i, Unit& u) const {
        const long L = (long)i * G + c; if (L >= nwg) return false;
        int wgid = (int)L; { const int q = nwg / NXCD, r = nwg % NXCD, xcd = wgid % NXCD, off = wgid / NXCD; wgid = (xcd < r ? xcd * (q + 1) : r * (q + 1) + (xcd - r) * q) + off; }
        const int nig = WGM * nN, gid = wgid / nig, fm = gid * WGM, gsz = (nM - fm) < WGM ? (nM - fm) : WGM;
        u.pm = fm + ((wgid % nig) % gsz); u.pn = (wgid % nig) / gsz; u.srow = 0; u.kh = -1; return true;
    }
    __device__ __forceinline__ void a_ready(const Unit&) const {}
    __device__ __forceinline__ void done(const Unit&) const {}
};
struct LatOrder {
    static constexpr bool SPLIT = false;
    int nN, nwg, G, c;
    __host__ __device__ void init(int N, int G_, int c_) { nN = N / BM; nwg = 32 * nN; G = G_; c = c_; }
    __host__ __device__ bool next(int i, Unit& u) const {
        const long L = (long)i * G + c; if (L >= nwg) return false;
        int wgid = (int)L; { const int q = nwg / NXCD, r = nwg % NXCD, xcd = wgid % NXCD, off = wgid / NXCD; wgid = (xcd < r ? xcd * (q + 1) : r * (q + 1) + (xcd - r) * q) + off; }
        const int nig = WGM * nN, gid = wgid / nig, fm = gid * WGM;
        const int p = fm + ((wgid % nig) % WGM); u.pn = (wgid % nig) / WGM; u.pm = p + 1 + (p >= 16 ? 1 : 0); u.srow = (p >> 4) * RB + (p & 15) * 16; u.kh = -1; return true;
    }
    __device__ __forceinline__ void a_ready(const Unit&) const {}
    __device__ __forceinline__ void done(const Unit&) const {}
};
template <size_t XOFF, size_t FOFF> struct LatOrderSplit {
    static constexpr bool SPLIT = true;
    int nN, nwg, G, c, full, R; GAS unsigned char* wsb; static constexpr size_t xoff = XOFF, foff = FOFF;
    __device__ __forceinline__ void init(int N, int G_, int c_) { nN = N / BM; nwg = 32 * nN; G = G_; c = c_; R = nwg % G; if (R > 0 && 2 * R <= G && R % NXCD == 0) full = nwg - R; else { full = nwg; R = 0; } }
    __device__ __forceinline__ bool next(int i, Unit& u) const {
        const long L = (long)i * G + c; int wgid, kh = -1;
        if (L < full) wgid = (int)L;
        else { if (R == 0 || L >= full + 2 * R) return false; const int t = (int)(L - full); kh = t >= R ? 1 : 0; wgid = full + (t >= R ? t - R : t); }
        { const int q = nwg / NXCD, r = nwg % NXCD, xcd = wgid % NXCD, off = wgid / NXCD; wgid = (xcd < r ? xcd * (q + 1) : r * (q + 1) + (xcd - r) * q) + off; }
        const int nig = WGM * nN, gid = wgid / nig, fm = gid * WGM;
        const int p = fm + ((wgid % nig) % WGM); u.pn = (wgid % nig) / WGM; u.pm = p + 1 + (p >= 16 ? 1 : 0); u.srow = (p >> 4) * RB + (p & 15) * 16; u.kh = kh; return true;
    }
    __device__ __forceinline__ void a_ready(const Unit&) const {}
    __device__ __forceinline__ void done(const Unit&) const {}
};


__device__ __forceinline__ float rstd_of(float ss) { return __builtin_amdgcn_rsqf(ss * (1.0f / DM) + NORM_EPS); }
__device__ __forceinline__ void atomic_add_f32(gf32* p, float v) { (void)__builtin_amdgcn_global_atomic_fadd_f32(p, v); }

struct EpiRes {
    static constexpr bool PERM = true, AFTER_DRAIN = false;
    const gh16* base; gh16* out; const gf32* ada_l; int chunk; const gf32* ls;
    gb16* An; const gf32* gnext; const gf32* ada_n; int sc_chunk; gf32* stats;
    __device__ __forceinline__ void prefetch(const Unit&, PG8_LAS float*, int, int, int) const {}
    __device__ __forceinline__ void operator()(const f32x4 (&acc)[2][2][4][2], const Unit& u, int wr, int wc, int fr, int fq, const PG8_LAS float*) const {
        const int vec = (u.pm % PTILES == 0) ? 2 : (u.pm / PTILES);
        const GAS char* gate = (const GAS char*)(ada_l + (size_t)(vec * 6 + chunk) * DM + u.pn * BM);
        const GAS char* lsp = (const GAS char*)(ls + u.pn * BM);
        const GAS char* gnp = (const GAS char*)(gnext + u.pn * BM);
        const GAS char* scp = (const GAS char*)(ada_n + (size_t)(vec * 6 + sc_chunk) * DM + u.pn * BM);
        const GAS char* bt = (const GAS char*)(base + (size_t)u.pm * BM * DM + u.pn * BM);
        GAS char* ot = (GAS char*)(out + (size_t)u.pm * BM * DM + u.pn * BM);
        GAS char* at = (GAS char*)(An + (size_t)u.pm * BM * DM + u.pn * BM);
        asm volatile("" : "+v"(fr), "+v"(fq));
        const unsigned lo = (unsigned)((wr * 64 + fr) * DM + wc * 32 + 8 * fq) * 2u, co = (unsigned)(wc * 32 + 8 * fq) * 4u;
        const unsigned so = (unsigned)(wr * 64 + fq * 16 + fr) * 4u;
        float ssq[2][4];
#pragma unroll
        for (int ai = 0; ai < 2; ++ai)
#pragma unroll
            for (int m = 0; m < 4; ++m) ssq[ai][m] = 0.f;
#pragma unroll
        for (int bj = 0; bj < 2; ++bj) {
            f32x4 gv[2], gm[2];
#pragma unroll
            for (int n = 0; n < 2; ++n) { const unsigned c = co + (unsigned)(bj * HALF + n * 4) * 4u;
                gv[n] = *(const gf32x4*)(gate + c); if (ls) gv[n] = gv[n] * *(const gf32x4*)(lsp + c);
                gm[n] = An ? *(const gf32x4*)(gnp + c) * (*(const gf32x4*)(scp + c) + 1.0f) : (f32x4){0.f, 0.f, 0.f, 0.f}; }
            u32x4 bs[2][4];
#pragma unroll
            for (int ai = 0; ai < 2; ++ai)
#pragma unroll
                for (int m = 0; m < 4; ++m) { const unsigned o = lo + (unsigned)((ai * HALF + m * 16) * DM + bj * HALF) * 2u; bs[ai][m] = *(const gu32x4*)(bt + o); }
            asm volatile("" ::: "memory");
#pragma unroll
            for (int ai = 0; ai < 2; ++ai)
#pragma unroll
                for (int m = 0; m < 4; ++m) { const unsigned o = lo + (unsigned)((ai * HALF + m * 16) * DM + bj * HALF) * 2u; const u32x4 b = bs[ai][m];
                    const f32x4 x0 = (f32x4){h16_lo(b.x), h16_hi(b.x), h16_lo(b.y), h16_hi(b.y)} + acc[ai][bj][m][0] * gv[0], x1 = (f32x4){h16_lo(b.z), h16_hi(b.z), h16_lo(b.w), h16_hi(b.w)} + acc[ai][bj][m][1] * gv[1];
                    { u32x4 w; w.x = pk_h16(x0.x, x0.y); w.y = pk_h16(x0.z, x0.w); w.z = pk_h16(x1.x, x1.y); w.w = pk_h16(x1.z, x1.w); *(gu32x4*)(ot + o) = w; }
                    ssq[ai][m] += (x0.x * x0.x + x0.y * x0.y) + (x0.z * x0.z + x0.w * x0.w) + (x1.x * x1.x + x1.y * x1.y) + (x1.z * x1.z + x1.w * x1.w);
                    if (An) { const f32x4 y0 = x0 * gm[0], y1 = x1 * gm[1]; u32x4 w; w.x = cvt_pk_bf16(y0.x, y0.y); w.y = cvt_pk_bf16(y0.z, y0.w); w.z = cvt_pk_bf16(y1.x, y1.y); w.w = cvt_pk_bf16(y1.z, y1.w); *(gu32x4*)(at + o) = w; } }
            asm volatile("" ::: "memory");
        }
        if (stats) {
#pragma unroll
            for (int ai = 0; ai < 2; ++ai) {
#pragma unroll
                for (int m = 0; m < 4; ++m) { ssq[ai][m] += __shfl_xor(ssq[ai][m], 16); ssq[ai][m] += __shfl_xor(ssq[ai][m], 32); }
                const float v = fq == 0 ? ssq[ai][0] : fq == 1 ? ssq[ai][1] : fq == 2 ? ssq[ai][2] : ssq[ai][3];
                atomic_add_f32((gf32*)((GAS char*)(stats + u.pm * BM + ai * HALF) + so), v); }
        }
    }
    __device__ __forceinline__ void strip(const f32x4 (&accS)[2], const Unit& u, int wr, int wc, int fr, int fq) const {
        const GAS char* gate = (const GAS char*)(ada_l + (size_t)(2 * 6 + chunk) * DM + u.pn * BM);
        const GAS char* lsp = (const GAS char*)(ls + u.pn * BM);
        const GAS char* gnp = (const GAS char*)(gnext + u.pn * BM);
        const GAS char* scp = (const GAS char*)(ada_n + (size_t)(2 * 6 + sc_chunk) * DM + u.pn * BM);
        const GAS char* bt = (const GAS char*)(base + (size_t)u.srow * DM + u.pn * BM);
        GAS char* ot = (GAS char*)(out + (size_t)u.srow * DM + u.pn * BM);
        GAS char* at = (GAS char*)(An + (size_t)u.srow * DM + u.pn * BM);
        asm volatile("" : "+v"(fr), "+v"(fq));
        const unsigned co = (unsigned)(wc * 32 + 8 * fq + 4 * wr) * 4u, lo = (unsigned)(fr * DM) * 2u + (co >> 1), so = (unsigned)fr * 4u;
        float q = 0.f;
#pragma unroll
        for (int bj = 0; bj < 2; ++bj) { const unsigned c = co + (unsigned)(bj * HALF) * 4u, o = lo + (unsigned)(bj * HALF) * 2u;
            f32x4 gv = *(const gf32x4*)(gate + c); if (ls) gv = gv * *(const gf32x4*)(lsp + c);
            const u32x2 b = *(const gu32x2*)(bt + o);
            const f32x4 x0 = (f32x4){h16_lo(b.x), h16_hi(b.x), h16_lo(b.y), h16_hi(b.y)} + accS[bj] * gv; { u32x2 w; w.x = pk_h16(x0.x, x0.y); w.y = pk_h16(x0.z, x0.w); *(gu32x2*)(ot + o) = w; }
            q += (x0.x * x0.x + x0.y * x0.y) + (x0.z * x0.z + x0.w * x0.w);
            if (An) { const f32x4 y0 = x0 * (*(const gf32x4*)(gnp + c) * (*(const gf32x4*)(scp + c) + 1.0f));
                u32x2 w; w.x = cvt_pk_bf16(y0.x, y0.y); w.y = cvt_pk_bf16(y0.z, y0.w); *(gu32x2*)(at + o) = w; } }
        if (stats) { q += __shfl_xor(q, 16); q += __shfl_xor(q, 32); if (fq == 0) atomic_add_f32((gf32*)((GAS char*)(stats + u.srow) + so), q); }
    }
};
struct EpiFinal {
    static constexpr bool PERM = true, AFTER_DRAIN = false;
    const gh16* base; const gf32* ada_l; int chunk; gf32* stats; const gf32* fg; gf32* out; unsigned* cnt;
    __device__ __forceinline__ void prefetch(const Unit&, PG8_LAS float*, int, int, int) const {}
    __device__ __forceinline__ void operator()(f32x4 (&acc)[2][2][4][2], const Unit& u, int wr, int wc, int fr, int fq, const PG8_LAS float*) const {
        const int b = u.pm / PTILES;
        const GAS char* gate = (const GAS char*)(ada_l + (size_t)(b * 6 + chunk) * DM + u.pn * BM);
        const GAS char* bt = (const GAS char*)(base + (size_t)u.pm * BM * DM + u.pn * BM);
        asm volatile("" : "+v"(fr), "+v"(fq));
        const unsigned lo = (unsigned)((wr * 64 + fr) * DM + wc * 32 + 8 * fq) * 2u, co = (unsigned)(wc * 32 + 8 * fq) * 4u;
        const unsigned so = (unsigned)(wr * 64 + fq * 16 + fr) * 4u;
        float ssq[2][4];
#pragma unroll
        for (int ai = 0; ai < 2; ++ai)
#pragma unroll
            for (int m = 0; m < 4; ++m) ssq[ai][m] = 0.f;
#pragma unroll
        for (int bj = 0; bj < 2; ++bj) {
            f32x4 gv[2];
#pragma unroll
            for (int n = 0; n < 2; ++n) gv[n] = *(const gf32x4*)(gate + co + (unsigned)(bj * HALF + n * 4) * 4u);
            u32x4 bs[2][4];
#pragma unroll
            for (int ai = 0; ai < 2; ++ai)
#pragma unroll
                for (int m = 0; m < 4; ++m) bs[ai][m] = *(const gu32x4*)(bt + lo + (unsigned)((ai * HALF + m * 16) * DM + bj * HALF) * 2u);
            asm volatile("" ::: "memory");
#pragma unroll
            for (int ai = 0; ai < 2; ++ai)
#pragma unroll
                for (int m = 0; m < 4; ++m) { const u32x4 bb = bs[ai][m];
                    const f32x4 x0 = (f32x4){h16_lo(bb.x), h16_hi(bb.x), h16_lo(bb.y), h16_hi(bb.y)} + acc[ai][bj][m][0] * gv[0], x1 = (f32x4){h16_lo(bb.z), h16_hi(bb.z), h16_lo(bb.w), h16_hi(bb.w)} + acc[ai][bj][m][1] * gv[1];
                    acc[ai][bj][m][0] = x0; acc[ai][bj][m][1] = x1;
                    ssq[ai][m] += (x0.x * x0.x + x0.y * x0.y) + (x0.z * x0.z + x0.w * x0.w) + (x1.x * x1.x + x1.y * x1.y) + (x1.z * x1.z + x1.w * x1.w); }
        }
#pragma unroll
        for (int ai = 0; ai < 2; ++ai) {
#pragma unroll
            for (int m = 0; m < 4; ++m) { ssq[ai][m] += __shfl_xor(ssq[ai][m], 16); ssq[ai][m] += __shfl_xor(ssq[ai][m], 32); }
            const float v = fq == 0 ? ssq[ai][0] : fq == 1 ? ssq[ai][1] : fq == 2 ? ssq[ai][2] : ssq[ai][3];
            atomic_add_f32((gf32*)((GAS char*)(stats + u.pm * BM + ai * HALF) + so), v); }
        asm volatile("s_waitcnt vmcnt(0)" ::: "memory"); __builtin_amdgcn_s_barrier();
        if ((wr | wc | fr | fq) == 0) { unsigned* cp = cnt + u.pm * 16; (void)__hip_atomic_fetch_add(cp, 1u, __ATOMIC_RELAXED, __HIP_MEMORY_SCOPE_AGENT);
            unsigned sp = 0; while (__hip_atomic_load(cp, __ATOMIC_RELAXED, __HIP_MEMORY_SCOPE_AGENT) < (unsigned)(DM / BM)) { __builtin_amdgcn_s_sleep(1); if (++sp > (1u << 22)) break; } }
        __builtin_amdgcn_s_barrier(); asm volatile("" ::: "memory");
        float rs[2][4];
#pragma unroll
        for (int ai = 0; ai < 2; ++ai)
#pragma unroll
            for (int m = 0; m < 4; ++m) rs[ai][m] = rstd_of(__hip_atomic_load(stats + u.pm * BM + ai * HALF + wr * 64 + m * 16 + fr, __ATOMIC_RELAXED, __HIP_MEMORY_SCOPE_AGENT));
        GAS char* ob = (GAS char*)(out + ((size_t)b * SEQ + (size_t)(u.pm % PTILES - 1) * BM) * DM + u.pn * BM);
        const unsigned oo = (unsigned)((wr * 64 + fr) * DM + wc * 32 + 8 * fq) * 4u;
#pragma unroll
        for (int bj = 0; bj < 2; ++bj) {
            const f32x4 f0 = *(const gf32x4*)((const GAS char*)(fg + u.pn * BM) + co + (unsigned)(bj * HALF) * 4u), f1 = *(const gf32x4*)((const GAS char*)(fg + u.pn * BM) + co + (unsigned)(bj * HALF + 4) * 4u);
#pragma unroll
            for (int ai = 0; ai < 2; ++ai)
#pragma unroll
                for (int m = 0; m < 4; ++m) { const unsigned o = oo + (unsigned)((ai * HALF + m * 16) * DM + bj * HALF) * 4u;
                    *(gf32x4*)(ob + o) = (acc[ai][bj][m][0] * rs[ai][m]) * f0; *(gf32x4*)(ob + o + 16) = (acc[ai][bj][m][1] * rs[ai][m]) * f1; }
        }
    }
};
template <bool PF> struct EpiQKV {
    static constexpr bool PERM = true, AFTER_DRAIN = false;
    gb16* P0; gb16* P1; gb16* P2; int n0, n1, ld0, ld1; const gf32* stats; const gf32* bias; int nb; float qscale;
    const gf32* gk; const gf32* rope; PG8_LAS float* xk;
    __device__ __forceinline__ void prefetch(const Unit& u, PG8_LAS float* area, int lane, int wr, int wc) const {
        if constexpr (!PF) return;
        asm volatile("" : "+v"(lane));
        const int vec = (u.pm % PTILES == 0) ? 2 : (u.pm / PTILES);
        const gf32* sp = stats + u.pm * BM + wr * 64 + lane;
        __builtin_amdgcn_global_load_lds((const GAS unsigned*)sp, (PG8_LAS unsigned*)area, 4, 0, 0);
        __builtin_amdgcn_global_load_lds((const GAS unsigned*)(sp + HALF), (PG8_LAS unsigned*)(area + 64), 4, 0, 0);
        __builtin_amdgcn_global_load_lds((const GAS unsigned*)(bias + (size_t)vec * nb + u.pn * BM + (lane >> 5) * HALF + wc * 32 + (lane & 31)), (PG8_LAS unsigned*)(area + 128), 4, 0, 0);
    }
    __device__ __forceinline__ void operator()(const f32x4 (&acc)[2][2][4][2], const Unit& u, int wr, int wc, int fr, int fq, const PG8_LAS float* area, int aim = 3, int flip = 0) const {
        asm volatile("" : "+v"(fr), "+v"(fq));
        const int row0 = u.pm * BM + wr * 64 + fr;
        int colt = u.pn * BM; gb16* base = P0; int ldc = ld0; float qs = qscale;
        if (colt >= n0 + n1) { base = P2; ldc = ld1; colt -= n0 + n1; qs = 1.f; } else if (colt >= n0) { base = P1; ldc = ld1; colt -= n0; qs = 1.f; }
        const int col0 = colt + wc * 32 + 8 * fq;
        if (gk && base == P1) { ktile(acc, u, wr, wc, fr, fq, area, P1 + (size_t)row0 * ld1 + col0, aim, flip); return; }
        f32x4 bv[2][2];
#pragma unroll
        for (int bj = 0; bj < 2; ++bj)
#pragma unroll
            for (int n = 0; n < 2; ++n) bv[bj][n] = PF ? *(const PG8_LAS f32x4*)(area + 128 + bj * 32 + 8 * fq + 4 * n) : *(const gf32x4*)(bias + (size_t)((u.pm % PTILES == 0) ? 2 : (u.pm / PTILES)) * nb + u.pn * BM + wc * 32 + 8 * fq + bj * HALF + 4 * n);
#pragma unroll
        for (int ai = 0; ai < 2; ++ai) { if (!((aim >> ai) & 1)) continue; const int h = ai ^ flip;
#pragma unroll
            for (int m = 0; m < 4; ++m) { const int row = row0 + h * HALF + m * 16; const float rs = rstd_of(PF ? area[h * 64 + m * 16 + fr] : stats[row]); gb16* rowp = base + (size_t)row * ldc + col0;
#pragma unroll
                for (int bj = 0; bj < 2; ++bj) { const f32x4 v0 = (acc[ai][bj][m][0] * rs + bv[bj][0]) * qs, v1 = (acc[ai][bj][m][1] * rs + bv[bj][1]) * qs;
                    u32x4 w; w.x = cvt_pk_bf16(v0[0], v0[1]); w.y = cvt_pk_bf16(v0[2], v0[3]); w.z = cvt_pk_bf16(v1[0], v1[1]); w.w = cvt_pk_bf16(v1[2], v1[3]);
                    *(gu32x4*)(rowp + bj * HALF) = w; } } }
    }
    __device__ __forceinline__ void ktile(const f32x4 (&acc)[2][2][4][2], const Unit& u, int wr, int wc, int fr, int fq, const PG8_LAS float* area, gb16* rowp0, int aim, int flip) const {
        f32x4 bv[2][2];
#pragma unroll
        for (int bj = 0; bj < 2; ++bj)
#pragma unroll
            for (int n = 0; n < 2; ++n) bv[bj][n] = *(const PG8_LAS f32x4*)(area + 128 + bj * 32 + 8 * fq + 4 * n);
        float rs[2][4];
#pragma unroll
        for (int ai = 0; ai < 2; ++ai) { if (!((aim >> ai) & 1)) continue; const int h = ai ^ flip;
#pragma unroll
            for (int m = 0; m < 4; ++m) { rs[ai][m] = rstd_of(area[h * 64 + m * 16 + fr]);
#pragma unroll
                for (int bj = 0; bj < 2; ++bj) { const f32x4 v0 = acc[ai][bj][m][0] * rs[ai][m] + bv[bj][0], v1 = acc[ai][bj][m][1] * rs[ai][m] + bv[bj][1];
                    float q = (v0.x * v0.x + v0.y * v0.y) + (v0.z * v0.z + v0.w * v0.w) + (v1.x * v1.x + v1.y * v1.y) + (v1.z * v1.z + v1.w * v1.w);
                    q += __shfl_xor(q, 16); q += __shfl_xor(q, 32);
                    if (fq == 0) xk[(bj * BM + h * HALF + wr * 64 + m * 16 + fr) * 4 + wc] = q; } } }
        asm volatile("s_waitcnt lgkmcnt(0)" ::: "memory"); __builtin_amdgcn_s_barrier(); asm volatile("" ::: "memory");
        const f32x4 g0 = *(const gf32x4*)(gk + wc * 32 + 8 * fq), g1 = *(const gf32x4*)(gk + wc * 32 + 8 * fq + 4);
        const bool lat = (u.pm % PTILES) != 0;
        const int f0 = 16 * (wc & 1) + 4 * fq;
#pragma unroll
        for (int ai = 0; ai < 2; ++ai) { if (!((aim >> ai) & 1)) continue;
#pragma unroll
            for (int m = 0; m < 4; ++m) { const int rl = (ai ^ flip) * HALF + wr * 64 + m * 16 + fr; const int t = ((u.pm % PTILES) - 1) * BM + rl; const int pos = wc < 2 ? (t >> 6) : (t & 63);
                f32x4 t0 = {1.f, 0.f, 1.f, 0.f}, t1 = t0;
                if (lat) { t0 = *(const gf32x4*)(rope + 2 * (pos * 32 + f0)); t1 = *(const gf32x4*)(rope + 2 * (pos * 32 + f0 + 2)); }
#pragma unroll
                for (int bj = 0; bj < 2; ++bj) { const f32x4 pq = *(const PG8_LAS f32x4*)(xk + (bj * BM + rl) * 4);
                    const float rh = __builtin_amdgcn_rsqf(((pq.x + pq.y) + (pq.z + pq.w)) * (1.0f / 128.0f) + NORM_EPS);
                    const f32x4 y0 = (acc[ai][bj][m][0] * rs[ai][m] + bv[bj][0]) * rh * g0, y1 = (acc[ai][bj][m][1] * rs[ai][m] + bv[bj][1]) * rh * g1;
                    u32x4 w; w.x = cvt_pk_bf16(y0.x * t0.x - y0.y * t0.y, y0.x * t0.y + y0.y * t0.x); w.y = cvt_pk_bf16(y0.z * t0.z - y0.w * t0.w, y0.z * t0.w + y0.w * t0.z);
                    w.z = cvt_pk_bf16(y1.x * t1.x - y1.y * t1.y, y1.x * t1.y + y1.y * t1.x); w.w = cvt_pk_bf16(y1.z * t1.z - y1.w * t1.w, y1.z * t1.w + y1.w * t1.z);
                    *(gu32x4*)(rowp0 + (size_t)((ai ^ flip) * HALF + m * 16) * ld1 + bj * HALF) = w; } } }
    }
    __device__ __forceinline__ void strip(const f32x4 (&accS)[2], const Unit& u, int wr, int wc, int fr, int fq) const {
        asm volatile("" : "+v"(fr), "+v"(fq));
        int colt = u.pn * BM; gb16* base = P0; int ldc = ld0; float qs = qscale;
        if (colt >= n0 + n1) { base = P2; ldc = ld1; colt -= n0 + n1; qs = 1.f; } else if (colt >= n0) { base = P1; ldc = ld1; colt -= n0; qs = 1.f; }
        const int row = u.srow + fr; const float rs = rstd_of(stats[row]);
        gb16* rowp = base + (size_t)row * ldc + colt + wc * 32 + 8 * fq + 4 * wr; const gf32* bp = bias + (size_t)2 * nb + u.pn * BM + wc * 32 + 8 * fq + 4 * wr;
        if (gk && base == P1) {
            f32x4 v[2];
            __builtin_amdgcn_s_barrier();
#pragma unroll
            for (int bj = 0; bj < 2; ++bj) { v[bj] = accS[bj] * rs + *(const gf32x4*)(bp + bj * HALF);
                float q = (v[bj].x * v[bj].x + v[bj].y * v[bj].y) + (v[bj].z * v[bj].z + v[bj].w * v[bj].w); q += __shfl_xor(q, 16); q += __shfl_xor(q, 32);
                if (fq == 0) xk[(bj * 16 + fr) * 8 + wr * 4 + wc] = q; }
            asm volatile("s_waitcnt lgkmcnt(0)" ::: "memory"); __builtin_amdgcn_s_barrier(); asm volatile("" ::: "memory");
            const f32x4 g = *(const gf32x4*)(gk + wc * 32 + 8 * fq + 4 * wr);
#pragma unroll
            for (int bj = 0; bj < 2; ++bj) { const f32x4 p0 = *(const PG8_LAS f32x4*)(xk + (bj * 16 + fr) * 8), p1 = *(const PG8_LAS f32x4*)(xk + (bj * 16 + fr) * 8 + 4);
                const float rh = __builtin_amdgcn_rsqf((((p0.x + p0.y) + (p0.z + p0.w)) + ((p1.x + p1.y) + (p1.z + p1.w))) * (1.0f / 128.0f) + NORM_EPS);
                const f32x4 y = v[bj] * rh * g; u32x2 w; w.x = cvt_pk_bf16(y[0], y[1]); w.y = cvt_pk_bf16(y[2], y[3]); *(gu32x2*)(rowp + bj * HALF) = w; }
            return; }
#pragma unroll
        for (int bj = 0; bj < 2; ++bj) { const f32x4 v = (accS[bj] * rs + *(const gf32x4*)(bp + bj * HALF)) * qs; u32x2 w; w.x = cvt_pk_bf16(v[0], v[1]); w.y = cvt_pk_bf16(v[2], v[3]); *(gu32x2*)(rowp + bj * HALF) = w; }
    }
};
__device__ __forceinline__ float silu_mul(float g, float u) { return g * u * __builtin_amdgcn_rcpf(1.0f + __builtin_amdgcn_exp2f(-1.4426950408889634f * g)); }
__device__ __forceinline__ unsigned silu_mul_pk(f32x2 g, f32x2 u) {
    const f32x2 t = g * (-1.4426950408889634f); f32x2 e; e.x = __builtin_amdgcn_exp2f(t.x); e.y = __builtin_amdgcn_exp2f(t.y);
    const f32x2 d = e + 1.0f; f32x2 r; r.x = __builtin_amdgcn_rcpf(d.x); r.y = __builtin_amdgcn_rcpf(d.y);
    const f32x2 o = (g * u) * r; return cvt_pk_bf16(o.x, o.y);
}
struct EpiSwiGLU {
    static constexpr bool PERM = true, AFTER_DRAIN = false;
    gb16* U; const gf32* stats; const gf32* bias;
    __device__ __forceinline__ void prefetch(const Unit& u, PG8_LAS float* area, int lane, int wr, int wc) const {
        asm volatile("" : "+v"(lane));
        const int vec = (u.pm % PTILES == 0) ? 2 : (u.pm / PTILES);
        const gf32* sp = stats + u.pm * BM + wr * 64 + lane;
        __builtin_amdgcn_global_load_lds((const GAS unsigned*)sp, (PG8_LAS unsigned*)area, 4, 0, 0);
        __builtin_amdgcn_global_load_lds((const GAS unsigned*)(sp + HALF), (PG8_LAS unsigned*)(area + 64), 4, 0, 0);
        __builtin_amdgcn_global_load_lds((const GAS unsigned*)(bias + (size_t)vec * (2 * FF) + u.pn * BM + (lane >> 5) * HALF + wc * 32 + (lane & 31)), (PG8_LAS unsigned*)(area + 128), 4, 0, 0);
    }
    __device__ __forceinline__ void operator()(const f32x4 (&acc)[2][2][4][2], const Unit& u, int wr, int wc, int fr, int fq, const PG8_LAS float* area, int aim = 3, int flip = 0) const {
        asm volatile("" : "+v"(fr), "+v"(fq));
        const int row0 = u.pm * BM + wr * 64 + fr;
        const int col0 = u.pn * HALF + wc * 32 + 8 * fq;
        const f32x4 bg0 = *(const PG8_LAS f32x4*)(area + 128 + 8 * fq), bg1 = *(const PG8_LAS f32x4*)(area + 128 + 8 * fq + 4), bu0 = *(const PG8_LAS f32x4*)(area + 160 + 8 * fq), bu1 = *(const PG8_LAS f32x4*)(area + 160 + 8 * fq + 4);
#pragma unroll
        for (int ai = 0; ai < 2; ++ai) { if (!((aim >> ai) & 1)) continue;
#pragma unroll
            for (int m = 0; m < 4; ++m) { const int h = ai ^ flip; const int row = row0 + h * HALF + m * 16; const float rs = rstd_of(area[h * 64 + m * 16 + fr]); gb16* rowp = U + (size_t)row * FF + col0;
                const f32x4 g0 = acc[ai][0][m][0] * rs + bg0, g1 = acc[ai][0][m][1] * rs + bg1, u0 = acc[ai][1][m][0] * rs + bu0, u1 = acc[ai][1][m][1] * rs + bu1;
                u32x4 w; w.x = silu_mul_pk((f32x2){g0[0], g0[1]}, (f32x2){u0[0], u0[1]}); w.y = silu_mul_pk((f32x2){g0[2], g0[3]}, (f32x2){u0[2], u0[3]});
                w.z = silu_mul_pk((f32x2){g1[0], g1[1]}, (f32x2){u1[0], u1[1]}); w.w = silu_mul_pk((f32x2){g1[2], g1[3]}, (f32x2){u1[2], u1[3]});
                *(gu32x4*)rowp = w; } }
    }
};

template <class Epi, class Sched, bool ALIGN_EPI = false, bool SP2 = false>
__device__ __forceinline__ void gemm_phase(PG8_LAS unsigned char* lds, PG8_LAS unsigned char* pf, const Gemm g, const Sched& S, const Epi& E, int wv) {
    const int tid = tid_here(wv), wid = wv, lane = tid & 63, wr = wid >> 2, wc = wid & 3, fr = lane & 15, fq = lane >> 4;
    const int K = g.K, nt = K / BK, lda = g.lda;
    unsigned voffA[2], voffB[2];
#pragma unroll
    for (int i = 0; i < 2; ++i) { int R, C; stage_rc(tid * 16 + i * 8192, R, C); const int Rb = Epi::PERM ? ((R & ~31) + perm32(R & 31)) : R;
        voffA[i] = (unsigned)(R * lda + C) * 2u; voffB[i] = (unsigned)(Rb * K + C) * 2u; }
    const size_t kstep = (size_t)(BK * 2);
    const size_t hstepA = (size_t)HALF * lda * 2, hstepB = (size_t)HALF * K * 2;
    const size_t tstepA = 2 * hstepA, tstepB = 2 * hstepB;
    const unsigned ldsw = (unsigned)wid * 1024u;
    const int aoff = lds_byte(wr * 64 + fr, fq * 8), boff = lds_byte(wc * 32 + fr, fq * 8);
#define PG8_SA(b, h) (((b) * 2 + (h)) * HTB)
#define PG8_SB(b, h) ((4 + (b) * 2 + (h)) * HTB)
#define PG8_STAGE(bufoff, gbase, voff) do { _Pragma("unroll") for (int _i = 0; _i < 2; ++_i) \
        __builtin_amdgcn_global_load_lds((const GAS unsigned*)((const GAS char*)(gbase) + (voff)[_i]), (PG8_LAS unsigned*)(lds + (bufoff) + ldsw + _i * 8192), 16, 0, 0); } while (0)
#define PG8_LDA(dst, b, h) do { _Pragma("unroll") for (int m = 0; m < 4; ++m) _Pragma("unroll") for (int k = 0; k < 2; ++k) dst[m][k] = *(const PG8_LAS bf16x8*)(lds + PG8_SA(b, h) + aoff + m * 2048 + k * 1024); } while (0)
#define PG8_LDB(dst, b, h) do { _Pragma("unroll") for (int n = 0; n < 2; ++n) _Pragma("unroll") for (int k = 0; k < 2; ++k) dst[n][k] = *(const PG8_LAS bf16x8*)(lds + PG8_SB(b, h) + boff + n * 2048 + k * 1024); } while (0)
#define PG8_MMA(ai, bj, At, Bt) do { __builtin_amdgcn_s_setprio(1); _Pragma("unroll") for (int m = 0; m < 4; ++m) _Pragma("unroll") for (int n = 0; n < 2; ++n) _Pragma("unroll") for (int k = 0; k < 2; ++k) \
        acc[ai][bj][m][n] = __builtin_amdgcn_mfma_f32_16x16x32_bf16(Bt[n][k], At[m][k], acc[ai][bj][m][n], 0, 0, 0); __builtin_amdgcn_s_setprio(0); } while (0)
#define PG8_WAIT_V(n) asm volatile("s_waitcnt vmcnt(" #n ")" ::: "memory")
#define PG8_WAIT_L(n) asm volatile("s_waitcnt lgkmcnt(" #n ")" ::: "memory")
#define PG8_BAR __builtin_amdgcn_s_barrier()
#define PG8_SCHED __builtin_amdgcn_sched_barrier(0)
#define PG8_KOFF(u) ((Sched::SPLIT && (u).kh > 0) ? (size_t)K : (size_t)0)
#define PG8_ABASE(u) ((const GAS char*)g.A + (size_t)(u).pm * tstepA + (size_t)((u).pn / g.a_tpg) * (size_t)K * 2 + PG8_KOFF(u))
#define PG8_BBASE(u) ((const GAS char*)g.Bt + (size_t)(u).pn * tstepB + PG8_KOFF(u))
    Unit cur, nxt; int ui = 0;
    if (!S.next(0, cur)) return;
    f32x4 acc[2][2][4][2];
#pragma unroll
    for (int a = 0; a < 2; ++a)
#pragma unroll
        for (int b = 0; b < 2; ++b)
#pragma unroll
            for (int m = 0; m < 4; ++m)
#pragma unroll
                for (int n = 0; n < 2; ++n) acc[a][b][m][n] = (f32x4){0.f, 0.f, 0.f, 0.f};
    bf16x8 At[4][2], B0[2][2], B1[2][2];
    const GAS char* cA = PG8_ABASE(cur); const GAS char* cB = PG8_BBASE(cur);
    long hsA = (long)hstepA;
    if constexpr (Sched::SPLIT) { if (cur.kh > 0) { cA += hstepA; hsA = -(long)hstepA; } }
    S.a_ready(cur);
    int par = 0;
    E.prefetch(cur, (PG8_LAS float*)(pf + wid * 1024), lane, wr, wc);
    if constexpr (SP2) {
        PG8_STAGE(PG8_SB(0, 0), cB, voffB); PG8_STAGE(PG8_SB(0, 1), cB + hstepB, voffB); PG8_STAGE(PG8_SA(0, 0), cA, voffA); PG8_STAGE(PG8_SA(0, 1), cA + (Sched::SPLIT ? hsA : (long)hstepA), voffA);
        if (wr == 1) PG8_BAR;
        PG8_WAIT_V(2); PG8_BAR;
        PG8_STAGE(PG8_SB(1, 0), cB + kstep, voffB); PG8_STAGE(PG8_SA(1, 0), cA + kstep, voffA); PG8_STAGE(PG8_SB(1, 1), cB + hstepB + kstep, voffB);
        PG8_WAIT_V(6); PG8_BAR;
    } else {
        PG8_STAGE(PG8_SB(0, 0), cB, voffB); PG8_STAGE(PG8_SA(0, 0), cA, voffA); PG8_STAGE(PG8_SB(0, 1), cB + hstepB, voffB); PG8_STAGE(PG8_SA(0, 1), cA + hstepA, voffA);
        if (wr == 1) PG8_BAR;
        PG8_WAIT_V(4); PG8_BAR;
        PG8_STAGE(PG8_SB(1, 0), cB + kstep, voffB); PG8_STAGE(PG8_SA(1, 0), cA + kstep, voffA); PG8_STAGE(PG8_SB(1, 1), cB + hstepB + kstep, voffB);
        PG8_WAIT_V(6); PG8_BAR;
    }
    for (;;) {
        const bool has_next = S.next(ui + 1, nxt);
        const GAS char* nA = has_next ? PG8_ABASE(nxt) : cA; const GAS char* nB = has_next ? PG8_BBASE(nxt) : cB;
        if constexpr (Sched::SPLIT) { if (has_next && nxt.kh > 0) nA += hstepA; }
        int ntu = nt; if constexpr (Sched::SPLIT) { if (cur.kh >= 0) ntu = nt >> 1; }
        asm volatile(".p2align 6");
        for (int t = 0; t < ntu; t += 2) {
            const bool last = (t == ntu - 2);
            const GAS char* a1 = cA + (size_t)(t + 1) * kstep;
            const GAS char* a2 = last ? nA : cA + (size_t)(t + 2) * kstep; const GAS char* b2 = last ? nB : cB + (size_t)(t + 2) * kstep;
            const GAS char* a3 = a2 + kstep; const GAS char* b3 = b2 + kstep;
            if (last && has_next) S.a_ready(nxt);
            if constexpr (SP2) {
            PG8_LDB(B0, 0, 0); PG8_LDB(B1, 0, 1); PG8_SCHED; PG8_LDA(At, 0, 0); PG8_STAGE(PG8_SA(1, 1), a1 + (Sched::SPLIT ? hsA : (long)hstepA), voffA);
            PG8_WAIT_V(8); PG8_WAIT_L(0); PG8_BAR; PG8_MMA(0, 0, At, B0); PG8_MMA(0, 1, At, B1); PG8_BAR; PG8_SCHED;
            PG8_LDA(At, 0, 1); PG8_STAGE(PG8_SB(0, 0), b2, voffB); PG8_STAGE(PG8_SB(0, 1), b2 + hstepB, voffB); PG8_STAGE(PG8_SA(0, 0), a2, voffA);
            PG8_WAIT_V(8); PG8_WAIT_L(0); PG8_BAR; PG8_MMA(1, 0, At, B0); PG8_MMA(1, 1, At, B1); PG8_BAR; PG8_SCHED;
            PG8_LDB(B0, 1, 0); PG8_LDB(B1, 1, 1); PG8_SCHED; PG8_LDA(At, 1, 0); PG8_STAGE(PG8_SA(0, 1), a2 + (Sched::SPLIT ? ((last && has_next) ? (nxt.kh > 0 ? -(long)hstepA : (long)hstepA) : hsA) : (long)hstepA), voffA);
            PG8_WAIT_V(8); PG8_WAIT_L(0); PG8_BAR; PG8_MMA(0, 0, At, B0); PG8_MMA(0, 1, At, B1); PG8_BAR; PG8_SCHED;
            PG8_LDA(At, 1, 1); PG8_STAGE(PG8_SB(1, 0), b3, voffB); PG8_STAGE(PG8_SB(1, 1), b3 + hstepB, voffB); PG8_STAGE(PG8_SA(1, 0), a3, voffA);
            PG8_WAIT_V(8); PG8_WAIT_L(0); PG8_BAR; PG8_MMA(1, 0, At, B0); PG8_MMA(1, 1, At, B1); PG8_BAR; PG8_SCHED;
            } else {
            PG8_LDB(B0, 0, 0); PG8_SCHED; PG8_LDA(At, 0, 0); PG8_STAGE(PG8_SA(1, 1), a1 + hstepA, voffA);
            PG8_WAIT_L(8); PG8_BAR; PG8_WAIT_L(0); PG8_MMA(0, 0, At, B0); PG8_BAR; PG8_SCHED;
            PG8_LDB(B1, 0, 1); PG8_STAGE(PG8_SB(0, 0), b2, voffB);
            PG8_BAR; PG8_WAIT_L(0); PG8_MMA(0, 1, At, B1); PG8_BAR;
            PG8_LDA(At, 0, 1); PG8_STAGE(PG8_SA(0, 0), a2, voffA);
            PG8_BAR; PG8_WAIT_L(0); PG8_MMA(1, 0, At, B0); PG8_BAR; PG8_SCHED;
            PG8_STAGE(PG8_SB(0, 1), b2 + hstepB, voffB);
            PG8_WAIT_V(6); PG8_BAR; PG8_MMA(1, 1, At, B1); PG8_BAR;
            PG8_LDB(B0, 1, 0); PG8_SCHED; PG8_LDA(At, 1, 0); PG8_STAGE(PG8_SA(0, 1), a2 + hstepA, voffA);
            PG8_WAIT_L(8); PG8_BAR; PG8_WAIT_L(0); PG8_MMA(0, 0, At, B0); PG8_BAR; PG8_SCHED;
            PG8_LDB(B1, 1, 1); PG8_STAGE(PG8_SB(1, 0), b3, voffB);
            PG8_BAR; PG8_WAIT_L(0); PG8_MMA(0, 1, At, B1); PG8_BAR;
            PG8_LDA(At, 1, 1); PG8_STAGE(PG8_SA(1, 0), a3, voffA);
            PG8_BAR; PG8_WAIT_L(0); PG8_MMA(1, 0, At, B0); PG8_BAR; PG8_SCHED;
            PG8_STAGE(PG8_SB(1, 1), b3 + hstepB, voffB);
            PG8_WAIT_V(6); PG8_BAR; PG8_MMA(1, 1, At, B1); PG8_BAR;
            }
        }
        if constexpr (ALIGN_EPI) { if (wr == 0) PG8_BAR; }
        if constexpr (Sched::SPLIT) {
            int aim = 3, flip = 0;
            if (cur.kh >= 0) {
                const int kh = cur.kh, pair = S.c % S.R;
                const __amdgpu_buffer_rsrc_t rw = __builtin_amdgcn_make_buffer_rsrc((void*)(unsigned char*)(S.wsb + S.xoff + (size_t)(pair * 2 + (1 - kh)) * 131072), 0, 131072, 0x00020000);
                const __amdgpu_buffer_rsrc_t rr = __builtin_amdgcn_make_buffer_rsrc((void*)(unsigned char*)(S.wsb + S.xoff + (size_t)(pair * 2 + kh) * 131072), 0, 131072, 0x00020000);
                int tl = tid; asm volatile("" : "+v"(tl)); const int vo = tl * 16;
#pragma unroll
                for (int j = 0; j < 16; ++j) __builtin_amdgcn_raw_buffer_store_b128(__builtin_bit_cast(u32x4, acc[1][j >> 3][(j >> 1) & 3][j & 1]), rw, vo, j * 8192, 16);
                PG8_WAIT_V(0); PG8_BAR;
                if (tl == 0) { (void)__hip_atomic_fetch_add(&((unsigned*)(S.wsb + S.foff))[(pair * 2 + kh) * 16], 1u, __ATOMIC_RELAXED, __HIP_MEMORY_SCOPE_AGENT);
                    unsigned sp = 0; while (__hip_atomic_load(&((unsigned*)(S.wsb + S.foff))[(pair * 2 + (1 - kh)) * 16], __ATOMIC_RELAXED, __HIP_MEMORY_SCOPE_AGENT) == 0u) { __builtin_amdgcn_s_sleep(1); if (++sp > (1u << 22)) break; } }
                PG8_BAR;
#pragma unroll
                for (int j = 0; j < 16; ++j) acc[0][j >> 3][(j >> 1) & 3][j & 1] += __builtin_bit_cast(f32x4, __builtin_amdgcn_raw_buffer_load_b128(rr, vo, j * 8192, 16));
                aim = 1; flip = kh;
            }
            E(acc, cur, wr, wc, fr, fq, (const PG8_LAS float*)(pf + par * 8192 + wid * 1024), aim, flip); S.done(cur);
        } else
        if constexpr (!Epi::AFTER_DRAIN) { E(acc, cur, wr, wc, fr, fq, (const PG8_LAS float*)(pf + par * 8192 + wid * 1024)); S.done(cur); }
        if (!has_next) break;
#pragma unroll
        for (int a = 0; a < 2; ++a)
#pragma unroll
            for (int b = 0; b < 2; ++b)
#pragma unroll
                for (int m = 0; m < 4; ++m)
#pragma unroll
                    for (int n = 0; n < 2; ++n) acc[a][b][m][n] = (f32x4){0.f, 0.f, 0.f, 0.f};
        cur = nxt; cA = nA; cB = nB; if constexpr (Sched::SPLIT) hsA = cur.kh > 0 ? -(long)hstepA : (long)hstepA; ++ui; par ^= 1;
        E.prefetch(cur, (PG8_LAS float*)(pf + par * 8192 + wid * 1024), lane, wr, wc);
        if constexpr (ALIGN_EPI) { if (wr == 1) PG8_BAR; }
    }
    PG8_WAIT_V(0);
    if constexpr (!ALIGN_EPI) { if (wr == 0) PG8_BAR; }
    PG8_BAR;
#undef PG8_SA
#undef PG8_SB
#undef PG8_STAGE
#undef PG8_LDA
#undef PG8_LDB
#undef PG8_MMA
#undef PG8_WAIT_V
#undef PG8_WAIT_L
#undef PG8_BAR
#undef PG8_SCHED
#undef PG8_KOFF
#undef PG8_ABASE
#undef PG8_BBASE
}

template <class Epi, class Sched>
__device__ __forceinline__ void gemm_phase_strip(PG8_LAS unsigned char* lds, PG8_LAS unsigned char* slds, PG8_LAS unsigned char* pf, const Gemm g, const Sched& S, const Epi& E, int wv) {
    const int tid = tid_here(wv), wid = wv, lane = tid & 63, wr = wid >> 2, wc = wid & 3, fr = lane & 15, fq = lane >> 4;
    const int K = g.K, nt = K / BK, lda = g.lda;
    unsigned voffA[2], voffB[2], voffS;
#pragma unroll
    for (int i = 0; i < 2; ++i) { int R, C; stage_rc(tid * 16 + i * 8192, R, C); const int Rb = Epi::PERM ? ((R & ~31) + perm32(R & 31)) : R;
        voffA[i] = (unsigned)(R * lda + C) * 2u; voffB[i] = (unsigned)(Rb * K + C) * 2u; }
    { const int d = wid * 64 + lane, P = d >> 2, sub = d & 3, r = P >> 3, c = (P & 7) ^ (r & 7); voffS = (unsigned)(r * lda + c * 8 + sub * 2) * 2u; }
    const size_t kstep = (size_t)(BK * 2);
    const size_t hstepA = (size_t)HALF * lda * 2, hstepB = (size_t)HALF * K * 2;
    const size_t tstepA = 2 * hstepA, tstepB = 2 * hstepB;
    const unsigned ldsw = (unsigned)wid * 1024u, ldss = (unsigned)wid * 256u;
    const int aoff = lds_byte(wr * 64 + fr, fq * 8), boff = lds_byte(wc * 32 + fr, fq * 8);
#define PG8_SA(b, h) (((b) * 2 + (h)) * HTB)
#define PG8_SB(b, h) ((4 + (b) * 2 + (h)) * HTB)
#define PG8_STAGE(bufoff, gbase, voff) do { _Pragma("unroll") for (int _i = 0; _i < 2; ++_i) \
        __builtin_amdgcn_global_load_lds((const GAS unsigned*)((const GAS char*)(gbase) + (voff)[_i]), (PG8_LAS unsigned*)(lds + (bufoff) + ldsw + _i * 8192), 16, 0, 0); } while (0)
#define PG8_STAGE_S(b, gbase) __builtin_amdgcn_global_load_lds((const GAS unsigned*)((const GAS char*)(gbase) + voffS), (PG8_LAS unsigned*)(slds + (b) * 2048 + ldss), 4, 0, 0)
#define PG8_LDA(dst, b, h) do { _Pragma("unroll") for (int m = 0; m < 4; ++m) _Pragma("unroll") for (int k = 0; k < 2; ++k) dst[m][k] = *(const PG8_LAS bf16x8*)(lds + PG8_SA(b, h) + aoff + m * 2048 + k * 1024); } while (0)
#define PG8_LDB(dst, b, h) do { _Pragma("unroll") for (int n = 0; n < 2; ++n) _Pragma("unroll") for (int k = 0; k < 2; ++k) dst[n][k] = *(const PG8_LAS bf16x8*)(lds + PG8_SB(b, h) + boff + n * 2048 + k * 1024); } while (0)
#define PG8_LDS_S(dst, b) do { int _l = lane; asm volatile("" : "+v"(_l)); const int _fr = _l & 15, _fq = _l >> 4, _s0 = _fr * 128 + ((_fq ^ (_fr & 7)) << 4), _s1 = _fr * 128 + (((4 + _fq) ^ (_fr & 7)) << 4);        \
        dst[0] = *(const PG8_LAS bf16x8*)(slds + (b) * 2048 + _s0); dst[1] = *(const PG8_LAS bf16x8*)(slds + (b) * 2048 + _s1); } while (0)
#define PG8_MMA(ai, bj, At, Bt) do { __builtin_amdgcn_s_setprio(1); _Pragma("unroll") for (int m = 0; m < 4; ++m) _Pragma("unroll") for (int n = 0; n < 2; ++n) _Pragma("unroll") for (int k = 0; k < 2; ++k) \
        acc[ai][bj][m][n] = __builtin_amdgcn_mfma_f32_16x16x32_bf16(Bt[n][k], At[m][k], acc[ai][bj][m][n], 0, 0, 0); __builtin_amdgcn_s_setprio(0); } while (0)
#define PG8_MMA_S() do { __builtin_amdgcn_s_setprio(1); if (wr == 0) { _Pragma("unroll") for (int k = 0; k < 2; ++k) { accS[0] = __builtin_amdgcn_mfma_f32_16x16x32_bf16(B0[0][k], As[k], accS[0], 0, 0, 0); accS[1] = __builtin_amdgcn_mfma_f32_16x16x32_bf16(B1[0][k], As[k], accS[1], 0, 0, 0); } } \
        else { _Pragma("unroll") for (int k = 0; k < 2; ++k) { accS[0] = __builtin_amdgcn_mfma_f32_16x16x32_bf16(B0[1][k], As[k], accS[0], 0, 0, 0); accS[1] = __builtin_amdgcn_mfma_f32_16x16x32_bf16(B1[1][k], As[k], accS[1], 0, 0, 0); } } __builtin_amdgcn_s_setprio(0); } while (0)
#define PG8_WAIT_V(n) asm volatile("s_waitcnt vmcnt(" #n ")" ::: "memory")
#define PG8_WAIT_L(n) asm volatile("s_waitcnt lgkmcnt(" #n ")" ::: "memory")
#define PG8_BAR __builtin_amdgcn_s_barrier()
#define PG8_SCHED __builtin_amdgcn_sched_barrier(0)
#define PG8_KOFF(u) ((Sched::SPLIT && (u).kh > 0) ? (size_t)K : (size_t)0)
#define PG8_ABASE(u) ((const GAS char*)g.A + (size_t)(u).pm * tstepA + (size_t)((u).pn / g.a_tpg) * (size_t)K * 2 + PG8_KOFF(u))
#define PG8_BBASE(u) ((const GAS char*)g.Bt + (size_t)(u).pn * tstepB + PG8_KOFF(u))
#define PG8_SBASE(u) ((const GAS char*)g.A + (size_t)(u).srow * (size_t)lda * 2 + (size_t)((u).pn / g.a_tpg) * (size_t)K * 2 + PG8_KOFF(u))
#define PG8_HS (Sched::SPLIT ? hsA : (long)hstepA)
    Unit cur, nxt; int ui = 0;
    if (!S.next(0, cur)) return;
    f32x4 acc[2][2][4][2]; f32x4 accS[2];
#pragma unroll
    for (int a = 0; a < 2; ++a)
#pragma unroll
        for (int b = 0; b < 2; ++b)
#pragma unroll
            for (int m = 0; m < 4; ++m)
#pragma unroll
                for (int n = 0; n < 2; ++n) acc[a][b][m][n] = (f32x4){0.f, 0.f, 0.f, 0.f};
    accS[0] = (f32x4){0.f, 0.f, 0.f, 0.f}; accS[1] = (f32x4){0.f, 0.f, 0.f, 0.f};
    bf16x8 At[4][2], B0[2][2], B1[2][2], As[2];
    const GAS char* cA = PG8_ABASE(cur); const GAS char* cB = PG8_BBASE(cur); const GAS char* cS = PG8_SBASE(cur);
    long hsA = (long)hstepA;
    if constexpr (Sched::SPLIT) { if (cur.kh > 0) { cA += hstepA; hsA = -(long)hstepA; } }
    int par = 0;
    E.prefetch(cur, (PG8_LAS float*)(pf + wid * 1024), lane, wr, wc);
    PG8_STAGE(PG8_SB(0, 0), cB, voffB); PG8_STAGE(PG8_SB(0, 1), cB + hstepB, voffB); PG8_STAGE(PG8_SA(0, 0), cA, voffA); PG8_STAGE(PG8_SA(0, 1), cA + PG8_HS, voffA); PG8_STAGE_S(0, cS);
    if (wr == 1) PG8_BAR;
    PG8_WAIT_V(3); PG8_BAR;
    PG8_STAGE(PG8_SB(1, 0), cB + kstep, voffB); PG8_STAGE(PG8_SA(1, 0), cA + kstep, voffA); PG8_STAGE(PG8_SB(1, 1), cB + hstepB + kstep, voffB);
    PG8_WAIT_V(6); PG8_BAR;
    for (;;) {
        const bool has_next = S.next(ui + 1, nxt);
        const GAS char* nA = has_next ? PG8_ABASE(nxt) : cA; const GAS char* nB = has_next ? PG8_BBASE(nxt) : cB; const GAS char* nS = has_next ? PG8_SBASE(nxt) : cS;
        if constexpr (Sched::SPLIT) { if (has_next && nxt.kh > 0) nA += hstepA; }
        int ntu = nt; if constexpr (Sched::SPLIT) { if (cur.kh >= 0) ntu = nt >> 1; }
        asm volatile(".p2align 6");
        for (int t = 0; t < ntu; t += 2) {
            const bool last = (t == ntu - 2);
            const GAS char* a1 = cA + (size_t)(t + 1) * kstep; const GAS char* s1 = cS + (size_t)(t + 1) * kstep;
            const GAS char* a2 = last ? nA : cA + (size_t)(t + 2) * kstep; const GAS char* b2 = last ? nB : cB + (size_t)(t + 2) * kstep; const GAS char* s2 = last ? nS : cS + (size_t)(t + 2) * kstep;
            const GAS char* a3 = a2 + kstep; const GAS char* b3 = b2 + kstep;
            PG8_LDB(B0, 0, 0); PG8_LDB(B1, 0, 1); PG8_SCHED; PG8_LDA(At, 0, 0); PG8_STAGE(PG8_SA(1, 1), a1 + PG8_HS, voffA); PG8_STAGE_S(1, s1);
            PG8_WAIT_V(9); PG8_WAIT_L(0); PG8_BAR; PG8_MMA(0, 0, At, B0); PG8_MMA(0, 1, At, B1); PG8_BAR; PG8_SCHED;
            PG8_LDA(At, 0, 1); PG8_LDS_S(As, 0); PG8_STAGE(PG8_SB(0, 0), b2, voffB); PG8_STAGE(PG8_SB(0, 1), b2 + hstepB, voffB); PG8_STAGE(PG8_SA(0, 0), a2, voffA);
            PG8_WAIT_V(9); PG8_WAIT_L(0); PG8_BAR; PG8_MMA(1, 0, At, B0); PG8_MMA(1, 1, At, B1); PG8_MMA_S(); PG8_BAR; PG8_SCHED;
            PG8_LDB(B0, 1, 0); PG8_LDB(B1, 1, 1); PG8_SCHED; PG8_LDA(At, 1, 0); PG8_STAGE(PG8_SA(0, 1), a2 + (Sched::SPLIT ? ((last && has_next) ? (nxt.kh > 0 ? -(long)hstepA : (long)hstepA) : hsA) : (long)hstepA), voffA); PG8_STAGE_S(0, s2);
            PG8_WAIT_V(9); PG8_WAIT_L(0); PG8_BAR; PG8_MMA(0, 0, At, B0); PG8_MMA(0, 1, At, B1); PG8_BAR; PG8_SCHED;
            PG8_LDA(At, 1, 1); PG8_LDS_S(As, 1); PG8_STAGE(PG8_SB(1, 0), b3, voffB); PG8_STAGE(PG8_SB(1, 1), b3 + hstepB, voffB); PG8_STAGE(PG8_SA(1, 0), a3, voffA);
            PG8_WAIT_V(9); PG8_WAIT_L(0); PG8_BAR; PG8_MMA(1, 0, At, B0); PG8_MMA(1, 1, At, B1); PG8_MMA_S(); PG8_BAR; PG8_SCHED;
        }
        if (wr == 0) PG8_BAR;
        if constexpr (Sched::SPLIT) {
            int aim = 3, flip = 0;
            if (cur.kh >= 0) {
                const int kh = cur.kh, pair = S.c % S.R;
                const __amdgpu_buffer_rsrc_t rw = __builtin_amdgcn_make_buffer_rsrc((void*)(unsigned char*)(S.wsb + S.xoff + (size_t)(pair * 2 + (1 - kh)) * 147456), 0, 147456, 0x00020000);
                const __amdgpu_buffer_rsrc_t rr = __builtin_amdgcn_make_buffer_rsrc((void*)(unsigned char*)(S.wsb + S.xoff + (size_t)(pair * 2 + kh) * 147456), 0, 147456, 0x00020000);
                int tl = tid; asm volatile("" : "+v"(tl)); const int vo = tl * 16;
#pragma unroll
                for (int j = 0; j < 16; ++j) __builtin_amdgcn_raw_buffer_store_b128(__builtin_bit_cast(u32x4, acc[1][j >> 3][(j >> 1) & 3][j & 1]), rw, vo, j * 8192, 16);
                __builtin_amdgcn_raw_buffer_store_b128(__builtin_bit_cast(u32x4, accS[0]), rw, vo, 16 * 8192, 16); __builtin_amdgcn_raw_buffer_store_b128(__builtin_bit_cast(u32x4, accS[1]), rw, vo, 17 * 8192, 16);
                PG8_WAIT_V(0); PG8_BAR;
                if (tl == 0) { (void)__hip_atomic_fetch_add(&((unsigned*)(S.wsb + S.foff))[(pair * 2 + kh) * 16], 1u, __ATOMIC_RELAXED, __HIP_MEMORY_SCOPE_AGENT);
                    unsigned sp = 0; while (__hip_atomic_load(&((unsigned*)(S.wsb + S.foff))[(pair * 2 + (1 - kh)) * 16], __ATOMIC_RELAXED, __HIP_MEMORY_SCOPE_AGENT) == 0u) { __builtin_amdgcn_s_sleep(1); if (++sp > (1u << 22)) break; } }
                PG8_BAR;
#pragma unroll
                for (int j = 0; j < 16; ++j) acc[0][j >> 3][(j >> 1) & 3][j & 1] += __builtin_bit_cast(f32x4, __builtin_amdgcn_raw_buffer_load_b128(rr, vo, j * 8192, 16));
                accS[0] += __builtin_bit_cast(f32x4, __builtin_amdgcn_raw_buffer_load_b128(rr, vo, 16 * 8192, 16)); accS[1] += __builtin_bit_cast(f32x4, __builtin_amdgcn_raw_buffer_load_b128(rr, vo, 17 * 8192, 16));
                aim = 1; flip = kh;
            }
            E(acc, cur, wr, wc, fr, fq, (const PG8_LAS float*)(pf + par * 8192 + wid * 1024), aim, flip); if (cur.kh <= 0) E.strip(accS, cur, wr, wc, fr, fq);
        } else {
        E(acc, cur, wr, wc, fr, fq, (const PG8_LAS float*)(pf + par * 8192 + wid * 1024)); E.strip(accS, cur, wr, wc, fr, fq); }
        if (!has_next) break;
#pragma unroll
        for (int a = 0; a < 2; ++a)
#pragma unroll
            for (int b = 0; b < 2; ++b)
#pragma unroll
                for (int m = 0; m < 4; ++m)
#pragma unroll
                    for (int n = 0; n < 2; ++n) acc[a][b][m][n] = (f32x4){0.f, 0.f, 0.f, 0.f};
        accS[0] = (f32x4){0.f, 0.f, 0.f, 0.f}; accS[1] = (f32x4){0.f, 0.f, 0.f, 0.f};
        cur = nxt; cA = nA; cB = nB; cS = nS; if constexpr (Sched::SPLIT) hsA = cur.kh > 0 ? -(long)hstepA : (long)hstepA; ++ui; par ^= 1;
        E.prefetch(cur, (PG8_LAS float*)(pf + par * 8192 + wid * 1024), lane, wr, wc);
        if (wr == 1) PG8_BAR;
    }
    PG8_WAIT_V(0);
    PG8_BAR;
#undef PG8_SA
#undef PG8_SB
#undef PG8_STAGE
#undef PG8_STAGE_S
#undef PG8_LDA
#undef PG8_LDB
#undef PG8_LDS_S
#undef PG8_MMA
#undef PG8_MMA_S
#undef PG8_WAIT_V
#undef PG8_WAIT_L
#undef PG8_BAR
#undef PG8_SCHED
#undef PG8_ABASE
#undef PG8_BBASE
#undef PG8_SBASE
#undef PG8_KOFF
#undef PG8_HS
}
}

namespace att {
using s16x4  = __attribute__((ext_vector_type(4))) short;
using f32x16 = __attribute__((ext_vector_type(16))) float;
constexpr int D = 128, NW = 8, QBLK = 32, KVBLK = 64;
constexpr float SCALE = 0.088388347648318440f;
constexpr float THR = 8.f;
constexpr int SHM_V = KVBLK * D * 2, SHM_K = KVBLK * D * 2, SHM_WS = 2 * SHM_V + 2 * SHM_K, SHM_BIAS = SHM_WS + NW * 64 * 4, SHM_ATTN = SHM_BIAS + 2560, OST_HI = 71680  ;
constexpr int NBIAS = 15 * 31, BIAS_PAD = 48;
#define KSWZ(row, colB) ((row) * 256 + ((colB) ^ (((row) & 7) << 4)))
#define SBAR() __builtin_amdgcn_sched_barrier(0)
__device__ __forceinline__ int crow(int r, int hi) { return (r & 3) + 8 * (r >> 2) + 4 * hi; }
__device__ __forceinline__ unsigned cvtpk(float lo, float hi) { unsigned r; asm volatile("v_cvt_pk_bf16_f32 %0, %1, %2" : "=v"(r) : "v"(lo), "v"(hi)); return r; }

constexpr float QSCALE = SCALE * 1.4426950408889634f;
template <bool FIRST>
__device__ __forceinline__ void partialSM(f32x16& p0, f32x16& p1, float& m_reg, float& alpha) {
  constexpr float THRL = THR * 1.4426950408889634f;
  float pmax = p0[0];
#pragma unroll
  for (int r = 1; r < 16; ++r) pmax = fmaxf(pmax, p0[r]);
#pragma unroll
  for (int r = 0; r < 16; ++r) pmax = fmaxf(pmax, p1[r]);
  { auto rr = __builtin_amdgcn_permlane32_swap(__float_as_uint(pmax), __float_as_uint(pmax), false, false);
    pmax = fmaxf(__uint_as_float(rr[0]), __uint_as_float(rr[1])); }
  if (!FIRST && __builtin_expect(__all(pmax <= THRL), 1)) { alpha = 1.f; }
  else { const float delta = FIRST ? pmax : fmaxf(pmax, 0.f); alpha = FIRST ? 1.f : __builtin_amdgcn_exp2f(-delta); m_reg += delta;
#pragma unroll
    for (int r = 0; r < 16; ++r) { p0[r] -= delta; p1[r] -= delta; } }
#pragma unroll
  for (int r = 0; r < 16; ++r) p0[r] = __builtin_amdgcn_exp2f(p0[r]);
}
__device__ __forceinline__ void finishSM(f32x16& p0, f32x16& p1, float alpha, float& l_reg, bf16x8& pa0, bf16x8& pa1, bf16x8& pa2, bf16x8& pa3) {
#pragma unroll
  for (int r = 0; r < 16; ++r) p1[r] = __builtin_amdgcn_exp2f(p1[r]);
  float ps = 0;
#pragma unroll
  for (int r = 0; r < 16; ++r) ps += p0[r];
#pragma unroll
  for (int r = 0; r < 16; ++r) ps += p1[r];
  { auto rr = __builtin_amdgcn_permlane32_swap(__float_as_uint(ps), __float_as_uint(ps), false, false);
    ps = __uint_as_float(rr[0]) + __uint_as_float(rr[1]); }
  l_reg = l_reg * alpha + ps;
#define PK4(P, BASE, OUT) do { unsigned a0 = cvtpk(P[BASE + 0], P[BASE + 1]), a1 = cvtpk(P[BASE + 2], P[BASE + 3]);   \
    unsigned b0 = cvtpk(P[BASE + 4], P[BASE + 5]), b1 = cvtpk(P[BASE + 6], P[BASE + 7]);                              \
    auto r0 = __builtin_amdgcn_permlane32_swap(a0, b0, false, false); auto r1 = __builtin_amdgcn_permlane32_swap(a1, b1, false, false); \
    u32x4 w = {r0[0], r1[0], r0[1], r1[1]}; OUT = *reinterpret_cast<bf16x8*>(&w); } while (0)
  PK4(p0, 0, pa0); PK4(p0, 8, pa1); PK4(p1, 0, pa2); PK4(p1, 8, pa3);
#undef PK4
}
__device__ __forceinline__ void qkt(f32x16& p0, f32x16& p1, const char* Ks, const bf16x8* qr, int r32, int hi, float negm) {
#pragma unroll
  for (int r = 0; r < 16; ++r) { p0[r] = negm; p1[r] = negm; }
#pragma unroll
  for (int d0 = 0; d0 < 8; ++d0) { int cb = (d0 * 16 + hi * 8) * 2;
    bf16x8 b0 = *reinterpret_cast<const bf16x8*>(Ks + KSWZ(r32, cb));
    bf16x8 b1 = *reinterpret_cast<const bf16x8*>(Ks + KSWZ(32 + r32, cb));
    p0 = __builtin_amdgcn_mfma_f32_32x32x16_bf16(b0, qr[d0], p0, 0, 0, 0);
    p1 = __builtin_amdgcn_mfma_f32_32x32x16_bf16(b1, qr[d0], p1, 0, 0, 0); }
}
__device__ __forceinline__ int v_st(int k, int c) { const int kk = (k & ~0xC) | ((k & 4) << 1) | ((k & 8) >> 1); return ((kk >> 3) * 4 + (c >> 5)) * 512 + ((kk & 7) * 32 + (c & 31)) * 2; }
__device__ __forceinline__ int v_rd_base(int lane) { return ((lane & 3) << 3) | (((lane >> 2) & 3) << 6) | (((lane >> 4) & 1) << 5) | (((lane >> 5) & 1) << 8); }
constexpr int v_rd_off(int d0, int ks, int half) { return d0 * 512 + ks * 4096 + half * 2048; }
template <int OFF> __device__ __forceinline__ s16x4 tr_read(int vb) {
  s16x4 r; asm volatile("ds_read_b64_tr_b16 %0, %1 offset:%2" : "=&v"(r) : "v"(vb), "i"(OFF) : "memory"); return r;
}
template <int D0> __device__ __forceinline__ void pv_one(f32x16& od, int vb, bf16x8 pa0, bf16x8 pa1, bf16x8 pa2, bf16x8 pa3) {
  const s16x4 l0 = tr_read<v_rd_off(D0, 0, 0)>(vb), h0 = tr_read<v_rd_off(D0, 0, 1)>(vb), l1 = tr_read<v_rd_off(D0, 1, 0)>(vb), h1 = tr_read<v_rd_off(D0, 1, 1)>(vb);
  const s16x4 l2 = tr_read<v_rd_off(D0, 2, 0)>(vb), h2 = tr_read<v_rd_off(D0, 2, 1)>(vb), l3 = tr_read<v_rd_off(D0, 3, 0)>(vb), h3 = tr_read<v_rd_off(D0, 3, 1)>(vb);
  asm volatile("s_waitcnt lgkmcnt(0)" ::: "memory"); SBAR();
#define PK(L, H) (bf16x8){L[0], L[1], L[2], L[3], H[0], H[1], H[2], H[3]}
  od = __builtin_amdgcn_mfma_f32_32x32x16_bf16(pa0, PK(l0, h0), od, 0, 0, 0);
  od = __builtin_amdgcn_mfma_f32_32x32x16_bf16(pa1, PK(l1, h1), od, 0, 0, 0);
  od = __builtin_amdgcn_mfma_f32_32x32x16_bf16(pa2, PK(l2, h2), od, 0, 0, 0);
  od = __builtin_amdgcn_mfma_f32_32x32x16_bf16(pa3, PK(l3, h3), od, 0, 0, 0);
#undef PK
}
__device__ __forceinline__ void pv_d0(f32x16* o, int vb, bf16x8 pa0, bf16x8 pa1, bf16x8 pa2, bf16x8 pa3) {
  pv_one<0>(o[0], vb, pa0, pa1, pa2, pa3); pv_one<1>(o[1], vb, pa0, pa1, pa2, pa3); pv_one<2>(o[2], vb, pa0, pa1, pa2, pa3); pv_one<3>(o[3], vb, pa0, pa1, pa2, pa3);
}
__device__ __forceinline__ void nat_mask(f32x16& p0, f32x16& p1, const float* blp, unsigned mlo, unsigned mhi) {
#pragma unroll
  for (int r = 0; r < 16; ++r) {
    const int c = (r & 3) + 8 * (r >> 2);
    const float b0 = blp[c], b1 = blp[c + 32];
    p0[r] = ((mlo >> c) & 1u) ? p0[r] + b0 : -1e30f;
    p1[r] = ((mhi >> c) & 1u) ? p1[r] + b1 : -1e30f;
  }
}
template <bool NATM, int QN>
__device__ __forceinline__ void attn_unit(const gb16* __restrict__ Qb, const gb16* __restrict__ Kh, const gb16* __restrict__ Vh, gb16* __restrict__ Ob,
                                          int ldq, int ldk, int ldo, int n1, int off2, int NT, char* lds, int qrow0, int kr_lo, const gf32* qg, const gf32* rope, int qtok0, int wv) {
  const int tid = tid_here(wv), wid = wv, lane = tid & 63, r32 = lane & 31, hi = lane >> 5;
  char* V_lds = lds; char* K_lds = lds + 2 * SHM_V;
  float* ws = (float*)(lds + SHM_WS) + wid * 64; float* li_l = ws; float* al_l = ws + 32;
  const float* bl = (const float*)(lds + SHM_BIAS);
  float m_reg = 0.f, l_reg = 0; f32x16 o[4] = {}; bf16x8 qr[8];
  unsigned kso[2], vso[2];
#pragma unroll
  for (int i = 0; i < 2; ++i) { const int B = i * 8 + wid;
    const int row = 4 * B + (lane >> 4); kso[i] = (unsigned)(row * ldk + (((lane & 15) ^ (row & 7)) << 3)) * 2u;
    const int S = 2 * B + (lane >> 5), kk = (S >> 2) * 8 + ((lane >> 2) & 7), kt = (kk & ~0xC) | ((kk & 4) << 1) | ((kk & 8) >> 1), c = (S & 3) * 32 + (lane & 3) * 8; vso[i] = (unsigned)(kt * ldk + c) * 2u; }
#define KROW(j) ((j) < n1 ? (j) * KVBLK : off2 + ((j) - n1) * KVBLK)
#define KDMA(b, k0) do { const GAS char* _g = (const GAS char*)Kh + (size_t)(k0) * (size_t)ldk * 2; _Pragma("unroll") for (int _i = 0; _i < 2; ++_i) \
    __builtin_amdgcn_global_load_lds((const GAS unsigned*)(_g + kso[_i]), (LAS unsigned*)(K_lds + (b) * SHM_K + (_i * 8 + wid) * 1024), 16, 0, 0); } while (0)
#define VDMA(b, k0) do { const GAS char* _g = (const GAS char*)Vh + (size_t)(k0) * (size_t)ldk * 2; _Pragma("unroll") for (int _i = 0; _i < 2; ++_i) \
    __builtin_amdgcn_global_load_lds((const GAS unsigned*)(_g + vso[_i]), (LAS unsigned*)(V_lds + (b) * SHM_V + (_i * 8 + wid) * 1024), 16, 0, 0); } while (0)
  KDMA(0, KROW(0)); VDMA(0, KROW(0)); KDMA(1, KROW(1));
  const gb16* Qw = Qb + (long)(wid * QBLK + r32) * ldq + hi * 8;
#pragma unroll
  for (int d0 = 0; d0 < 8; ++d0) qr[d0] = *(const gbf16x8*)(Qw + d0 * 16);
  if constexpr (QN != 0) {
    float ss = 0.f;
#pragma unroll
    for (int d0 = 0; d0 < 8; ++d0) { const u32x4 w = *reinterpret_cast<const u32x4*>(&qr[d0]);
      ss += (bf_lo(w.x) * bf_lo(w.x) + bf_hi(w.x) * bf_hi(w.x)) + (bf_lo(w.y) * bf_lo(w.y) + bf_hi(w.y) * bf_hi(w.y)) + (bf_lo(w.z) * bf_lo(w.z) + bf_hi(w.z) * bf_hi(w.z)) + (bf_lo(w.w) * bf_lo(w.w) + bf_hi(w.w) * bf_hi(w.w)); }
    { auto rr = __builtin_amdgcn_permlane32_swap(__float_as_uint(ss), __float_as_uint(ss), false, false); ss = __uint_as_float(rr[0]) + __uint_as_float(rr[1]); }
    const float rstd = QSCALE * __builtin_amdgcn_rsqf(ss * (1.0f / D) + NORM_EPS);
    const int tok = qtok0 + wid * QBLK + r32, pr = tok >> 6, pc = tok & 63;
#pragma unroll
    for (int d0 = 0; d0 < 8; ++d0) { const u32x4 w = *reinterpret_cast<const u32x4*>(&qr[d0]);
      const f32x4 g0 = *(const gf32x4*)(qg + d0 * 16 + hi * 8), g1 = *(const gf32x4*)(qg + d0 * 16 + hi * 8 + 4);
      float y[8] = {bf_lo(w.x) * rstd * g0.x, bf_hi(w.x) * rstd * g0.y, bf_lo(w.y) * rstd * g0.z, bf_hi(w.y) * rstd * g0.w, bf_lo(w.z) * rstd * g1.x, bf_hi(w.z) * rstd * g1.y, bf_lo(w.w) * rstd * g1.z, bf_hi(w.w) * rstd * g1.w};
      if constexpr (QN == 2) { const int pos = d0 < 4 ? pr : pc, f0 = (d0 & 3) * 8 + hi * 4;
        const f32x4 t0 = *(const gf32x4*)(rope + 2 * (pos * 32 + f0)), t1 = *(const gf32x4*)(rope + 2 * (pos * 32 + f0) + 4);
        const float a0 = y[0] * t0.x - y[1] * t0.y, b0 = y[0] * t0.y + y[1] * t0.x, a1 = y[2] * t0.z - y[3] * t0.w, b1 = y[2] * t0.w + y[3] * t0.z;
        const float a2 = y[4] * t1.x - y[5] * t1.y, b2 = y[4] * t1.y + y[5] * t1.x, a3 = y[6] * t1.z - y[7] * t1.w, b3 = y[6] * t1.w + y[7] * t1.z;
        y[0] = a0; y[1] = b0; y[2] = a1; y[3] = b1; y[4] = a2; y[5] = b2; y[6] = a3; y[7] = b3; }
      u32x4 o4; o4.x = cvtpk(y[0], y[1]); o4.y = cvtpk(y[2], y[3]); o4.z = cvtpk(y[4], y[5]); o4.w = cvtpk(y[6], y[7]); qr[d0] = *reinterpret_cast<bf16x8*>(&o4); }
  }
  const int vb0 = (int)(uintptr_t)V_lds + v_rd_base(lane);
  const int nq_row = qrow0 + (wid >> 1), nq_col = 32 * (wid & 1) + r32, nrs = min(max(nq_row - 4, 0), 56);
  const unsigned long long nwin = (0xFFFFull << min(max(nq_col - 8, 0), 48)) >> (4 * hi);
  const unsigned nmlo = (unsigned)nwin, nmhi = (unsigned)(nwin >> 32);
  const float* nbl = bl + BIAS_PAD + 15 - nq_col + 4 * hi;
#define LANDED() do { asm volatile("s_waitcnt vmcnt(0)" ::: "memory"); __syncthreads(); } while (0)
#define RESC(a) do { if (__any((a) < 1.f)) { if (hi == 0) al_l[r32] = (a); asm volatile("s_waitcnt lgkmcnt(0)" ::: "memory"); \
    _Pragma("unroll") for (int d = 0; d < 4; ++d) _Pragma("unroll") for (int r = 0; r < 16; ++r) o[d][r] *= al_l[crow(r, hi)]; } } while (0)
#define NMASK(P0, P1, j) do { if (NATM) { if ((j) >= n1) { const int _kr = kr_lo + ((j) - n1); const bool _ok = (_kr >= nrs) && (_kr < nrs + 8); const int _dr = min(max(_kr - nq_row + 7, 0), 14); \
    nat_mask(P0, P1, nbl + _dr * 31, _ok ? nmlo : 0u, _ok ? nmhi : 0u); } } } while (0)
  f32x16 pA0, pA1, pB0, pB1; float alA, alB; bf16x8 pa0, pa1, pa2, pa3;
  LANDED();
  qkt(pA0, pA1, K_lds, qr, r32, hi, 0.f); NMASK(pA0, pA1, 0); partialSM<true>(pA0, pA1, m_reg, alA);
  __syncthreads();
#define OKT(j) (!NATM || (j) < n1 || (kr_lo + ((j) - n1) >= nrs && kr_lo + ((j) - n1) < nrs + 8))
  bool okA = true, okB;
  for (int j = 1; j + 1 < NT; j += 2) {
    KDMA(0, KROW(j + 1)); VDMA(1, KROW(j));
    okB = OKT(j);
    SBAR(); if (okB) qkt(pB0, pB1, K_lds + SHM_K, qr, r32, hi, -m_reg);
    if (okA) { finishSM(pA0, pA1, alA, l_reg, pa0, pa1, pa2, pa3); SBAR();
      pv_d0(o, vb0, pa0, pa1, pa2, pa3); }
    if (okB) { NMASK(pB0, pB1, j); partialSM<false>(pB0, pB1, m_reg, alB); RESC(alB); }
    LANDED();
    if (j + 2 < NT) KDMA(1, KROW(j + 2)); VDMA(0, KROW(j + 1));
    okA = OKT(j + 1);
    SBAR(); if (okA) qkt(pA0, pA1, K_lds, qr, r32, hi, -m_reg);
    if (okB) { finishSM(pB0, pB1, alB, l_reg, pa0, pa1, pa2, pa3); SBAR();
      pv_d0(o, vb0 + SHM_V, pa0, pa1, pa2, pa3); }
    if (okA) { NMASK(pA0, pA1, j + 1); partialSM<false>(pA0, pA1, m_reg, alA); RESC(alA); }
    LANDED();
  }
  VDMA(1, KROW(NT - 1));
  okB = OKT(NT - 1);
  SBAR(); if (okB) qkt(pB0, pB1, K_lds + SHM_K, qr, r32, hi, -m_reg);
  if (okA) { finishSM(pA0, pA1, alA, l_reg, pa0, pa1, pa2, pa3); SBAR();
    pv_d0(o, vb0, pa0, pa1, pa2, pa3); }
  if (okB) { NMASK(pB0, pB1, NT - 1); partialSM<false>(pB0, pB1, m_reg, alB); RESC(alB); }
  LANDED();
  if (okB) { finishSM(pB0, pB1, alB, l_reg, pa0, pa1, pa2, pa3); SBAR();
    pv_d0(o, vb0 + SHM_V, pa0, pa1, pa2, pa3); }
  if (hi == 0) li_l[r32] = l_reg; asm volatile("s_waitcnt lgkmcnt(0)" ::: "memory");
  float rli[16];
#pragma unroll
  for (int r = 0; r < 16; ++r) rli[r] = __builtin_amdgcn_rcpf(li_l[crow(r, hi)]);
  gb16* Ow = Ob + (long)(wid * QBLK) * ldo;
  { bf16_t* stg = (bf16_t*)(lds + (wid < 4 ? 2 * SHM_V + wid * 8192 : OST_HI + (wid - 4) * 8192));
#pragma unroll
    for (int r = 0; r < 16; ++r) { const int orow = crow(r, hi);
#pragma unroll
      for (int d0 = 0; d0 < 4; ++d0) { const unsigned pk = cvtpk(o[d0][r] * rli[r], 0.f); stg[orow * 128 + d0 * 32 + r32] = (bf16_t)(pk & 0xffffu); } }
    asm volatile("s_waitcnt lgkmcnt(0)" ::: "memory");
#pragma unroll
    for (int i = 0; i < 8; ++i) { const int row = i * 4 + (lane >> 4), ch = lane & 15; const u32x4 v = *(const u32x4*)(stg + row * 128 + ch * 8); *(gu32x4*)(Ow + (long)row * ldo + ch * 8) = v; } }
#undef OKT
#undef KROW
#undef KDMA
#undef VDMA
#undef LANDED
#undef RESC
#undef NMASK
}
}

constexpr size_t MiB = 1u << 20;
constexpr size_t WS_CTL = 0, CTL_ZERO_BYTES = 2 * MiB;
constexpr size_t WS_STATS = 64 * 1024;
constexpr size_t WS_BUP = 384 * 1024;
constexpr size_t WS_BQKV = 912 * 1024;
constexpr size_t WS_ADA = 2 * MiB;
constexpr size_t WS_ROPE = 3 * MiB;
constexpr size_t WS_XS = 4 * MiB;
constexpr size_t WS_H = 72 * MiB;
constexpr size_t WS_PO = 106 * MiB;
constexpr size_t WS_Q = 140 * MiB, WS_K = 174 * MiB, WS_V = 208 * MiB;
constexpr size_t WS_U = 242 * MiB;
constexpr size_t WS_W13 = 336 * MiB;
constexpr size_t WS_W2 = 512 * MiB;
constexpr size_t WS_PW = 600 * MiB;
constexpr size_t WS_GQKV = 604 * MiB, WS_GWO = 616 * MiB, WS_NQKV = 624 * MiB, WS_NWO = 648 * MiB, WS_END = 656 * MiB;
static_assert(WS_STATS + (size_t)9 * MROWS * 4 <= WS_BUP && WS_BUP + (size_t)4 * 3 * 2 * FF * 4 <= WS_BQKV && WS_BQKV + (size_t)2 * 3 * 6144 * 4 <= CTL_ZERO_BYTES, "ctl map");
static_assert(WS_XS + (size_t)MROWS * DM * 4 <= WS_H && WS_U + (size_t)MROWS * FF * 2 <= WS_W13 && WS_W13 + (size_t)4 * 2 * FF * DM * 2 <= WS_W2 && WS_W2 + (size_t)4 * DM * FF * 2 <= WS_PW, "ws map");
constexpr size_t CTL_FINAL_CNT = 49152;
constexpr size_t CTL_SPLIT_FLAGS2 = 0;
constexpr size_t CTL_SPLIT_FLAGS = 32768;
constexpr int CW_BAR = 4096;

constexpr int RING_BYTES = 131072, LDSCTL_OFF = RING_BYTES, MISC_OFF = LDSCTL_OFF + 320, STRIP_OFF = LDSCTL_OFF + 4096  , PF_OFF = 139264  , XK_OFF = 155648  , LDS_BYTES = 163840;

#define XB_TMO      128
#define XB_XCNT(j)  (256  + 64 * (j))
#define XB_XSUB(j)  (1280 + 64 * (j))
#define XB_XGEN(j)  (2304 + 64 * (j))
#define XB_TOP      3328
#define XB_TOPGEN   3392
#define XCD_BAR_WORDS 3456
#define XB_SPIN_CAP (1u << 18)
__device__ __forceinline__ unsigned xb_ld(unsigned* p)              { return __hip_atomic_load(p, __ATOMIC_RELAXED, __HIP_MEMORY_SCOPE_AGENT); }
__device__ __forceinline__ unsigned xb_add(unsigned* p, unsigned v) { return __hip_atomic_fetch_add(p, v, __ATOMIC_RELAXED, __HIP_MEMORY_SCOPE_AGENT); }
__device__ __forceinline__ unsigned xb_xcc_id() { return (unsigned)__builtin_amdgcn_s_getreg((3 << 11) | 20) & 0xFu; }
#define XB_SPIN(cond, bar) do { unsigned _sp = 0; while (cond) { __builtin_amdgcn_s_sleep(1); \
    if ((++_sp & 255u) == 0u) { if (xb_ld(&(bar)[XB_TMO])) break; if (_sp > XB_SPIN_CAP) { atomicAdd(&(bar)[XB_TMO], 1u); break; } } } } while (0)
struct XcdBarrier { unsigned* bar; unsigned x; volatile LAS unsigned* st; };
__device__ __forceinline__ XcdBarrier xcd_barrier_post(unsigned* bar, volatile LAS unsigned* st) {
    XcdBarrier b; b.bar = bar; b.x = xb_xcc_id(); b.st = st;
    if (threadIdx.x == 0) (void)xb_add(&bar[XB_XCNT(b.x)], 1u);
    return b;
}
__device__ __forceinline__ void xcd_barrier_complete(unsigned* bar, unsigned x, unsigned& nloc, unsigned& nx) {
    const unsigned G = gridDim.x * gridDim.y * gridDim.z;
    unsigned sum, cnt, mine, sp = 0u;
    for (;;) {
        sum = 0u; cnt = 0u; mine = 0u;
#pragma unroll
        for (unsigned j = 0; j < 16; ++j) { const unsigned c = xb_ld(&bar[XB_XCNT(j)]); sum += c; cnt += (c > 0u) ? 1u : 0u; mine = (j == x) ? c : mine; }
        if (sum == G) break;
        __builtin_amdgcn_s_sleep(1);
        if ((++sp & 255u) == 0u) { if (xb_ld(&bar[XB_TMO])) break; if (sp > XB_SPIN_CAP) { atomicAdd(&bar[XB_TMO], 1u); break; } }
    }
    nloc = mine > 0u ? mine : 1u; nx = cnt > 0u ? cnt : 1u;
}
__device__ __forceinline__ void xcd_barrier(const XcdBarrier& b, int tid) {
    asm volatile("s_waitcnt vmcnt(0)" ::: "memory");
    __syncthreads();
    if (tid == 0) {
        unsigned* bar = b.bar;
        __builtin_amdgcn_s_waitcnt(0);
        unsigned nloc = b.st[0], nx = b.st[1];
        if (nloc == 0u) { xcd_barrier_complete(bar, b.x, nloc, nx); b.st[0] = nloc; b.st[1] = nx; }
        const unsigned old = xb_add(&bar[XB_XSUB(b.x)], 1u);
        const unsigned gen = old / nloc;
        if (old + 1u == (gen + 1u) * nloc) {
            __builtin_amdgcn_fence(__ATOMIC_RELEASE, "agent");
            asm volatile("s_waitcnt vmcnt(0)" ::: "memory");
            const unsigned og = xb_add(&bar[XB_TOP], 1u);
            const unsigned tg = og / nx;
            if (og + 1u == (tg + 1u) * nx) xb_add(&bar[XB_TOPGEN], 1u);
            else XB_SPIN(xb_ld(&bar[XB_TOPGEN]) == tg, bar);
            __builtin_amdgcn_fence(__ATOMIC_ACQUIRE, "agent");
            xb_add(&bar[XB_XGEN(b.x)], 1u);
            asm volatile("s_waitcnt vmcnt(0)" ::: "memory");
        } else {
            XB_SPIN(xb_ld(&bar[XB_XGEN(b.x)]) == gen, bar);
            __builtin_amdgcn_fence(__ATOMIC_ACQUIRE, "agent");
            asm volatile("s_waitcnt vmcnt(0)" ::: "memory");
        }
    }
    __syncthreads();
}

struct Frame { LAS unsigned char* lds; GAS unsigned char* ws; gf32* out; int tid, lane, wave, vcu, G, bid; };
enum { I_X = 0, I_C, I_CTX, I_CCTX, I_ADAW, I_ADAB, I_NORMG, I_W1, I_W3, I_W2, I_POOLW, I_POOLLS, I_GWQ, I_GWK, I_GWV, I_GWO, I_GQN, I_GKN, I_NWQ, I_NWK, I_NWV, I_NWO, I_RPB, I_FINALG, I_COUNT };
constexpr int PTR_OFF = LDSCTL_OFF + 1024;
__device__ __forceinline__ const gf32* inp(const Frame& F, int k) {
    const unsigned long long v = ((volatile LAS unsigned long long*)(F.lds + PTR_OFF))[k];
    const unsigned lo = __builtin_amdgcn_readfirstlane((unsigned)v), hi = __builtin_amdgcn_readfirstlane((unsigned)(v >> 32));
    return (const gf32*)(((unsigned long long)hi << 32) | lo);
}
#define WSF(off) ((gf32*)(F.ws + (off)))
#define WSB(off) ((gb16*)(F.ws + (off)))
#define WSH(off) ((gh16*)(F.ws + (off)))

struct TrItem { const gf32* src; gb16* dst; int N, K, k0, n0, drow0; const gf32* sh; gf32* bias; int nb; };
__device__ __forceinline__ void tr_load(const TrItem& d, int ks, f32x4 (&a)[8], f32x4 (&b)[8], int lane) {
    const int q = lane >> 4, c = lane & 15;
#pragma unroll
    for (int it = 0; it < 8; ++it) { const int k = ks * 64 + 8 * it + 2 * q;
        a[it] = __builtin_nontemporal_load((const gf32x4*)(d.src + (size_t)(d.k0 + k) * d.N + d.n0 + 4 * c)); b[it] = __builtin_nontemporal_load((const gf32x4*)(d.src + (size_t)(d.k0 + k + 1) * d.N + d.n0 + 4 * c)); }
}
__device__ __forceinline__ void tr_half(const TrItem& d, int ks, const f32x4 (&a)[8], const f32x4 (&b)[8], LAS unsigned char* T, LAS float* SH, int lane) {
    const int q = lane >> 4, c = lane & 15;
    if (d.sh) {
        const gf32* shp = d.sh + ks * 64;
        SH[lane] = shp[lane]; SH[64 + lane] = shp[6 * DM + lane]; SH[128 + lane] = shp[12 * DM + lane];
        LDS_WAIT(); asm volatile("" ::: "memory");
        f32x4 p0 = {0.f, 0.f, 0.f, 0.f}, p1 = p0, p2 = p0;
#pragma unroll
        for (int it = 0; it < 8; ++it) { const f32x2 s0 = *(const LAS f32x2*)(SH + 8 * it + 2 * q), s1 = *(const LAS f32x2*)(SH + 64 + 8 * it + 2 * q), s2 = *(const LAS f32x2*)(SH + 128 + 8 * it + 2 * q);
            p0 += a[it] * s0.x + b[it] * s0.y; p1 += a[it] * s1.x + b[it] * s1.y; p2 += a[it] * s2.x + b[it] * s2.y; }
#pragma unroll
        for (int i = 0; i < 4; ++i) { p0[i] += __shfl_xor(p0[i], 16); p0[i] += __shfl_xor(p0[i], 32); p1[i] += __shfl_xor(p1[i], 16); p1[i] += __shfl_xor(p1[i], 32); p2[i] += __shfl_xor(p2[i], 16); p2[i] += __shfl_xor(p2[i], 32); }
        const float v0 = q == 0 ? p0[0] : q == 1 ? p0[1] : q == 2 ? p0[2] : p0[3], v1 = q == 0 ? p1[0] : q == 1 ? p1[1] : q == 2 ? p1[2] : p1[3], v2 = q == 0 ? p2[0] : q == 1 ? p2[1] : q == 2 ? p2[2] : p2[3];
        gf32* bp = d.bias + d.drow0 + 4 * c + q;
        pg8::atomic_add_f32(bp, v0); pg8::atomic_add_f32(bp + d.nb, v1); pg8::atomic_add_f32(bp + 2 * d.nb, v2);
        asm volatile("" ::: "memory");
    }
#pragma unroll
    for (int it = 0; it < 8; ++it) {
#pragma unroll
        for (int i = 0; i < 4; ++i) { const int n = 4 * c + i; const int byte = n * 256 + (((ks * 8 + it) ^ c) << 4) + q * 4;
            *(LAS unsigned*)(T + byte) = cvt_pk_bf16(a[it][i], b[it][i]); } }
}
__device__ __forceinline__ void tr_flush(const TrItem& d, LAS unsigned char* T, int lane) {
    LDS_WAIT(); asm volatile("" ::: "memory");
#pragma unroll
    for (int it2 = 0; it2 < 16; ++it2) { const int n = 4 * it2 + (lane >> 4), j = lane & 15;
        const u32x4 v = *(const LAS u32x4*)(T + n * 256 + ((j ^ ((n >> 2) & 15)) << 4));
        *(gu32x4*)(d.dst + (size_t)(d.drow0 + n) * d.K + d.k0 + 8 * j) = v; }
    LDS_WAIT(); asm volatile("" ::: "memory");
}
constexpr int TR_I_FF = (DM / 128) * (FF / 64);
constexpr int TR_N_FFN = 12 * TR_I_FF, TR_N_POOL = 8 * 32, TR_N_G = 512 + 128 + 128 + 512, TR_N_N = 4 * 512, TR_NITEMS = TR_N_FFN + TR_N_POOL + TR_N_G + TR_N_N;
__device__ __forceinline__ TrItem tr_decode(Frame& F, int it) {
    TrItem d; int r = it; d.sh = nullptr; d.bias = nullptr; d.nb = 0;
    if (r < TR_N_FFN) { const int m = r / TR_I_FF, rr = r % TR_I_FF, l = m / 3, wch = m % 3;
        if (wch < 2) { const int kb = rr / 88, nb = rr % 88, n0 = nb * 64;
            d.src = inp(F, wch == 0 ? I_W1 : I_W3) + (size_t)l * DM * FF; d.N = FF; d.dst = WSB(WS_W13) + (size_t)l * 2 * FF * DM; d.K = DM; d.k0 = kb * 128; d.n0 = n0; d.drow0 = (n0 / 128) * 256 + (n0 % 128) + wch * 128;
            d.sh = WSF(WS_ADA) + (size_t)(l * 3 * 6 + 3) * DM + d.k0; d.bias = WSF(WS_BUP) + (size_t)l * 3 * 2 * FF; d.nb = 2 * FF; }
        else { const int kb = rr / 32, nb = rr % 32;
            d.src = inp(F, I_W2) + (size_t)l * FF * DM; d.N = DM; d.dst = WSB(WS_W2) + (size_t)l * DM * FF; d.K = FF; d.k0 = kb * 128; d.n0 = nb * 64; d.drow0 = nb * 64; }
        return d; }
    r -= TR_N_FFN;
    if (r < TR_N_POOL) { const int jg = r / 32, rr = r % 32, j = jg / 4, gg = jg % 4, kb = rr / 8, nb = rr % 8;
        d.src = inp(F, I_POOLW) + (size_t)jg * 512 * 512; d.N = 512; d.dst = WSB(WS_PW) + (size_t)j * DM * 512; d.K = 512; d.k0 = kb * 128; d.n0 = nb * 64; d.drow0 = gg * 512 + nb * 64; return d; }
    r -= TR_N_POOL;
    if (r < TR_N_G) {
        if (r < 512) { d.src = inp(F, I_GWQ); d.N = DM; d.dst = WSB(WS_GQKV); d.K = DM; d.k0 = (r / 32) * 128; d.n0 = (r % 32) * 64; d.drow0 = d.n0; d.sh = WSF(WS_ADA) + (size_t)(1 * 3 * 6) * DM + d.k0; d.bias = WSF(WS_BQKV); d.nb = 6144; return d; } r -= 512;
        if (r < 128) { d.src = inp(F, I_GWK); d.N = 512; d.dst = WSB(WS_GQKV); d.K = DM; d.k0 = (r / 8) * 128; d.n0 = (r % 8) * 64; d.drow0 = 2048 + d.n0; d.sh = WSF(WS_ADA) + (size_t)(1 * 3 * 6) * DM + d.k0; d.bias = WSF(WS_BQKV); d.nb = 6144; return d; } r -= 128;
        if (r < 128) { d.src = inp(F, I_GWV); d.N = 512; d.dst = WSB(WS_GQKV); d.K = DM; d.k0 = (r / 8) * 128; d.n0 = (r % 8) * 64; d.drow0 = 2560 + d.n0; d.sh = WSF(WS_ADA) + (size_t)(1 * 3 * 6) * DM + d.k0; d.bias = WSF(WS_BQKV); d.nb = 6144; return d; } r -= 128;
        d.src = inp(F, I_GWO); d.N = DM; d.dst = WSB(WS_GWO); d.K = DM; d.k0 = (r / 32) * 128; d.n0 = (r % 32) * 64; d.drow0 = d.n0; return d; }
    r -= TR_N_G;
    { const int which = r / 512, rr = r % 512; d.N = DM; d.K = DM; d.k0 = (rr / 32) * 128; d.n0 = (rr % 32) * 64;
      if (which == 0) { d.src = inp(F, I_NWQ); d.dst = WSB(WS_NQKV); d.drow0 = d.n0; }
      else if (which == 1) { d.src = inp(F, I_NWK); d.dst = WSB(WS_NQKV); d.drow0 = 2048 + d.n0; }
      else if (which == 2) { d.src = inp(F, I_NWV); d.dst = WSB(WS_NQKV); d.drow0 = 4096 + d.n0; }
      else { d.src = inp(F, I_NWO); d.dst = WSB(WS_NWO); d.drow0 = d.n0; }
      if (which < 3) { d.sh = WSF(WS_ADA) + (size_t)(2 * 3 * 6) * DM + d.k0; d.bias = WSF(WS_BQKV) + (size_t)3 * 6144; d.nb = 6144; } }
    return d;
}

__device__ __forceinline__ void p0a_prologue(Frame& F) {
    {
        const gf32* cvec = inp(F, I_C); const gf32* cctx = inp(F, I_CCTX); const gf32* ada_w = inp(F, I_ADAW); const gf32* ada_b = inp(F, I_ADAB); gf32* ada = WSF(WS_ADA);
        LAS float* S = (LAS float*)(F.lds);
        LAS float* red0 = (LAS float*)(F.lds + 24576);
        int rpar = 0;
        for (int i = F.tid; i < 3 * DM; i += 512) { const int v = i / DM, k = i % DM; const float cv = v < 2 ? cvec[v * DM + k] : cctx[k]; S[i] = cv / (1.0f + __expf(-cv)); }
        __syncthreads();
        const int kq = F.lane >> 4, cq = F.lane & 15;
        for (int u = F.bid; u < DEPTH * 192; u += F.G) {
            const int l = u / 192, n0 = (u % 192) * 64;
            const gf32* Wp = ada_w + (size_t)l * DM * 6 * DM + n0 + 4 * cq;
            f32x4 a0 = {0.f, 0.f, 0.f, 0.f}, a1 = a0, a2 = a0;
            f32x4 wA[8], wB[8];
            const int kb0 = F.wave * 256 + kq;
#define ADA_LD(dst, g) do { _Pragma("unroll") for (int i = 0; i < 8; ++i) dst[i] = __builtin_nontemporal_load((const gf32x4*)(Wp + (size_t)(kb0 + 4 * (8 * (g) + i)) * (6 * DM))); } while (0)
#define ADA_FMA(src, g) do { _Pragma("unroll") for (int i = 0; i < 8; ++i) { const int k = kb0 + 4 * (8 * (g) + i); a0 += src[i] * S[k]; a1 += src[i] * S[DM + k]; a2 += src[i] * S[2 * DM + k]; } } while (0)
            ADA_LD(wA, 0);
#pragma unroll 1
            for (int g = 0; g < 8; g += 2) { ADA_LD(wB, g + 1); ADA_FMA(wA, g); if (g + 2 < 8) ADA_LD(wA, g + 2); ADA_FMA(wB, g + 1); }
#undef ADA_LD
#undef ADA_FMA
#pragma unroll
            for (int i = 0; i < 4; ++i) { a0[i] += __shfl_xor(a0[i], 16); a0[i] += __shfl_xor(a0[i], 32); a1[i] += __shfl_xor(a1[i], 16); a1[i] += __shfl_xor(a1[i], 32); a2[i] += __shfl_xor(a2[i], 16); a2[i] += __shfl_xor(a2[i], 32); }
            LAS float* red = red0 + rpar * 1536; rpar ^= 1;
            if (kq == 0) {
#pragma unroll
                for (int i = 0; i < 4; ++i) { red[(F.wave * 3 + 0) * 64 + 4 * cq + i] = a0[i]; red[(F.wave * 3 + 1) * 64 + 4 * cq + i] = a1[i]; red[(F.wave * 3 + 2) * 64 + 4 * cq + i] = a2[i]; } }
            __syncthreads();
            if (F.tid < 192) { const int v = F.tid / 64, cc = F.tid % 64; float s = ada_b[l * 6 * DM + n0 + cc];
#pragma unroll
                for (int w = 0; w < 8; ++w) s += red[(w * 3 + v) * 64 + cc];
                ada[(size_t)(l * 3 + v) * 6 * DM + n0 + cc] = s; }
        }
    }
    {
        const size_t gt = (size_t)F.bid * 512 + F.tid, NT = (size_t)F.G * 512;
        gf32* rope = WSF(WS_ROPE);
        for (size_t i = gt; i < 64 * 32; i += NT) { const int p = (int)i / 32, j = (int)i % 32; const float inv = powf(10000.0f, -(float)(2 * j) / 64.0f); const float ang = (float)p * inv;
            rope[2 * i] = cosf(ang); rope[2 * i + 1] = sinf(ang); }
    }
}
__device__ __forceinline__ void p0b_prologue(Frame& F) {
    const int gw = F.vcu * 8 + F.wave, NGW = F.G * 8;
    {
        LAS unsigned char* T = F.lds + F.wave * 16384; LAS float* SH = (LAS float*)(F.lds + 139264 + F.wave * 1024);
        for (int it = gw; it < TR_NITEMS; it += NGW) {
            const TrItem d = tr_decode(F, it);
            f32x4 a0[8], b0[8], a1[8], b1[8];
            tr_load(d, 0, a0, b0, F.lane); tr_load(d, 1, a1, b1, F.lane);
            tr_half(d, 0, a0, b0, T, SH, F.lane); tr_half(d, 1, a1, b1, T, SH, F.lane);
            tr_flush(d, T, F.lane);
        }
    }
    {
        const gf32* g = inp(F, I_NORMG); const gf32* xin = inp(F, I_X); const gf32* cin = inp(F, I_CTX); const gf32* adab = WSF(WS_ADA); gb16* H = WSB(WS_H); gf32* stats = WSF(WS_STATS);
        const int gwb = F.bid * 8 + F.wave;
        for (int row = gwb; row < MROWS; row += NGW) {
            const int b = row / RB, rr = row % RB, vec = rr < CTXL ? 2 : b;
            const gf32* sc = adab + (size_t)(vec * 6 + 1) * DM;
            const gf32* xrow = rr < CTXL ? cin + ((size_t)b * CTXL + rr) * DM : xin + ((size_t)b * SEQ + (rr - CTXL)) * DM;
            const gf32x4* xr = (const gf32x4*)xrow + F.lane;
            f32x4 v[8]; float ss = 0.f;
#pragma unroll
            for (int j = 0; j < 8; ++j) { v[j] = xr[64 * j]; ss += (v[j].x * v[j].x + v[j].y * v[j].y) + (v[j].z * v[j].z + v[j].w * v[j].w); }
            ss = wave_sum(ss); if (F.lane == 0) stats[row] = ss;
            gu32x2* x8 = (gu32x2*)(WSH(WS_XS) + (size_t)row * DM) + F.lane;
#pragma unroll
            for (int j = 0; j < 8; ++j) {
                u32x2 xw; xw.x = pk_h16(v[j].x, v[j].y); xw.y = pk_h16(v[j].z, v[j].w); x8[64 * j] = xw; }
        }
    }
}

constexpr int POOL_R = 18, POOL_RL = (SEQ + POOL_R - 1) / POOL_R, POOL_RC = (CTXL + POOL_R - 1) / POOL_R;
template <int HW>
__device__ __forceinline__ void pool_task(const gh16* __restrict__ H, gb16* __restrict__ PO, const gf32* __restrict__ stats, const gf32* __restrict__ gng, const gf32* __restrict__ gsc, int seq0, int n, int t0, int len, int c, int lane) {
    constexpr int NR = POOL_R + 2 * HW;
    const unsigned colb = (unsigned)(c * 64 + lane) * 16u;
    u32x4 v[NR];
#pragma unroll
    for (int i = 0; i < NR; ++i) { const int tt = min(max(t0 - HW + i, 0), n - 1);
        const GAS char* rb = (const GAS char*)(H + (size_t)(seq0 + tt) * DM);
        asm volatile("s_nop 4\n\tglobal_load_dwordx4 %0, %1, %2" : "=v"(v[i]) : "v"(colb), "s"(rb) : "memory"); }
    asm volatile("s_waitcnt vmcnt(0)" ::: "memory");
#pragma unroll
    for (int i = 0; i < NR; ++i) asm volatile("" : "+v"(v[i]));
    float rl = 0.f;
    { const int tt = t0 - HW + lane; if (lane < NR && tt >= 0 && tt < n) rl = pg8::rstd_of(stats[seq0 + tt]); }
    float gmv[8];
    { const f32x4 g0 = *(const gf32x4*)(gng + c * 512 + lane * 8), g1 = *(const gf32x4*)(gng + c * 512 + lane * 8 + 4), s0 = *(const gf32x4*)(gsc + c * 512 + lane * 8), s1 = *(const gf32x4*)(gsc + c * 512 + lane * 8 + 4);
      gmv[0] = g0.x * (s0.x + 1.0f); gmv[1] = g0.y * (s0.y + 1.0f); gmv[2] = g0.z * (s0.z + 1.0f); gmv[3] = g0.w * (s0.w + 1.0f); gmv[4] = g1.x * (s1.x + 1.0f); gmv[5] = g1.y * (s1.y + 1.0f); gmv[6] = g1.z * (s1.z + 1.0f); gmv[7] = g1.w * (s1.w + 1.0f); }
    float a[8];
#pragma unroll
    for (int e = 0; e < 8; ++e) a[e] = 0.f;
#define POOL_ACC(i, sgn) do { const float _r = (sgn) * __uint_as_float(__builtin_amdgcn_readlane(__float_as_uint(rl), (i))); u32x4 _t = v[i]; asm volatile("" : "+v"(_t)); a[0] += _r * h16_lo(_t.x); a[1] += _r * h16_hi(_t.x); a[2] += _r * h16_lo(_t.y); a[3] += _r * h16_hi(_t.y); \
        a[4] += _r * h16_lo(_t.z); a[5] += _r * h16_hi(_t.z); a[6] += _r * h16_lo(_t.w); a[7] += _r * h16_hi(_t.w); } while (0)
#pragma unroll
    for (int i = 0; i < 2 * HW; ++i) POOL_ACC(i, 1.0f);
#pragma unroll
    for (int k = 0; k < POOL_R; ++k) {
        if (k < len) { const int t = t0 + k; const int lo = max(t - HW, 0), hi = min(t + HW, n); const float rc = __builtin_amdgcn_rcpf((float)(hi - lo)), ro = __uint_as_float(__builtin_amdgcn_readlane(__float_as_uint(rl), k + HW));
            u32x4 own = v[k + HW]; asm volatile("" : "+v"(own));
            u32x4 w; w.x = cvt_pk_bf16((a[0] * rc - ro * h16_lo(own.x)) * gmv[0], (a[1] * rc - ro * h16_hi(own.x)) * gmv[1]); w.y = cvt_pk_bf16((a[2] * rc - ro * h16_lo(own.y)) * gmv[2], (a[3] * rc - ro * h16_hi(own.y)) * gmv[3]);
            w.z = cvt_pk_bf16((a[4] * rc - ro * h16_lo(own.z)) * gmv[4], (a[5] * rc - ro * h16_hi(own.z)) * gmv[5]); w.w = cvt_pk_bf16((a[6] * rc - ro * h16_lo(own.w)) * gmv[6], (a[7] * rc - ro * h16_hi(own.w)) * gmv[7]);
            GAS char* ob = (GAS char*)(PO + (size_t)(seq0 + t) * DM); asm volatile("s_nop 4\n\tglobal_store_dwordx4 %0, %1, %2\n\ts_nop 1" :: "v"(colb), "v"(w), "s"(ob) : "memory"); }
        if (k + 1 < POOL_R) { POOL_ACC(k + 2 * HW, 1.0f); POOL_ACC(k, -1.0f); }
    }
#undef POOL_ACC
}
__device__ __forceinline__ void phase_pool(Frame& F, const gf32* stats, bool lat_only, int layer) {
    const gh16* H = WSH(WS_XS); gb16* PO = WSB(WS_PO);
    const gf32* gng = inp(F, I_NORMG) + (size_t)(layer * 2) * DM; const gf32* ada1 = WSF(WS_ADA) + (size_t)layer * 3 * 6 * DM + DM;
    const int gw = F.bid * 8 + F.wave, NGW = F.G * 8;
    const int ntask = (2 * POOL_RL + (lat_only ? 0 : 2 * POOL_RC)) * 4;
    for (int task = gw; task < ntask; task += NGW) {
        const int c = task & 3; int ridx = task >> 2; int seq0, n, t0;
        int vec;
        if (ridx < 2 * POOL_RL) { const int b = ridx / POOL_RL; seq0 = b * RB + CTXL; n = SEQ; t0 = (ridx % POOL_RL) * POOL_R; vec = b; }
        else { ridx -= 2 * POOL_RL; const int b = ridx / POOL_RC; seq0 = b * RB; n = CTXL; t0 = (ridx % POOL_RC) * POOL_R; vec = 2; }
        const gf32* gsc = ada1 + (size_t)vec * 6 * DM;
        const int len = min(POOL_R, n - t0);
        int ln = F.lane; asm volatile("" : "+v"(ln));
        if (c == 0) pool_task<1>(H, PO, stats, gng, gsc, seq0, n, t0, len, c, ln);
        else if (c == 1) pool_task<2>(H, PO, stats, gng, gsc, seq0, n, t0, len, c, ln);
        else if (c == 2) pool_task<4>(H, PO, stats, gng, gsc, seq0, n, t0, len, c, ln);
        else pool_task<8>(H, PO, stats, gng, gsc, seq0, n, t0, len, c, ln);
    }
}
__device__ __forceinline__ void phase_krope(Frame& F) {
    const int gw = F.bid * 8 + F.wave, NGW = F.G * 8;
    const f32x2 gk = *(const gf32x2*)(inp(F, I_GKN) + 2 * F.lane);
    gb16* Kp = WSB(WS_K); const gf32* rope = WSF(WS_ROPE);
    for (int row = gw; row < MROWS; row += NGW) {
        const int rr = row % RB; const bool lat = rr >= CTXL; const int t = rr - CTXL;
        float cs = 1.f, sn = 0.f;
        if (lat) { const int pos = F.lane < 32 ? (t >> 6) : (t & 63); const f32x2 r2 = *(const gf32x2*)(rope + 2 * (pos * 32 + (F.lane & 31))); cs = r2.x; sn = r2.y; }
        unsigned u[KVH];
#pragma unroll
        for (int hh = 0; hh < KVH; ++hh) u[hh] = *((const gu32*)(Kp + (size_t)row * 512 + hh * HD) + F.lane);
#pragma unroll
        for (int hh = 0; hh < KVH; ++hh) { const float x1 = bf_lo(u[hh]), x2 = bf_hi(u[hh]);
            const float rstd = __builtin_amdgcn_rsqf(wave_sum(x1 * x1 + x2 * x2) * (1.0f / HD) + NORM_EPS);
            const float y1 = x1 * rstd * gk.x, y2 = x2 * rstd * gk.y;
            *((gu32*)(Kp + (size_t)row * 512 + hh * HD) + F.lane) = cvt_pk_bf16(y1 * cs - y2 * sn, y1 * sn + y2 * cs); }
    }
}
__device__ __forceinline__ void phase_final(Frame& F) {
    const gh16* xs = WSH(WS_XS); const gf32* fg = inp(F, I_FINALG);
    const int gw = F.bid * 8 + F.wave, NGW = F.G * 8;
    for (int r = gw; r < NB * SEQ; r += NGW) {
        const int b = r / SEQ, t = r % SEQ; const int row = b * RB + CTXL + t;
        const gu32x4* xr = (const gu32x4*)(xs + (size_t)row * DM) + F.lane;
        f32x4 v[8]; float s = 0.f;
#pragma unroll
        for (int j = 0; j < 4; ++j) { const u32x4 h = xr[64 * j]; v[2 * j] = (f32x4){h16_lo(h.x), h16_hi(h.x), h16_lo(h.y), h16_hi(h.y)}; v[2 * j + 1] = (f32x4){h16_lo(h.z), h16_hi(h.z), h16_lo(h.w), h16_hi(h.w)};
            s += (v[2 * j].x * v[2 * j].x + v[2 * j].y * v[2 * j].y) + (v[2 * j].z * v[2 * j].z + v[2 * j].w * v[2 * j].w) + (v[2 * j + 1].x * v[2 * j + 1].x + v[2 * j + 1].y * v[2 * j + 1].y) + (v[2 * j + 1].z * v[2 * j + 1].z + v[2 * j + 1].w * v[2 * j + 1].w); }
        const float rstd = __builtin_amdgcn_rsqf(wave_sum(s) * (1.0f / DM) + NORM_EPS);
        gf32x4* o = (gf32x4*)(F.out + (size_t)r * DM) + 2 * F.lane;
#pragma unroll
        for (int j = 0; j < 4; ++j) { const int d = (F.lane + 64 * j) * 8;
            o[128 * j] = (v[2 * j] * rstd) * *(const gf32x4*)(fg + d); o[128 * j + 1] = (v[2 * j + 1] * rstd) * *(const gf32x4*)(fg + d + 4); }
    }
}
__device__ __forceinline__ void phase_attn_gqa(Frame& F, char* lds) {
    const gb16* Q = WSB(WS_Q); const gb16* Kp = WSB(WS_K); const gb16* Vp = WSB(WS_V); gb16* PO = WSB(WS_PO); const gf32* gqn = inp(F, I_GQN); const gf32* rope = WSF(WS_ROPE);
    for (int u = F.vcu; u < 512 + 32; u += F.G) {
        __syncthreads();
        if (u < 512) { const int b = u >> 8, rem = u & 255, kvh = rem >> 6, gq = (rem >> 4) & 3, qb = rem & 15, h = kvh * 4 + gq;
            const size_t qrow = (size_t)b * RB + CTXL + (size_t)qb * 256;
            att::attn_unit<false, 2>(Q + qrow * DM + h * HD, Kp + (size_t)b * RB * 512 + kvh * HD, Vp + (size_t)b * RB * 512 + kvh * HD, PO + qrow * DM + h * HD, DM, 512, DM, RB / 64, 0, RB / 64, lds, 0, 0, gqn, rope, qb * 256, F.wave); }
        else { const int v = u - 512, b = v >> 4, h = v & 15, kvh = h >> 2; const size_t qrow = (size_t)b * RB;
            att::attn_unit<false, 1>(Q + qrow * DM + h * HD, Kp + (size_t)b * RB * 512 + kvh * HD, Vp + (size_t)b * RB * 512 + kvh * HD, PO + qrow * DM + h * HD, DM, 512, DM, CTXL / 64, 0, CTXL / 64, lds, 0, 0, gqn, rope, 0, F.wave); }
    }
}
__device__ __forceinline__ void phase_attn_nat(Frame& F, char* lds) {
    const gb16* Q = WSB(WS_Q); const gb16* Kp = WSB(WS_K); const gb16* Vp = WSB(WS_V); gb16* PO = WSB(WS_PO); const gf32* rpb = inp(F, I_RPB);
    for (int u = F.vcu; u < 512; u += F.G) {
        __syncthreads();
        { const int b = u >> 8, h = (u >> 4) & 15, qb = u & 15, r0 = 4 * qb;
            const int kr_lo = min(max(r0 - 4, 0), 56), kr_hi = min(max(r0 + 3 - 4, 0), 56) + 8; int n2 = kr_hi - kr_lo; n2 += (n2 & 1);
            { int bt = F.tid; asm volatile("" : "+v"(bt));
              if (bt < att::NBIAS) ((float*)(lds + att::SHM_BIAS))[att::BIAS_PAD + bt] = rpb[h * att::NBIAS + bt] * 1.4426950408889634f; }
            const size_t qrow = (size_t)b * RB + CTXL + (size_t)qb * 256;
            att::attn_unit<true, 0>(Q + qrow * DM + h * HD, Kp + (size_t)b * RB * DM + h * HD, Vp + (size_t)b * RB * DM + h * HD, PO + qrow * DM + h * HD, DM, DM, DM, CTXL / 64, CTXL + kr_lo * 64, CTXL / 64 + n2, lds, r0, kr_lo, nullptr, nullptr, 0, F.wave); }
    }
    int v, vstep;
    if (F.G == 256) { const int e = F.vcu & 15; v = (e == 0 || e == 15) ? (F.vcu >> 4) * 2 + (e == 15 ? 1 : 0) : 32; vstep = 32; } else { v = F.vcu; vstep = F.G; }
    for (; v < 32; v += vstep) {
        __syncthreads();
        const int b = v >> 4, h = v & 15; const size_t qrow = (size_t)b * RB;
        att::attn_unit<false, 0>(Q + qrow * DM + h * HD, Kp + (size_t)b * RB * DM + h * HD, Vp + (size_t)b * RB * DM + h * HD, PO + qrow * DM + h * HD, DM, DM, DM, CTXL / 64, 0, CTXL / 64, lds, 0, 0, nullptr, nullptr, 0, F.wave);
    }
}

struct Args { const float* in[24]; float* out; unsigned char* ws; int gp_lo, gp_hi; };
static_assert(sizeof(Args) == 24 * 8 + 8 + 8 + 8, "Args has no padding");
constexpr int GP_END = 35;

__global__ void __launch_bounds__(512, 2) fwd_kernel(Args args) {
    extern __shared__ __attribute__((aligned(16))) unsigned char lds[];
    Frame F;
    F.lds = (LAS unsigned char*)lds;
    F.tid = threadIdx.x; F.lane = F.tid & 63; F.wave = __builtin_amdgcn_readfirstlane(F.tid >> 6);
    F.G = gridDim.x; { const int bx = blockIdx.x; F.vcu = (F.G % 8 == 0) ? (bx % 8) * (F.G / 8) + bx / 8 : bx; }
    F.out = (gf32*)args.out; F.ws = (GAS unsigned char*)args.ws;
    unsigned char* ws = args.ws;
    for (int u = F.tid; u < (LDS_BYTES - LDSCTL_OFF) / 4; u += 512) ((LAS unsigned*)(F.lds + LDSCTL_OFF))[u] = 0u;
    __syncthreads();
    if (F.tid < I_COUNT) ((LAS unsigned long long*)(F.lds + PTR_OFF))[F.tid] = ((const unsigned long long*)__builtin_amdgcn_kernarg_segment_ptr())[F.tid];
    __syncthreads();
    const int lo = args.gp_lo, hi = args.gp_hi;
    unsigned* barw = (unsigned*)(ws + WS_CTL) + CW_BAR;
    XcdBarrier bar; bar.bar = barw; bar.x = 0; bar.st = nullptr;
    if (hi - lo > 1) bar = xcd_barrier_post(barw, (volatile LAS unsigned*)(F.lds + MISC_OFF) + 8);
    bool first = true;
#define PH_BEGIN(gp) if (lo <= (gp) && (gp) < hi) { if (!first) xcd_barrier(bar, tid_here(F.wave)); first = false; F.bid = blockIdx.x; asm volatile("" : "+s"(F.ws), "+s"(F.G), "+s"(F.vcu), "+s"(F.bid), "+s"(F.wave)); F.tid = tid_here(F.wave); F.lane = F.tid & 63;
#define PH_END }
    constexpr bool AL = true, SP = true;

    PH_BEGIN(0) if (EN & 1) p0a_prologue(F); PH_END
    PH_BEGIN(1) if (EN & 1) p0b_prologue(F); PH_END

    for (int layer = 0; layer < DEPTH; ++layer) {
        const int kind = layer % 3, j = layer / 3, gp0 = 2 + 8 * layer;
        const bool need_ctx = layer < DEPTH - 1;
        const gf32* ada_l = WSF(WS_ADA) + (size_t)layer * 3 * 6 * DM;
        gf32* st1 = WSF(WS_STATS) + (size_t)(2 * layer) * MROWS;
        gf32* st2 = st1 + MROWS;
        if (kind == 0) {
            PH_BEGIN(gp0 + 1) if (EN & 4) phase_pool(F, st1, !need_ctx, layer); PH_END
            PH_BEGIN(gp0 + 2) if (EN & 8) {
                pg8::Gemm g{WSB(WS_PO), WSB(WS_PW) + (size_t)j * DM * 512, MROWS, DM, 512, DM, 2};
                pg8::EpiRes E{WSH(WS_XS), WSH(WS_XS), ada_l, 2, inp(F, I_POOLLS) + (size_t)j * DM, WSB(WS_H), inp(F, I_NORMG) + (size_t)(layer * 2 + 1) * DM, ada_l, 4, st2};
                pg8::LatOrder S; S.init(DM, F.G, F.bid);
                if (need_ctx) pg8::gemm_phase_strip<pg8::EpiRes, pg8::LatOrder>(F.lds, F.lds + STRIP_OFF, F.lds + PF_OFF, g, S, E, F.wave);
                else pg8::gemm_phase<pg8::EpiRes, pg8::LatOrder, AL, SP>(F.lds, F.lds + PF_OFF, g, S, E, F.wave); } PH_END
        } else if (kind == 1) {
            PH_BEGIN(gp0 + 1) if (EN & 16) {
                pg8::Gemm g{WSB(WS_H), WSB(WS_GQKV), MROWS, 3072, DM, DM, 1 << 20}; typedef pg8::LatOrderSplit<WS_U, WS_CTL + CTL_SPLIT_FLAGS2> SplitQKV; SplitQKV S; S.init(3072, F.G, F.bid); S.wsb = F.ws;
                pg8::EpiQKV<true> E{WSB(WS_Q), WSB(WS_K), WSB(WS_V), 2048, 512, DM, 512, st1, WSF(WS_BQKV), 6144, 1.0f, inp(F, I_GKN), WSF(WS_ROPE), (LAS float*)(F.lds + XK_OFF)};
                pg8::gemm_phase_strip<pg8::EpiQKV<true>, SplitQKV>(F.lds, F.lds + STRIP_OFF, F.lds + PF_OFF, g, S, E, F.wave); } PH_END
            PH_BEGIN(gp0 + 3) if (EN & 64) phase_attn_gqa(F, (char*)lds); PH_END
        } else {
            PH_BEGIN(gp0 + 1) if (EN & 256) {
                pg8::Gemm g{WSB(WS_H), WSB(WS_NQKV), MROWS, 6144, DM, DM, 1 << 20}; pg8::LatOrder S; S.init(6144, F.G, F.bid);
                pg8::EpiQKV<true> E{WSB(WS_Q), WSB(WS_K), WSB(WS_V), 2048, 2048, DM, DM, st1, WSF(WS_BQKV) + 3 * 6144, 6144, att::QSCALE, nullptr, nullptr, nullptr};
                pg8::gemm_phase_strip<pg8::EpiQKV<true>, pg8::LatOrder>(F.lds, F.lds + STRIP_OFF, F.lds + PF_OFF, g, S, E, F.wave); } PH_END
            PH_BEGIN(gp0 + 3) if (EN & 512) phase_attn_nat(F, (char*)lds); PH_END
        }
        if (kind != 0) {
            PH_BEGIN(gp0 + 4) if (EN & 128) {
                pg8::Gemm g{WSB(WS_PO), kind == 1 ? WSB(WS_GWO) : WSB(WS_NWO), MROWS, DM, DM, DM, 1 << 20}; pg8::LatOrder S; S.init(DM, F.G, F.bid);
                pg8::EpiRes E{WSH(WS_XS), WSH(WS_XS), ada_l, 2, nullptr, WSB(WS_H), inp(F, I_NORMG) + (size_t)(layer * 2 + 1) * DM, ada_l, 4, st2};
                pg8::gemm_phase_strip<pg8::EpiRes, pg8::LatOrder>(F.lds, F.lds + STRIP_OFF, F.lds + PF_OFF, g, S, E, F.wave); } PH_END
        }
        PH_BEGIN(gp0 + 6) if (EN & 2048) {
            pg8::Gemm g{WSB(WS_H), WSB(WS_W13) + (size_t)layer * 2 * FF * DM, MROWS, 2 * FF, DM, DM, 1 << 20};
            pg8::EpiSwiGLU E{WSB(WS_U), st2, WSF(WS_BUP) + (size_t)layer * 3 * 2 * FF};
            if (need_ctx) { pg8::StaticOrder S; S.init(MROWS, 2 * FF, F.G, F.bid); pg8::gemm_phase<pg8::EpiSwiGLU, pg8::StaticOrder, AL, SP>(F.lds, F.lds + PF_OFF, g, S, E, F.wave); }
            else { typedef pg8::LatOrderSplit<WS_PO, WS_CTL + CTL_SPLIT_FLAGS> SplitUp; SplitUp S; S.init(2 * FF, F.G, F.bid); S.wsb = F.ws;
                pg8::gemm_phase<pg8::EpiSwiGLU, SplitUp, AL, SP>(F.lds, F.lds + PF_OFF, g, S, E, F.wave); } } PH_END
        if (need_ctx) {
            PH_BEGIN(gp0 + 7) if (EN & 4096) {
                pg8::Gemm g{WSB(WS_U), WSB(WS_W2) + (size_t)layer * DM * FF, MROWS, DM, FF, FF, 1 << 20}; pg8::LatOrder S; S.init(DM, F.G, F.bid);
                pg8::EpiRes E{WSH(WS_XS), WSH(WS_XS), ada_l, 5, nullptr, (layer + 1) % 3 == 0 ? (gb16*)nullptr : WSB(WS_H)  , inp(F, I_NORMG) + (size_t)((layer + 1) * 2) * DM, ada_l + (size_t)3 * 6 * DM, 1, st2 + MROWS};
                pg8::gemm_phase_strip<pg8::EpiRes, pg8::LatOrder>(F.lds, F.lds + STRIP_OFF, F.lds + PF_OFF, g, S, E, F.wave); } PH_END
        } else {
            PH_BEGIN(gp0 + 7) if (EN & 4096) {
                pg8::Gemm g{WSB(WS_U), WSB(WS_W2) + (size_t)layer * DM * FF, MROWS, DM, FF, FF, 1 << 20}; pg8::LatOrder S; S.init(DM, F.G, F.bid);
                if (F.G == 256) {
                    pg8::EpiFinal E{WSH(WS_XS), ada_l, 5, WSF(WS_STATS) + (size_t)8 * MROWS, inp(F, I_FINALG), F.out, (unsigned*)(ws + WS_CTL + CTL_FINAL_CNT)};
                    pg8::gemm_phase<pg8::EpiFinal, pg8::LatOrder, AL, SP>(F.lds, F.lds + PF_OFF, g, S, E, F.wave);
                } else {
                pg8::EpiRes E{WSH(WS_XS), WSH(WS_XS), ada_l, 5, nullptr, nullptr, nullptr, nullptr, 1, nullptr};
                pg8::gemm_phase<pg8::EpiRes, pg8::LatOrder, AL, SP>(F.lds, F.lds + PF_OFF, g, S, E, F.wave); } } PH_END
        }
    }
    if (F.G != 256) { PH_BEGIN(34) if (EN & 8192) phase_final(F); PH_END }
#undef PH_BEGIN
#undef PH_END
}

static bool phase_active(int gp) {
    if (gp <= 1 || gp == 34) return true;
    const int layer = (gp - 2) / 8, s = (gp - 2) % 8, kind = layer % 3;
    if (s == 0 || s == 5) return false;
    if (kind == 0) return s == 1 || s == 2 || s >= 6;
    return s != 2;
}
extern "C" void kernel_launch(void* const* d_in, const int* in_sizes, int n_in, void* d_out, int out_size, void* d_ws, size_t ws_size, hipStream_t stream) {
    static int grid = 0;
    if (grid == 0) {
        if (n_in != 24 || in_sizes[0] != NB * SEQ * DM || out_size != NB * SEQ * DM || ws_size < WS_END) {
            fprintf(stderr, "kernel_launch: shape mismatch: n_in %d in0 %d out %d ws %zu (need %zu)\n", n_in, n_in > 0 ? in_sizes[0] : -1, out_size, ws_size, (size_t)WS_END); grid = -1; return; }
        int dev = 0, cus = 0, per_cu = 0;
        if (hipGetDevice(&dev) != hipSuccess || hipDeviceGetAttribute(&cus, hipDeviceAttributeMultiprocessorCount, dev) != hipSuccess) { fprintf(stderr, "kernel_launch: device query failed\n"); grid = -1; return; }
        if (hipFuncSetAttribute((const void*)fwd_kernel, hipFuncAttributeMaxDynamicSharedMemorySize, LDS_BYTES) != hipSuccess) { fprintf(stderr, "kernel_launch: hipFuncSetAttribute failed\n"); grid = -1; return; }
        if (hipOccupancyMaxActiveBlocksPerMultiprocessor(&per_cu, (const void*)fwd_kernel, 512, LDS_BYTES) != hipSuccess || per_cu < 1)
            fprintf(stderr, "kernel_launch: note: occupancy query reports %d workgroups per CU\n", per_cu);
        (void)hipGetLastError();
        grid = cus;
    }
    if (grid < 0) return;
    if (hipMemsetAsync((char*)d_ws + WS_CTL, 0, CTL_ZERO_BYTES, stream) != hipSuccess) { fprintf(stderr, "kernel_launch: memset failed\n"); return; }
    Args a{};
    for (int i = 0; i < 24; ++i) a.in[i] = (const float*)d_in[i];
    a.out = (float*)d_out; a.ws = (unsigned char*)d_ws;
#if MK_ONE_LAUNCH
    a.gp_lo = 0; a.gp_hi = GP_END;
    hipLaunchKernelGGL(fwd_kernel, dim3(grid), dim3(512), LDS_BYTES, stream, a);
#else
    for (int gp = 0; gp < GP_END; ++gp) { if (!phase_active(gp)) continue;
        a.gp_lo = gp; a.gp_hi = gp + 1;
        hipLaunchKernelGGL(fwd_kernel, dim3(grid), dim3(512), LDS_BYTES, stream, a); }
#endif
    const hipError_t le = hipPeekAtLastError();
    if (le != hipSuccess) fprintf(stderr, "kernel_launch: launch failed: %s\n", hipGetErrorName(le));
}
```

```cpp
#include <hip/hip_runtime.h>
#include <cstdio>
#include <cstdint>

#ifndef EN
#define EN 0xffff
#endif
#ifndef MK_ONE_LAUNCH
#define MK_ONE_LAUNCH 1
#endif

constexpr int DM = 2048, NB = 2, SEQ = 4096, CTXL = 256, RB = SEQ + CTXL, MROWS = NB * RB, FF = 5632, HD = 128, NH = 16, KVH = 4, DEPTH = 4;
constexpr int PTILES = RB / 256;
constexpr float NORM_EPS = 1e-6f;
static_assert(RB % 256 == 0 && MROWS == 8704, "row layout");

#define GAS __attribute__((address_space(1)))
#define LAS __attribute__((address_space(3)))
typedef unsigned short bf16_t;
typedef float f32x4 __attribute__((ext_vector_type(4)));
typedef float f32x2 __attribute__((ext_vector_type(2)));
typedef unsigned u32x4 __attribute__((ext_vector_type(4)));
typedef unsigned u32x2 __attribute__((ext_vector_type(2)));
typedef short bf16x8 __attribute__((ext_vector_type(8)));
typedef _Float16 h16x2 __attribute__((ext_vector_type(2)));
typedef GAS _Float16 gh16;
__device__ __forceinline__ unsigned pk_h16(float a, float b) { const h16x2 v = {(_Float16)a, (_Float16)b}; return __builtin_bit_cast(unsigned, v); }
__device__ __forceinline__ float h16_lo(unsigned u) { return (float)__builtin_bit_cast(h16x2, u).x; }
__device__ __forceinline__ float h16_hi(unsigned u) { return (float)__builtin_bit_cast(h16x2, u).y; }
typedef GAS float gf32; typedef GAS bf16_t gb16; typedef GAS f32x4 gf32x4; typedef GAS f32x2 gf32x2; typedef GAS u32x4 gu32x4; typedef GAS u32x2 gu32x2; typedef GAS bf16x8 gbf16x8; typedef GAS unsigned gu32;
#define LDS_WAIT() asm volatile("s_waitcnt lgkmcnt(0)" ::: "memory")
#define VM_WAIT() asm volatile("s_waitcnt vmcnt(0)" ::: "memory")
__device__ __forceinline__ unsigned cvt_pk_bf16(float lo, float hi) { unsigned r; asm volatile("v_cvt_pk_bf16_f32 %0, %1, %2" : "=v"(r) : "v"(lo), "v"(hi)); return r; }
__device__ __forceinline__ float bf_lo(unsigned u) { return __uint_as_float(u << 16); }
__device__ __forceinline__ float bf_hi(unsigned u) { return __uint_as_float(u & 0xffff0000u); }
__device__ __forceinline__ int tid_here(int wave) { int l; asm volatile("v_mbcnt_lo_u32_b32 %0, -1, 0\n\tv_mbcnt_hi_u32_b32 %0, -1, %0" : "=v"(l)); return wave * 64 + l; }
__device__ __forceinline__ float wave_sum(float v) {
#pragma unroll
    for (int o = 1; o < 64; o <<= 1) v += __shfl_xor(v, o);
    return v;
}

namespace pg8 {
#define PG8_LAS __attribute__((address_space(3)))
constexpr int BM = 256, BK = 64, HALF = 128, HTB = HALF * BK * 2, STAGE_BYTES = 8 * HTB, NXCD = 8, WGM = 8;
__host__ __device__ __forceinline__ int lds_byte(int r, int c) { const int st = (r >> 4) * 2 + (c >> 5), rr = r & 15, cc = c & 31, ob = rr * 64 + cc * 2; return st * 1024 + (ob ^ (((ob >> 9) & 1) << 5)); }
__host__ __device__ __forceinline__ void stage_rc(int b, int& R, int& C) { const int st = b / 1024, sb = b % 1024, swz = sb ^ (((sb >> 9) & 1) << 5); R = (st >> 1) * 16 + swz / 64; C = (st & 1) * 32 + (swz % 64) / 2; }
__host__ __device__ __forceinline__ int perm32(int rho) { const int n = rho >> 4, i = rho & 15; return 8 * (i >> 2) + 4 * n + (i & 3); }

struct Unit { int pm, pn, srow, kh; };
struct Gemm { const gb16* A; const gb16* Bt; int M, N, K, lda, a_tpg; };

struct StaticOrder {
    static constexpr bool SPLIT = false;
    int nM, nN, nwg, G, c;
    __host__ __device__ void init(int M, int N, int G_, int c_) { nM = M / BM; nN = N / BM; nwg = nM * nN; G = G_; c = c_; }
    __host__ __device__ bool next(int i, Unit& u) const {
        const long L = (long)i * G + c; if (L >= nwg) return false;
        int wgid = (int)L; { const int q = nwg / NXCD, r = nwg % NXCD, xcd = wgid % NXCD, off = wgid / NXCD; wgid = (xcd < r ? xcd * (q + 1) : r * (q + 1) + (xcd - r) * q) + off; }
        const int nig = WGM * nN, gid = wgid / nig, fm = gid * WGM, gsz = (nM - fm) < WGM ? (nM - fm) : WGM;
        u.pm = fm + ((wgid % nig) % gsz); u.pn = (wgid % nig) / gsz; u.srow = 0; u.kh = -1; return true;
    }
    __device__ __forceinline__ void a_ready(const Unit&) const {}
    __device__ __forceinline__ void done(const Unit&) const {}
};
struct LatOrder {
    static constexpr bool SPLIT = false;
    int nN, nwg, G, c;
    __host__ __device__ void init(int N, int G_, int c_) { nN = N / BM; nwg = 32 * nN; G = G_; c = c_; }
    __host__ __device__ bool next(int i, Unit& u) const {
        const long L = (long)i * G + c; if (L >= nwg) return false;
        int wgid = (int)L; { const int q = nwg / NXCD, r = nwg % NXCD, xcd = wgid % NXCD, off = wgid / NXCD; wgid = (xcd < r ? xcd * (q + 1) : r * (q + 1) + (xcd - r) * q) + off; }
        const int nig = WGM * nN, gid = wgid / nig, fm = gid * WGM;
        const int p = fm + ((wgid % nig) % WGM); u.pn = (wgid % nig) / WGM; u.pm = p + 1 + (p >= 16 ? 1 : 0); u.srow = (p >> 4) * RB + (p & 15) * 16; u.kh = -1; return true;
    }
    __device__ __forceinline__ void a_ready(const Unit&) const {}
    __device__ __forceinline__ void done(const Unit&) const {}
};
template <size_t XOFF, size_t FOFF> struct LatOrderSplit {
    static constexpr bool SPLIT = true;
    int nN, nwg, G, c, full, R; GAS unsigned char* wsb; static constexpr size_t xoff = XOFF, foff = FOFF;
    __device__ __forceinline__ void init(int N, int G_, int c_) { nN = N / BM; nwg = 32 * nN; G = G_; c = c_; R = nwg % G; if (R > 0 && 2 * R <= G && R % NXCD == 0) full = nwg - R; else { full = nwg; R = 0; } }
    __device__ __forceinline__ bool next(int i, Unit& u) const {
        const long L = (long)i * G + c; int wgid, kh = -1;
        if (L < full) wgid = (int)L;
        else { if (R == 0 || L >= full + 2 * R) return false; const int t = (int)(L - full); kh = t >= R ? 1 : 0; wgid = full + (t >= R ? t - R : t); }
        { const int q = nwg / NXCD, r = nwg % NXCD, xcd = wgid % NXCD, off = wgid / NXCD; wgid = (xcd < r ? xcd * (q + 1) : r * (q + 1) + (xcd - r) * q) + off; }
        const int nig = WGM * nN, gid = wgid / nig, fm = gid * WGM;
        const int p = fm + ((wgid % nig) % WGM); u.pn = (wgid % nig) / WGM; u.pm = p + 1 + (p >= 16 ? 1 : 0); u.srow = (p >> 4) * RB + (p & 15) * 16; u.kh = kh; return true;
    }
    __device__ __forceinline__ void a_ready(const Unit&) const {}
    __device__ __forceinline__ void done(const Unit&) const {}
};


__device__ __forceinline__ float rstd_of(float ss) { return __builtin_amdgcn_rsqf(ss * (1.0f / DM) + NORM_EPS); }
__device__ __forceinline__ void atomic_add_f32(gf32* p, float v) { (void)__builtin_amdgcn_global_atomic_fadd_f32(p, v); }

struct EpiRes {
    static constexpr bool PERM = true, AFTER_DRAIN = false;
    const gh16* base; gh16* out; const gf32* ada_l; int chunk; const gf32* ls;
    gb16* An; const gf32* gnext; const gf32* ada_n; int sc_chunk; gf32* stats;
    __device__ __forceinline__ void prefetch(const Unit&, PG8_LAS float*, int, int, int) const {}
    __device__ __forceinline__ void operator()(const f32x4 (&acc)[2][2][4][2], const Unit& u, int wr, int wc, int fr, int fq, const PG8_LAS float*) const {
        const int vec = (u.pm % PTILES == 0) ? 2 : (u.pm / PTILES);
        const GAS char* gate = (const GAS char*)(ada_l + (size_t)(vec * 6 + chunk) * DM + u.pn * BM);
        const GAS char* lsp = (const GAS char*)(ls + u.pn * BM);
        const GAS char* gnp = (const GAS char*)(gnext + u.pn * BM);
        const GAS char* scp = (const GAS char*)(ada_n + (size_t)(vec * 6 + sc_chunk) * DM + u.pn * BM);
        const GAS char* bt = (const GAS char*)(base + (size_t)u.pm * BM * DM + u.pn * BM);
        GAS char* ot = (GAS char*)(out + (size_t)u.pm * BM * DM + u.pn * BM);
        GAS char* at = (GAS char*)(An + (size_t)u.pm * BM * DM + u.pn * BM);
        asm volatile("" : "+v"(fr), "+v"(fq));
        const unsigned lo = (unsigned)((wr * 64 + fr) * DM + wc * 32 + 8 * fq) * 2u, co = (unsigned)(wc * 32 + 8 * fq) * 4u;
        const unsigned so = (unsigned)(wr * 64 + fq * 16 + fr) * 4u;
        float ssq[2][4];
#pragma unroll
        for (int ai = 0; ai < 2; ++ai)
#pragma unroll
            for (int m = 0; m < 4; ++m) ssq[ai][m] = 0.f;
#pragma unroll
        for (int bj = 0; bj < 2; ++bj) {
            f32x4 gv[2], gm[2];
#pragma unroll
            for (int n = 0; n < 2; ++n) { const unsigned c = co + (unsigned)(bj * HALF + n * 4) * 4u;
                gv[n] = *(const gf32x4*)(gate + c); if (ls) gv[n] = gv[n] * *(const gf32x4*)(lsp + c);
                gm[n] = An ? *(const gf32x4*)(gnp + c) * (*(const gf32x4*)(scp + c) + 1.0f) : (f32x4){0.f, 0.f, 0.f, 0.f}; }
            u32x4 bs[2][4];
#pragma unroll
            for (int ai = 0; ai < 2; ++ai)
#pragma unroll
                for (int m = 0; m < 4; ++m) { const unsigned o = lo + (unsigned)((ai * HALF + m * 16) * DM + bj * HALF) * 2u; bs[ai][m] = *(const gu32x4*)(bt + o); }
            asm volatile("" ::: "memory");
#pragma unroll
            for (int ai = 0; ai < 2; ++ai)
#pragma unroll
                for (int m = 0; m < 4; ++m) { const unsigned o = lo + (unsigned)((ai * HALF + m * 16) * DM + bj * HALF) * 2u; const u32x4 b = bs[ai][m];
                    const f32x4 x0 = (f32x4){h16_lo(b.x), h16_hi(b.x), h16_lo(b.y), h16_hi(b.y)} + acc[ai][bj][m][0] * gv[0], x1 = (f32x4){h16_lo(b.z), h16_hi(b.z), h16_lo(b.w), h16_hi(b.w)} + acc[ai][bj][m][1] * gv[1];
                    { u32x4 w; w.x = pk_h16(x0.x, x0.y); w.y = pk_h16(x0.z, x0.w); w.z = pk_h16(x1.x, x1.y); w.w = pk_h16(x1.z, x1.w); *(gu32x4*)(ot + o) = w; }
                    ssq[ai][m] += (x0.x * x0.x + x0.y * x0.y) + (x0.z * x0.z + x0.w * x0.w) + (x1.x * x1.x + x1.y * x1.y) + (x1.z * x1.z + x1.w * x1.w);
                    if (An) { const f32x4 y0 = x0 * gm[0], y1 = x1 * gm[1]; u32x4 w; w.x = cvt_pk_bf16(y0.x, y0.y); w.y = cvt_pk_bf16(y0.z, y0.w); w.z = cvt_pk_bf16(y1.x, y1.y); w.w = cvt_pk_bf16(y1.z, y1.w); *(gu32x4*)(at + o) = w; } }
            asm volatile("" ::: "memory");
        }
        if (stats) {
#pragma unroll
            for (int ai = 0; ai < 2; ++ai) {
#pragma unroll
                for (int m = 0; m < 4; ++m) { ssq[ai][m] += __shfl_xor(ssq[ai][m], 16); ssq[ai][m] += __shfl_xor(ssq[ai][m], 32); }
                const float v = fq == 0 ? ssq[ai][0] : fq == 1 ? ssq[ai][1] : fq == 2 ? ssq[ai][2] : ssq[ai][3];
                atomic_add_f32((gf32*)((GAS char*)(stats + u.pm * BM + ai * HALF) + so), v); }
        }
    }
    __device__ __forceinline__ void strip(const f32x4 (&accS)[2], const Unit& u, int wr, int wc, int fr, int fq) const {
        const GAS char* gate = (const GAS char*)(ada_l + (size_t)(2 * 6 + chunk) * DM + u.pn * BM);
        const GAS char* lsp = (const GAS char*)(ls + u.pn * BM);
        const GAS char* gnp = (const GAS char*)(gnext + u.pn * BM);
        const GAS char* scp = (const GAS char*)(ada_n + (size_t)(2 * 6 + sc_chunk) * DM + u.pn * BM);
        const GAS char* bt = (const GAS char*)(base + (size_t)u.srow * DM + u.pn * BM);
        GAS char* ot = (GAS char*)(out + (size_t)u.srow * DM + u.pn * BM);
        GAS char* at = (GAS char*)(An + (size_t)u.srow * DM + u.pn * BM);
        asm volatile("" : "+v"(fr), "+v"(fq));
        const unsigned co = (unsigned)(wc * 32 + 8 * fq + 4 * wr) * 4u, lo = (unsigned)(fr * DM) * 2u + (co >> 1), so = (unsigned)fr * 4u;
        float q = 0.f;
#pragma unroll
        for (int bj = 0; bj < 2; ++bj) { const unsigned c = co + (unsigned)(bj * HALF) * 4u, o = lo + (unsigned)(bj * HALF) * 2u;
            f32x4 gv = *(const gf32x4*)(gate + c); if (ls) gv = gv * *(const gf32x4*)(lsp + c);
            const u32x2 b = *(const gu32x2*)(bt + o);
            const f32x4 x0 = (f32x4){h16_lo(b.x), h16_hi(b.x), h16_lo(b.y), h16_hi(b.y)} + accS[bj] * gv; { u32x2 w; w.x = pk_h16(x0.x, x0.y); w.y = pk_h16(x0.z, x0.w); *(gu32x2*)(ot + o) = w; }
            q += (x0.x * x0.x + x0.y * x0.y) + (x0.z * x0.z + x0.w * x0.w);
            if (An) { const f32x4 y0 = x0 * (*(const gf32x4*)(gnp + c) * (*(const gf32x4*)(scp + c) + 1.0f));
                u32x2 w; w.x = cvt_pk_bf16(y0.x, y0.y); w.y = cvt_pk_bf16(y0.z, y0.w); *(gu32x2*)(at + o) = w; } }
        if (stats) { q += __shfl_xor(q, 16); q += __shfl_xor(q, 32); if (fq == 0) atomic_add_f32((gf32*)((GAS char*)(stats + u.srow) + so), q); }
    }
};
struct EpiFinal {
    static constexpr bool PERM = true, AFTER_DRAIN = false;
    const gh16* base; const gf32* ada_l; int chunk; gf32* stats; const gf32* fg; gf32* out; unsigned* cnt;
    __device__ __forceinline__ void prefetch(const Unit&, PG8_LAS float*, int, int, int) const {}
    __device__ __forceinline__ void operator()(f32x4 (&acc)[2][2][4][2], const Unit& u, int wr, int wc, int fr, int fq, const PG8_LAS float*) const {
        const int b = u.pm / PTILES;
        const GAS char* gate = (const GAS char*)(ada_l + (size_t)(b * 6 + chunk) * DM + u.pn * BM);
        const GAS char* bt = (const GAS char*)(base + (size_t)u.pm * BM * DM + u.pn * BM);
        asm volatile("" : "+v"(fr), "+v"(fq));
        const unsigned lo = (unsigned)((wr * 64 + fr) * DM + wc * 32 + 8 * fq) * 2u, co = (unsigned)(wc * 32 + 8 * fq) * 4u;
        const unsigned so = (unsigned)(wr * 64 + fq * 16 + fr) * 4u;
        float ssq[2][4];
#pragma unroll
        for (int ai = 0; ai < 2; ++ai)
#pragma unroll
            for (int m = 0; m < 4; ++m) ssq[ai][m] = 0.f;
#pragma unroll
        for (int bj = 0; bj < 2; ++bj) {
            f32x4 gv[2];
#pragma unroll
            for (int n = 0; n < 2; ++n) gv[n] = *(const gf32x4*)(gate + co + (unsigned)(bj * HALF + n * 4) * 4u);
            u32x4 bs[2][4];
#pragma unroll
            for (int ai = 0; ai < 2; ++ai)
#pragma unroll
                for (int m = 0; m < 4; ++m) bs[ai][m] = *(const gu32x4*)(bt + lo + (unsigned)((ai * HALF + m * 16) * DM + bj * HALF) * 2u);
            asm volatile("" ::: "memory");
#pragma unroll
            for (int ai = 0; ai < 2; ++ai)
#pragma unroll
                for (int m = 0; m < 4; ++m) { const u32x4 bb = bs[ai][m];
                    const f32x4 x0 = (f32x4){h16_lo(bb.x), h16_hi(bb.x), h16_lo(bb.y), h16_hi(bb.y)} + acc[ai][bj][m][0] * gv[0], x1 = (f32x4){h16_lo(bb.z), h16_hi(bb.z), h16_lo(bb.w), h16_hi(bb.w)} + acc[ai][bj][m][1] * gv[1];
                    acc[ai][bj][m][0] = x0; acc[ai][bj][m][1] = x1;
                    ssq[ai][m] += (x0.x * x0.x + x0.y * x0.y) + (x0.z * x0.z + x0.w * x0.w) + (x1.x * x1.x + x1.y * x1.y) + (x1.z * x1.z + x1.w * x1.w); }
        }
#pragma unroll
        for (int ai = 0; ai < 2; ++ai) {
#pragma unroll
            for (int m = 0; m < 4; ++m) { ssq[ai][m] += __shfl_xor(ssq[ai][m], 16); ssq[ai][m] += __shfl_xor(ssq[ai][m], 32); }
            const float v = fq == 0 ? ssq[ai][0] : fq == 1 ? ssq[ai][1] : fq == 2 ? ssq[ai][2] : ssq[ai][3];
            atomic_add_f32((gf32*)((GAS char*)(stats + u.pm * BM + ai * HALF) + so), v); }
        asm volatile("s_waitcnt vmcnt(0)" ::: "memory"); __builtin_amdgcn_s_barrier();
        if ((wr | wc | fr | fq) == 0) { unsigned* cp = cnt + u.pm * 16; (void)__hip_atomic_fetch_add(cp, 1u, __ATOMIC_RELAXED, __HIP_MEMORY_SCOPE_AGENT);
            unsigned sp = 0; while (__hip_atomic_load(cp, __ATOMIC_RELAXED, __HIP_MEMORY_SCOPE_AGENT) < (unsigned)(DM / BM)) { __builtin_amdgcn_s_sleep(1); if (++sp > (1u << 22)) break; } }
        __builtin_amdgcn_s_barrier(); asm volatile("" ::: "memory");
        float rs[2][4];
#pragma unroll
        for (int ai = 0; ai < 2; ++ai)
#pragma unroll
            for (int m = 0; m < 4; ++m) rs[ai][m] = rstd_of(__hip_atomic_load(stats + u.pm * BM + ai * HALF + wr * 64 + m * 16 + fr, __ATOMIC_RELAXED, __HIP_MEMORY_SCOPE_AGENT));
        GAS char* ob = (GAS char*)(out + ((size_t)b * SEQ + (size_t)(u.pm % PTILES - 1) * BM) * DM + u.pn * BM);
        const unsigned oo = (unsigned)((wr * 64 + fr) * DM + wc * 32 + 8 * fq) * 4u;
#pragma unroll
        for (int bj = 0; bj < 2; ++bj) {
            const f32x4 f0 = *(const gf32x4*)((const GAS char*)(fg + u.pn * BM) + co + (unsigned)(bj * HALF) * 4u), f1 = *(const gf32x4*)((const GAS char*)(fg + u.pn * BM) + co + (unsigned)(bj * HALF + 4) * 4u);
#pragma unroll
            for (int ai = 0; ai < 2; ++ai)
#pragma unroll
                for (int m = 0; m < 4; ++m) { const unsigned o = oo + (unsigned)((ai * HALF + m * 16) * DM + bj * HALF) * 4u;
                    *(gf32x4*)(ob + o) = (acc[ai][bj][m][0] * rs[ai][m]) * f0; *(gf32x4*)(ob + o + 16) = (acc[ai][bj][m][1] * rs[ai][m]) * f1; }
        }
    }
};
template <bool PF> struct EpiQKV {
    static constexpr bool PERM = true, AFTER_DRAIN = false;
    gb16* P0; gb16* P1; gb16* P2; int n0, n1, ld0, ld1; const gf32* stats; const gf32* bias; int nb; float qscale;
    const gf32* gk; const gf32* rope; PG8_LAS float* xk;
    __device__ __forceinline__ void prefetch(const Unit& u, PG8_LAS float* area, int lane, int wr, int wc) const {
        if constexpr (!PF) return;
        asm volatile("" : "+v"(lane));
        const int vec = (u.pm % PTILES == 0) ? 2 : (u.pm / PTILES);
        const gf32* sp = stats + u.pm * BM + wr * 64 + lane;
        __builtin_amdgcn_global_load_lds((const GAS unsigned*)sp, (PG8_LAS unsigned*)area, 4, 0, 0);
        __builtin_amdgcn_global_load_lds((const GAS unsigned*)(sp + HALF), (PG8_LAS unsigned*)(area + 64), 4, 0, 0);
        __builtin_amdgcn_global_load_lds((const GAS unsigned*)(bias + (size_t)vec * nb + u.pn * BM + (lane >> 5) * HALF + wc * 32 + (lane & 31)), (PG8_LAS unsigned*)(area + 128), 4, 0, 0);
    }
    __device__ __forceinline__ void operator()(const f32x4 (&acc)[2][2][4][2], const Unit& u, int wr, int wc, int fr, int fq, const PG8_LAS float* area, int aim = 3, int flip = 0) const {
        asm volatile("" : "+v"(fr), "+v"(fq));
        const int row0 = u.pm * BM + wr * 64 + fr;
        int colt = u.pn * BM; gb16* base = P0; int ldc = ld0; float qs = qscale;
        if (colt >= n0 + n1) { base = P2; ldc = ld1; colt -= n0 + n1; qs = 1.f; } else if (colt >= n0) { base = P1; ldc = ld1; colt -= n0; qs = 1.f; }
        const int col0 = colt + wc * 32 + 8 * fq;
        if (gk && base == P1) { ktile(acc, u, wr, wc, fr, fq, area, P1 + (size_t)row0 * ld1 + col0, aim, flip); return; }
        f32x4 bv[2][2];
#pragma unroll
        for (int bj = 0; bj < 2; ++bj)
#pragma unroll
            for (int n = 0; n < 2; ++n) bv[bj][n] = PF ? *(const PG8_LAS f32x4*)(area + 128 + bj * 32 + 8 * fq + 4 * n) : *(const gf32x4*)(bias + (size_t)((u.pm % PTILES == 0) ? 2 : (u.pm / PTILES)) * nb + u.pn * BM + wc * 32 + 8 * fq + bj * HALF + 4 * n);
#pragma unroll
        for (int ai = 0; ai < 2; ++ai) { if (!((aim >> ai) & 1)) continue; const int h = ai ^ flip;
#pragma unroll
            for (int m = 0; m < 4; ++m) { const int row = row0 + h * HALF + m * 16; const float rs = rstd_of(PF ? area[h * 64 + m * 16 + fr] : stats[row]); gb16* rowp = base + (size_t)row * ldc + col0;
#pragma unroll
                for (int bj = 0; bj < 2; ++bj) { const f32x4 v0 = (acc[ai][bj][m][0] * rs + bv[bj][0]) * qs, v1 = (acc[ai][bj][m][1] * rs + bv[bj][1]) * qs;
                    u32x4 w; w.x = cvt_pk_bf16(v0[0], v0[1]); w.y = cvt_pk_bf16(v0[2], v0[3]); w.z = cvt_pk_bf16(v1[0], v1[1]); w.w = cvt_pk_bf16(v1[2], v1[3]);
                    *(gu32x4*)(rowp + bj * HALF) = w; } } }
    }
    __device__ __forceinline__ void ktile(const f32x4 (&acc)[2][2][4][2], const Unit& u, int wr, int wc, int fr, int fq, const PG8_LAS float* area, gb16* rowp0, int aim, int flip) const {
        f32x4 bv[2][2];
#pragma unroll
        for (int bj = 0; bj < 2; ++bj)
#pragma unroll
            for (int n = 0; n < 2; ++n) bv[bj][n] = *(const PG8_LAS f32x4*)(area + 128 + bj * 32 + 8 * fq + 4 * n);
        float rs[2][4];
#pragma unroll
        for (int ai = 0; ai < 2; ++ai) { if (!((aim >> ai) & 1)) continue; const int h = ai ^ flip;
#pragma unroll
            for (int m = 0; m < 4; ++m) { rs[ai][m] = rstd_of(area[h * 64 + m * 16 + fr]);
#pragma unroll
                for (int bj = 0; bj < 2; ++bj) { const f32x4 v0 = acc[ai][bj][m][0] * rs[ai][m] + bv[bj][0], v1 = acc[ai][bj][m][1] * rs[ai][m] + bv[bj][1];
                    float q = (v0.x * v0.x + v0.y * v0.y) + (v0.z * v0.z + v0.w * v0.w) + (v1.x * v1.x + v1.y * v1.y) + (v1.z * v1.z + v1.w * v1.w);
                    q += __shfl_xor(q, 16); q += __shfl_xor(q, 32);
                    if (fq == 0) xk[(bj * BM + h * HALF + wr * 64 + m * 16 + fr) * 4 + wc] = q; } } }
        asm volatile("s_waitcnt lgkmcnt(0)" ::: "memory"); __builtin_amdgcn_s_barrier(); asm volatile("" ::: "memory");
        const f32x4 g0 = *(const gf32x4*)(gk + wc * 32 + 8 * fq), g1 = *(const gf32x4*)(gk + wc * 32 + 8 * fq + 4);
        const bool lat = (u.pm % PTILES) != 0;
        const int f0 = 16 * (wc & 1) + 4 * fq;
#pragma unroll
        for (int ai = 0; ai < 2; ++ai) { if (!((aim >> ai) & 1)) continue;
#pragma unroll
            for (int m = 0; m < 4; ++m) { const int rl = (ai ^ flip) * HALF + wr * 64 + m * 16 + fr; const int t = ((u.pm % PTILES) - 1) * BM + rl; const int pos = wc < 2 ? (t >> 6) : (t & 63);
                f32x4 t0 = {1.f, 0.f, 1.f, 0.f}, t1 = t0;
                if (lat) { t0 = *(const gf32x4*)(rope + 2 * (pos * 32 + f0)); t1 = *(const gf32x4*)(rope + 2 * (pos * 32 + f0 + 2)); }
#pragma unroll
                for (int bj = 0; bj < 2; ++bj) { const f32x4 pq = *(const PG8_LAS f32x4*)(xk + (bj * BM + rl) * 4);
                    const float rh = __builtin_amdgcn_rsqf(((pq.x + pq.y) + (pq.z + pq.w)) * (1.0f / 128.0f) + NORM_EPS);
                    const f32x4 y0 = (acc[ai][bj][m][0] * rs[ai][m] + bv[bj][0]) * rh * g0, y1 = (acc[ai][bj][m][1] * rs[ai][m] + bv[bj][1]) * rh * g1;
                    u32x4 w; w.x = cvt_pk_bf16(y0.x * t0.x - y0.y * t0.y, y0.x * t0.y + y0.y * t0.x); w.y = cvt_pk_bf16(y0.z * t0.z - y0.w * t0.w, y0.z * t0.w + y0.w * t0.z);
                    w.z = cvt_pk_bf16(y1.x * t1.x - y1.y * t1.y, y1.x * t1.y + y1.y * t1.x); w.w = cvt_pk_bf16(y1.z * t1.z - y1.w * t1.w, y1.z * t1.w + y1.w * t1.z);
                    *(gu32x4*)(rowp0 + (size_t)((ai ^ flip) * HALF + m * 16) * ld1 + bj * HALF) = w; } } }
    }
    __device__ __forceinline__ void strip(const f32x4 (&accS)[2], const Unit& u, int wr, int wc, int fr, int fq) const {
        asm volatile("" : "+v"(fr), "+v"(fq));
        int colt = u.pn * BM; gb16* base = P0; int ldc = ld0; float qs = qscale;
        if (colt >= n0 + n1) { base = P2; ldc = ld1; colt -= n0 + n1; qs = 1.f; } else if (colt >= n0) { base = P1; ldc = ld1; colt -= n0; qs = 1.f; }
        const int row = u.srow + fr; const float rs = rstd_of(stats[row]);
        gb16* rowp = base + (size_t)row * ldc + colt + wc * 32 + 8 * fq + 4 * wr; const gf32* bp = bias + (size_t)2 * nb + u.pn * BM + wc * 32 + 8 * fq + 4 * wr;
        if (gk && base == P1) {
            f32x4 v[2];
            __builtin_amdgcn_s_barrier();
#pragma unroll
            for (int bj = 0; bj < 2; ++bj) { v[bj] = accS[bj] * rs + *(const gf32x4*)(bp + bj * HALF);
                float q = (v[bj].x * v[bj].x + v[bj].y * v[bj].y) + (v[bj].z * v[bj].z + v[bj].w * v[bj].w); q += __shfl_xor(q, 16); q += __shfl_xor(q, 32);
                if (fq == 0) xk[(bj * 16 + fr) * 8 + wr * 4 + wc] = q; }
            asm volatile("s_waitcnt lgkmcnt(0)" ::: "memory"); __builtin_amdgcn_s_barrier(); asm volatile("" ::: "memory");
            const f32x4 g = *(const gf32x4*)(gk + wc * 32 + 8 * fq + 4 * wr);
#pragma unroll
            for (int bj = 0; bj < 2; ++bj) { const f32x4 p0 = *(const PG8_LAS f32x4*)(xk + (bj * 16 + fr) * 8), p1 = *(const PG8_LAS f32x4*)(xk + (bj * 16 + fr) * 8 + 4);
                const float rh = __builtin_amdgcn_rsqf((((p0.x + p0.y) + (p0.z + p0.w)) + ((p1.x + p1.y) + (p1.z + p1.w))) * (1.0f / 128.0f) + NORM_EPS);
                const f32x4 y = v[bj] * rh * g; u32x2 w; w.x = cvt_pk_bf16(y[0], y[1]); w.y = cvt_pk_bf16(y[2], y[3]); *(gu32x2*)(rowp + bj * HALF) = w; }
            return; }
#pragma unroll
        for (int bj = 0; bj < 2; ++bj) { const f32x4 v = (accS[bj] * rs + *(const gf32x4*)(bp + bj * HALF)) * qs; u32x2 w; w.x = cvt_pk_bf16(v[0], v[1]); w.y = cvt_pk_bf16(v[2], v[3]); *(gu32x2*)(rowp + bj * HALF) = w; }
    }
};
__device__ __forceinline__ float silu_mul(float g, float u) { return g * u * __builtin_amdgcn_rcpf(1.0f + __builtin_amdgcn_exp2f(-1.4426950408889634f * g)); }
__device__ __forceinline__ unsigned silu_mul_pk(f32x2 g, f32x2 u) {
    const f32x2 t = g * (-1.4426950408889634f); f32x2 e; e.x = __builtin_amdgcn_exp2f(t.x); e.y = __builtin_amdgcn_exp2f(t.y);
    const f32x2 d = e + 1.0f; f32x2 r; r.x = __builtin_amdgcn_rcpf(d.x); r.y = __builtin_amdgcn_rcpf(d.y);
    const f32x2 o = (g * u) * r; return cvt_pk_bf16(o.x, o.y);
}
struct EpiSwiGLU {
    static constexpr bool PERM = true, AFTER_DRAIN = false;
    gb16* U; const gf32* stats; const gf32* bias;
    __device__ __forceinline__ void prefetch(const Unit& u, PG8_LAS float* area, int lane, int wr, int wc) const {
        asm volatile("" : "+v"(lane));
        const int vec = (u.pm % PTILES == 0) ? 2 : (u.pm / PTILES);
        const gf32* sp = stats + u.pm * BM + wr * 64 + lane;
        __builtin_amdgcn_global_load_lds((const GAS unsigned*)sp, (PG8_LAS unsigned*)area, 4, 0, 0);
        __builtin_amdgcn_global_load_lds((const GAS unsigned*)(sp + HALF), (PG8_LAS unsigned*)(area + 64), 4, 0, 0);
        __builtin_amdgcn_global_load_lds((const GAS unsigned*)(bias + (size_t)vec * (2 * FF) + u.pn * BM + (lane >> 5) * HALF + wc * 32 + (lane & 31)), (PG8_LAS unsigned*)(area + 128), 4, 0, 0);
    }
    __device__ __forceinline__ void operator()(const f32x4 (&acc)[2][2][4][2], const Unit& u, int wr, int wc, int fr, int fq, const PG8_LAS float* area, int aim = 3, int flip = 0) const {
        asm volatile("" : "+v"(fr), "+v"(fq));
        const int row0 = u.pm * BM + wr * 64 + fr;
        const int col0 = u.pn * HALF + wc * 32 + 8 * fq;
        const f32x4 bg0 = *(const PG8_LAS f32x4*)(area + 128 + 8 * fq), bg1 = *(const PG8_LAS f32x4*)(area + 128 + 8 * fq + 4), bu0 = *(const PG8_LAS f32x4*)(area + 160 + 8 * fq), bu1 = *(const PG8_LAS f32x4*)(area + 160 + 8 * fq + 4);
#pragma unroll
        for (int ai = 0; ai < 2; ++ai) { if (!((aim >> ai) & 1)) continue;
#pragma unroll
            for (int m = 0; m < 4; ++m) { const int h = ai ^ flip; const int row = row0 + h * HALF + m * 16; const float rs = rstd_of(area[h * 64 + m * 16 + fr]); gb16* rowp = U + (size_t)row * FF + col0;
                const f32x4 g0 = acc[ai][0][m][0] * rs + bg0, g1 = acc[ai][0][m][1] * rs + bg1, u0 = acc[ai][1][m][0] * rs + bu0, u1 = acc[ai][1][m][1] * rs + bu1;
                u32x4 w; w.x = silu_mul_pk((f32x2){g0[0], g0[1]}, (f32x2){u0[0], u0[1]}); w.y = silu_mul_pk((f32x2){g0[2], g0[3]}, (f32x2){u0[2], u0[3]});
                w.z = silu_mul_pk((f32x2){g1[0], g1[1]}, (f32x2){u1[0], u1[1]}); w.w = silu_mul_pk((f32x2){g1[2], g1[3]}, (f32x2){u1[2], u1[3]});
                *(gu32x4*)rowp = w; } }
    }
};

template <class Epi, class Sched, bool ALIGN_EPI = false, bool SP2 = false>
__device__ __forceinline__ void gemm_phase(PG8_LAS unsigned char* lds, PG8_LAS unsigned char* pf, const Gemm g, const Sched& S, const Epi& E, int wv) {
    const int tid = tid_here(wv), wid = wv, lane = tid & 63, wr = wid >> 2, wc = wid & 3, fr = lane & 15, fq = lane >> 4;
    const int K = g.K, nt = K / BK, lda = g.lda;
    unsigned voffA[2], voffB[2];
#pragma unroll
    for (int i = 0; i < 2; ++i) { int R, C; stage_rc(tid * 16 + i * 8192, R, C); const int Rb = Epi::PERM ? ((R & ~31) + perm32(R & 31)) : R;
        voffA[i] = (unsigned)(R * lda + C) * 2u; voffB[i] = (unsigned)(Rb * K + C) * 2u; }
    const size_t kstep = (size_t)(BK * 2);
    const size_t hstepA = (size_t)HALF * lda * 2, hstepB = (size_t)HALF * K * 2;
    const size_t tstepA = 2 * hstepA, tstepB = 2 * hstepB;
    const unsigned ldsw = (unsigned)wid * 1024u;
    const int aoff = lds_byte(wr * 64 + fr, fq * 8), boff = lds_byte(wc * 32 + fr, fq * 8);
#define PG8_SA(b, h) (((b) * 2 + (h)) * HTB)
#define PG8_SB(b, h) ((4 + (b) * 2 + (h)) * HTB)
#define PG8_STAGE(bufoff, gbase, voff) do { _Pragma("unroll") for (int _i = 0; _i < 2; ++_i) \
        __builtin_amdgcn_global_load_lds((const GAS unsigned*)((const GAS char*)(gbase) + (voff)[_i]), (PG8_LAS unsigned*)(lds + (bufoff) + ldsw + _i * 8192), 16, 0, 0); } while (0)
#define PG8_LDA(dst, b, h) do { _Pragma("unroll") for (int m = 0; m < 4; ++m) _Pragma("unroll") for (int k = 0; k < 2; ++k) dst[m][k] = *(const PG8_LAS bf16x8*)(lds + PG8_SA(b, h) + aoff + m * 2048 + k * 1024); } while (0)
#define PG8_LDB(dst, b, h) do { _Pragma("unroll") for (int n = 0; n < 2; ++n) _Pragma("unroll") for (int k = 0; k < 2; ++k) dst[n][k] = *(const PG8_LAS bf16x8*)(lds + PG8_SB(b, h) + boff + n * 2048 + k * 1024); } while (0)
#define PG8_MMA(ai, bj, At, Bt) do { __builtin_amdgcn_s_setprio(1); _Pragma("unroll") for (int m = 0; m < 4; ++m) _Pragma("unroll") for (int n = 0; n < 2; ++n) _Pragma("unroll") for (int k = 0; k < 2; ++k) \
        acc[ai][bj][m][n] = __builtin_amdgcn_mfma_f32_16x16x32_bf16(Bt[n][k], At[m][k], acc[ai][bj][m][n], 0, 0, 0); __builtin_amdgcn_s_setprio(0); } while (0)
#define PG8_WAIT_V(n) asm volatile("s_waitcnt vmcnt(" #n ")" ::: "memory")
#define PG8_WAIT_L(n) asm volatile("s_waitcnt lgkmcnt(" #n ")" ::: "memory")
#define PG8_BAR __builtin_amdgcn_s_barrier()
#define PG8_SCHED __builtin_amdgcn_sched_barrier(0)
#define PG8_KOFF(u) ((Sched::SPLIT && (u).kh > 0) ? (size_t)K : (size_t)0)
#define PG8_ABASE(u) ((const GAS char*)g.A + (size_t)(u).pm * tstepA + (size_t)((u).pn / g.a_tpg) * (size_t)K * 2 + PG8_KOFF(u))
#define PG8_BBASE(u) ((const GAS char*)g.Bt + (size_t)(u).pn * tstepB + PG8_KOFF(u))
    Unit cur, nxt; int ui = 0;
    if (!S.next(0, cur)) return;
    f32x4 acc[2][2][4][2];
#pragma unroll
    for (int a = 0; a < 2; ++a)
#pragma unroll
        for (int b = 0; b < 2; ++b)
#pragma unroll
            for (int m = 0; m < 4; ++m)
#pragma unroll
                for (int n = 0; n < 2; ++n) acc[a][b][m][n] = (f32x4){0.f, 0.f, 0.f, 0.f};
    bf16x8 At[4][2], B0[2][2], B1[2][2];
    const GAS char* cA = PG8_ABASE(cur); const GAS char* cB = PG8_BBASE(cur);
    long hsA = (long)hstepA;
    if constexpr (Sched::SPLIT) { if (cur.kh > 0) { cA += hstepA; hsA = -(long)hstepA; } }
    S.a_ready(cur);
    int par = 0;
    E.prefetch(cur, (PG8_LAS float*)(pf + wid * 1024), lane, wr, wc);
    if constexpr (SP2) {
        PG8_STAGE(PG8_SB(0, 0), cB, voffB); PG8_STAGE(PG8_SB(0, 1), cB + hstepB, voffB); PG8_STAGE(PG8_SA(0, 0), cA, voffA); PG8_STAGE(PG8_SA(0, 1), cA + (Sched::SPLIT ? hsA : (long)hstepA), voffA);
        if (wr == 1) PG8_BAR;
        PG8_WAIT_V(2); PG8_BAR;
        PG8_STAGE(PG8_SB(1, 0), cB + kstep, voffB); PG8_STAGE(PG8_SA(1, 0), cA + kstep, voffA); PG8_STAGE(PG8_SB(1, 1), cB + hstepB + kstep, voffB);
        PG8_WAIT_V(6); PG8_BAR;
    } else {
        PG8_STAGE(PG8_SB(0, 0), cB, voffB); PG8_STAGE(PG8_SA(0, 0), cA, voffA); PG8_STAGE(PG8_SB(0, 1), cB + hstepB, voffB); PG8_STAGE(PG8_SA(0, 1), cA + hstepA, voffA);
        if (wr == 1) PG8_BAR;
        PG8_WAIT_V(4); PG8_BAR;
        PG8_STAGE(PG8_SB(1, 0), cB + kstep, voffB); PG8_STAGE(PG8_SA(1, 0), cA + kstep, voffA); PG8_STAGE(PG8_SB(1, 1), cB + hstepB + kstep, voffB);
        PG8_WAIT_V(6); PG8_BAR;
    }
    for (;;) {
        const bool has_next = S.next(ui + 1, nxt);
        const GAS char* nA = has_next ? PG8_ABASE(nxt) : cA; const GAS char* nB = has_next ? PG8_BBASE(nxt) : cB;
        if constexpr (Sched::SPLIT) { if (has_next && nxt.kh > 0) nA += hstepA; }
        int ntu = nt; if constexpr (Sched::SPLIT) { if (cur.kh >= 0) ntu = nt >> 1; }
        for (int t = 0; t < ntu; t += 2) {
            const bool last = (t == ntu - 2);
            const GAS char* a1 = cA + (size_t)(t + 1) * kstep;
            const GAS char* a2 = last ? nA : cA + (size_t)(t + 2) * kstep; const GAS char* b2 = last ? nB : cB + (size_t)(t + 2) * kstep;
            const GAS char* a3 = a2 + kstep; const GAS char* b3 = b2 + kstep;
            if (last && has_next) S.a_ready(nxt);
            if constexpr (SP2) {
            PG8_LDB(B0, 0, 0); PG8_LDB(B1, 0, 1); PG8_SCHED; PG8_LDA(At, 0, 0); PG8_STAGE(PG8_SA(1, 1), a1 + (Sched::SPLIT ? hsA : (long)hstepA), voffA);
            PG8_WAIT_V(8); PG8_WAIT_L(0); PG8_BAR; PG8_MMA(0, 0, At, B0); PG8_MMA(0, 1, At, B1); PG8_BAR; PG8_SCHED;
            PG8_LDA(At, 0, 1); PG8_STAGE(PG8_SB(0, 0), b2, voffB); PG8_STAGE(PG8_SB(0, 1), b2 + hstepB, voffB); PG8_STAGE(PG8_SA(0, 0), a2, voffA);
            PG8_WAIT_V(8); PG8_WAIT_L(0); PG8_BAR; PG8_MMA(1, 0, At, B0); PG8_MMA(1, 1, At, B1); PG8_BAR; PG8_SCHED;
            PG8_LDB(B0, 1, 0); PG8_LDB(B1, 1, 1); PG8_SCHED; PG8_LDA(At, 1, 0); PG8_STAGE(PG8_SA(0, 1), a2 + (Sched::SPLIT ? ((last && has_next) ? (nxt.kh > 0 ? -(long)hstepA : (long)hstepA) : hsA) : (long)hstepA), voffA);
            PG8_WAIT_V(8); PG8_WAIT_L(0); PG8_BAR; PG8_MMA(0, 0, At, B0); PG8_MMA(0, 1, At, B1); PG8_BAR; PG8_SCHED;
            PG8_LDA(At, 1, 1); PG8_STAGE(PG8_SB(1, 0), b3, voffB); PG8_STAGE(PG8_SB(1, 1), b3 + hstepB, voffB); PG8_STAGE(PG8_SA(1, 0), a3, voffA);
            PG8_WAIT_V(8); PG8_WAIT_L(0); PG8_BAR; PG8_MMA(1, 0, At, B0); PG8_MMA(1, 1, At, B1); PG8_BAR; PG8_SCHED;
            } else {
            PG8_LDB(B0, 0, 0); PG8_SCHED; PG8_LDA(At, 0, 0); PG8_STAGE(PG8_SA(1, 1), a1 + hstepA, voffA);
            PG8_WAIT_L(8); PG8_BAR; PG8_WAIT_L(0); PG8_MMA(0, 0, At, B0); PG8_BAR; PG8_SCHED;
            PG8_LDB(B1, 0, 1); PG8_STAGE(PG8_SB(0, 0), b2, voffB);
            PG8_BAR; PG8_WAIT_L(0); PG8_MMA(0, 1, At, B1); PG8_BAR;
            PG8_LDA(At, 0, 1); PG8_STAGE(PG8_SA(0, 0), a2, voffA);
            PG8_BAR; PG8_WAIT_L(0); PG8_MMA(1, 0, At, B0); PG8_BAR; PG8_SCHED;
            PG8_STAGE(PG8_SB(0, 1), b2 + hstepB, voffB);
            PG8_WAIT_V(6); PG8_BAR; PG8_MMA(1, 1, At, B1); PG8_BAR;
            PG8_LDB(B0, 1, 0); PG8_SCHED; PG8_LDA(At, 1, 0); PG8_STAGE(PG8_SA(0, 1), a2 + hstepA, voffA);
            PG8_WAIT_L(8); PG8_BAR; PG8_WAIT_L(0); PG8_MMA(0, 0, At, B0); PG8_BAR; PG8_SCHED;
            PG8_LDB(B1, 1, 1); PG8_STAGE(PG8_SB(1, 0), b3, voffB);
            PG8_BAR; PG8_WAIT_L(0); PG8_MMA(0, 1, At, B1); PG8_BAR;
            PG8_LDA(At, 1, 1); PG8_STAGE(PG8_SA(1, 0), a3, voffA);
            PG8_BAR; PG8_WAIT_L(0); PG8_MMA(1, 0, At, B0); PG8_BAR; PG8_SCHED;
            PG8_STAGE(PG8_SB(1, 1), b3 + hstepB, voffB);
            PG8_WAIT_V(6); PG8_BAR; PG8_MMA(1, 1, At, B1); PG8_BAR;
            }
        }
        if constexpr (ALIGN_EPI) { if (wr == 0) PG8_BAR; }
        if constexpr (Sched::SPLIT) {
            int aim = 3, flip = 0;
            if (cur.kh >= 0) {
                const int kh = cur.kh, pair = S.c % S.R;
                const __amdgpu_buffer_rsrc_t rw = __builtin_amdgcn_make_buffer_rsrc((void*)(unsigned char*)(S.wsb + S.xoff + (size_t)(pair * 2 + (1 - kh)) * 131072), 0, 131072, 0x00020000);
                const __amdgpu_buffer_rsrc_t rr = __builtin_amdgcn_make_buffer_rsrc((void*)(unsigned char*)(S.wsb + S.xoff + (size_t)(pair * 2 + kh) * 131072), 0, 131072, 0x00020000);
                int tl = tid; asm volatile("" : "+v"(tl)); const int vo = tl * 16;
#pragma unroll
                for (int j = 0; j < 16; ++j) __builtin_amdgcn_raw_buffer_store_b128(__builtin_bit_cast(u32x4, acc[1][j >> 3][(j >> 1) & 3][j & 1]), rw, vo, j * 8192, 16);
                PG8_WAIT_V(0); PG8_BAR;
                if (tl == 0) { (void)__hip_atomic_fetch_add(&((unsigned*)(S.wsb + S.foff))[(pair * 2 + kh) * 16], 1u, __ATOMIC_RELAXED, __HIP_MEMORY_SCOPE_AGENT);
                    unsigned sp = 0; while (__hip_atomic_load(&((unsigned*)(S.wsb + S.foff))[(pair * 2 + (1 - kh)) * 16], __ATOMIC_RELAXED, __HIP_MEMORY_SCOPE_AGENT) == 0u) { __builtin_amdgcn_s_sleep(1); if (++sp > (1u << 22)) break; } }
                PG8_BAR;
#pragma unroll
                for (int j = 0; j < 16; ++j) acc[0][j >> 3][(j >> 1) & 3][j & 1] += __builtin_bit_cast(f32x4, __builtin_amdgcn_raw_buffer_load_b128(rr, vo, j * 8192, 16));
                aim = 1; flip = kh;
            }
            E(acc, cur, wr, wc, fr, fq, (const PG8_LAS float*)(pf + par * 8192 + wid * 1024), aim, flip); S.done(cur);
        } else
        if constexpr (!Epi::AFTER_DRAIN) { E(acc, cur, wr, wc, fr, fq, (const PG8_LAS float*)(pf + par * 8192 + wid * 1024)); S.done(cur); }
        if (!has_next) break;
#pragma unroll
        for (int a = 0; a < 2; ++a)
#pragma unroll
            for (int b = 0; b < 2; ++b)
#pragma unroll
                for (int m = 0; m < 4; ++m)
#pragma unroll
                    for (int n = 0; n < 2; ++n) acc[a][b][m][n] = (f32x4){0.f, 0.f, 0.f, 0.f};
        cur = nxt; cA = nA; cB = nB; if constexpr (Sched::SPLIT) hsA = cur.kh > 0 ? -(long)hstepA : (long)hstepA; ++ui; par ^= 1;
        E.prefetch(cur, (PG8_LAS float*)(pf + par * 8192 + wid * 1024), lane, wr, wc);
        if constexpr (ALIGN_EPI) { if (wr == 1) PG8_BAR; }
    }
    PG8_WAIT_V(0);
    if constexpr (!ALIGN_EPI) { if (wr == 0) PG8_BAR; }
    PG8_BAR;
#undef PG8_SA
#undef PG8_SB
#undef PG8_STAGE
#undef PG8_LDA
#undef PG8_LDB
#undef PG8_MMA
#undef PG8_WAIT_V
#undef PG8_WAIT_L
#undef PG8_BAR
#undef PG8_SCHED
#undef PG8_KOFF
#undef PG8_ABASE
#undef PG8_BBASE
}

template <class Epi, class Sched>
__device__ __forceinline__ void gemm_phase_strip(PG8_LAS unsigned char* lds, PG8_LAS unsigned char* slds, PG8_LAS unsigned char* pf, const Gemm g, const Sched& S, const Epi& E, int wv) {
    const int tid = tid_here(wv), wid = wv, lane = tid & 63, wr = wid >> 2, wc = wid & 3, fr = lane & 15, fq = lane >> 4;
    const int K = g.K, nt = K / BK, lda = g.lda;
    unsigned voffA[2], voffB[2], voffS;
#pragma unroll
    for (int i = 0; i < 2; ++i) { int R, C; stage_rc(tid * 16 + i * 8192, R, C); const int Rb = Epi::PERM ? ((R & ~31) + perm32(R & 31)) : R;
        voffA[i] = (unsigned)(R * lda + C) * 2u; voffB[i] = (unsigned)(Rb * K + C) * 2u; }
    { const int d = wid * 64 + lane, P = d >> 2, sub = d & 3, r = P >> 3, c = (P & 7) ^ (r & 7); voffS = (unsigned)(r * lda + c * 8 + sub * 2) * 2u; }
    const size_t kstep = (size_t)(BK * 2);
    const size_t hstepA = (size_t)HALF * lda * 2, hstepB = (size_t)HALF * K * 2;
    const size_t tstepA = 2 * hstepA, tstepB = 2 * hstepB;
    const unsigned ldsw = (unsigned)wid * 1024u, ldss = (unsigned)wid * 256u;
    const int aoff = lds_byte(wr * 64 + fr, fq * 8), boff = lds_byte(wc * 32 + fr, fq * 8);
    const int soff0 = fr * 128 + ((fq ^ (fr & 7)) << 4);
#define PG8_SA(b, h) (((b) * 2 + (h)) * HTB)
#define PG8_SB(b, h) ((4 + (b) * 2 + (h)) * HTB)
#define PG8_STAGE(bufoff, gbase, voff) do { _Pragma("unroll") for (int _i = 0; _i < 2; ++_i) \
        __builtin_amdgcn_global_load_lds((const GAS unsigned*)((const GAS char*)(gbase) + (voff)[_i]), (PG8_LAS unsigned*)(lds + (bufoff) + ldsw + _i * 8192), 16, 0, 0); } while (0)
#define PG8_STAGE_S(b, gbase) do { unsigned _vs = voffS; asm volatile("" : "+v"(_vs));        \
        __builtin_amdgcn_global_load_lds((const GAS unsigned*)((const GAS char*)(gbase) + _vs), (PG8_LAS unsigned*)(slds + (b) * 2048 + ldss), 4, 0, 0); } while (0)
#define PG8_LDA(dst, b, h) do { _Pragma("unroll") for (int m = 0; m < 4; ++m) _Pragma("unroll") for (int k = 0; k < 2; ++k) dst[m][k] = *(const PG8_LAS bf16x8*)(lds + PG8_SA(b, h) + aoff + m * 2048 + k * 1024); } while (0)
#define PG8_LDB(dst, b, h) do { _Pragma("unroll") for (int n = 0; n < 2; ++n) _Pragma("unroll") for (int k = 0; k < 2; ++k) dst[n][k] = *(const PG8_LAS bf16x8*)(lds + PG8_SB(b, h) + boff + n * 2048 + k * 1024); } while (0)
#define PG8_LDS_S(dst, b) do { dst[0] = *(const PG8_LAS bf16x8*)(slds + (b) * 2048 + soff0); dst[1] = *(const PG8_LAS bf16x8*)(slds + (b) * 2048 + (soff0 ^ 64)); } while (0)
#define PG8_MMA(ai, bj, At, Bt) do { __builtin_amdgcn_s_setprio(1); _Pragma("unroll") for (int m = 0; m < 4; ++m) _Pragma("unroll") for (int n = 0; n < 2; ++n) _Pragma("unroll") for (int k = 0; k < 2; ++k) \
        acc[ai][bj][m][n] = __builtin_amdgcn_mfma_f32_16x16x32_bf16(Bt[n][k], At[m][k], acc[ai][bj][m][n], 0, 0, 0); __builtin_amdgcn_s_setprio(0); } while (0)
#define PG8_MMA_S() do { __builtin_amdgcn_s_setprio(1); if (wr == 0) { _Pragma("unroll") for (int k = 0; k < 2; ++k) { accS[0] = __builtin_amdgcn_mfma_f32_16x16x32_bf16(B0[0][k], As[k], accS[0], 0, 0, 0); accS[1] = __builtin_amdgcn_mfma_f32_16x16x32_bf16(B1[0][k], As[k], accS[1], 0, 0, 0); } } \
        else { _Pragma("unroll") for (int k = 0; k < 2; ++k) { accS[0] = __builtin_amdgcn_mfma_f32_16x16x32_bf16(B0[1][k], As[k], accS[0], 0, 0, 0); accS[1] = __builtin_amdgcn_mfma_f32_16x16x32_bf16(B1[1][k], As[k], accS[1], 0, 0, 0); } } __builtin_amdgcn_s_setprio(0); } while (0)
#define PG8_WAIT_V(n) asm volatile("s_waitcnt vmcnt(" #n ")" ::: "memory")
#define PG8_WAIT_L(n) asm volatile("s_waitcnt lgkmcnt(" #n ")" ::: "memory")
#define PG8_BAR __builtin_amdgcn_s_barrier()
#define PG8_SCHED __builtin_amdgcn_sched_barrier(0)
#define PG8_KOFF(u) ((Sched::SPLIT && (u).kh > 0) ? (size_t)K : (size_t)0)
#define PG8_ABASE(u) ((const GAS char*)g.A + (size_t)(u).pm * tstepA + (size_t)((u).pn / g.a_tpg) * (size_t)K * 2 + PG8_KOFF(u))
#define PG8_BBASE(u) ((const GAS char*)g.Bt + (size_t)(u).pn * tstepB + PG8_KOFF(u))
#define PG8_SBASE(u) ((const GAS char*)g.A + (size_t)(u).srow * (size_t)lda * 2 + (size_t)((u).pn / g.a_tpg) * (size_t)K * 2 + PG8_KOFF(u))
#define PG8_HS (Sched::SPLIT ? hsA : (long)hstepA)
    Unit cur, nxt; int ui = 0;
    if (!S.next(0, cur)) return;
    f32x4 acc[2][2][4][2]; f32x4 accS[2];
#pragma unroll
    for (int a = 0; a < 2; ++a)
#pragma unroll
        for (int b = 0; b < 2; ++b)
#pragma unroll
            for (int m = 0; m < 4; ++m)
#pragma unroll
                for (int n = 0; n < 2; ++n) acc[a][b][m][n] = (f32x4){0.f, 0.f, 0.f, 0.f};
    accS[0] = (f32x4){0.f, 0.f, 0.f, 0.f}; accS[1] = (f32x4){0.f, 0.f, 0.f, 0.f};
    bf16x8 At[4][2], B0[2][2], B1[2][2], As[2];
    const GAS char* cA = PG8_ABASE(cur); const GAS char* cB = PG8_BBASE(cur); const GAS char* cS = PG8_SBASE(cur);
    long hsA = (long)hstepA;
    if constexpr (Sched::SPLIT) { if (cur.kh > 0) { cA += hstepA; hsA = -(long)hstepA; } }
    int par = 0;
    E.prefetch(cur, (PG8_LAS float*)(pf + wid * 1024), lane, wr, wc);
    PG8_STAGE(PG8_SB(0, 0), cB, voffB); PG8_STAGE(PG8_SB(0, 1), cB + hstepB, voffB); PG8_STAGE(PG8_SA(0, 0), cA, voffA); PG8_STAGE(PG8_SA(0, 1), cA + PG8_HS, voffA); PG8_STAGE_S(0, cS);
    if (wr == 1) PG8_BAR;
    PG8_WAIT_V(3); PG8_BAR;
    PG8_STAGE(PG8_SB(1, 0), cB + kstep, voffB); PG8_STAGE(PG8_SA(1, 0), cA + kstep, voffA); PG8_STAGE(PG8_SB(1, 1), cB + hstepB + kstep, voffB);
    PG8_WAIT_V(6); PG8_BAR;
    for (;;) {
        const bool has_next = S.next(ui + 1, nxt);
        const GAS char* nA = has_next ? PG8_ABASE(nxt) : cA; const GAS char* nB = has_next ? PG8_BBASE(nxt) : cB; const GAS char* nS = has_next ? PG8_SBASE(nxt) : cS;
        if constexpr (Sched::SPLIT) { if (has_next && nxt.kh > 0) nA += hstepA; }
        int ntu = nt; if constexpr (Sched::SPLIT) { if (cur.kh >= 0) ntu = nt >> 1; }
        for (int t = 0; t < ntu; t += 2) {
            const bool last = (t == ntu - 2);
            const GAS char* a1 = cA + (size_t)(t + 1) * kstep; const GAS char* s1 = cS + (size_t)(t + 1) * kstep;
            const GAS char* a2 = last ? nA : cA + (size_t)(t + 2) * kstep; const GAS char* b2 = last ? nB : cB + (size_t)(t + 2) * kstep; const GAS char* s2 = last ? nS : cS + (size_t)(t + 2) * kstep;
            const GAS char* a3 = a2 + kstep; const GAS char* b3 = b2 + kstep;
            PG8_LDB(B0, 0, 0); PG8_LDB(B1, 0, 1); PG8_SCHED; PG8_LDA(At, 0, 0); PG8_STAGE(PG8_SA(1, 1), a1 + PG8_HS, voffA); PG8_STAGE_S(1, s1);
            PG8_WAIT_V(9); PG8_WAIT_L(0); PG8_BAR; PG8_MMA(0, 0, At, B0); PG8_MMA(0, 1, At, B1); PG8_BAR; PG8_SCHED;
            PG8_LDA(At, 0, 1); PG8_LDS_S(As, 0); PG8_STAGE(PG8_SB(0, 0), b2, voffB); PG8_STAGE(PG8_SB(0, 1), b2 + hstepB, voffB); PG8_STAGE(PG8_SA(0, 0), a2, voffA);
            PG8_WAIT_V(9); PG8_WAIT_L(0); PG8_BAR; PG8_MMA(1, 0, At, B0); PG8_MMA(1, 1, At, B1); PG8_MMA_S(); PG8_BAR; PG8_SCHED;
            PG8_LDB(B0, 1, 0); PG8_LDB(B1, 1, 1); PG8_SCHED; PG8_LDA(At, 1, 0); PG8_STAGE(PG8_SA(0, 1), a2 + (Sched::SPLIT ? ((last && has_next) ? (nxt.kh > 0 ? -(long)hstepA : (long)hstepA) : hsA) : (long)hstepA), voffA); PG8_STAGE_S(0, s2);
            PG8_WAIT_V(9); PG8_WAIT_L(0); PG8_BAR; PG8_MMA(0, 0, At, B0); PG8_MMA(0, 1, At, B1); PG8_BAR; PG8_SCHED;
            PG8_LDA(At, 1, 1); PG8_LDS_S(As, 1); PG8_STAGE(PG8_SB(1, 0), b3, voffB); PG8_STAGE(PG8_SB(1, 1), b3 + hstepB, voffB); PG8_STAGE(PG8_SA(1, 0), a3, voffA);
            PG8_WAIT_V(9); PG8_WAIT_L(0); PG8_BAR; PG8_MMA(1, 0, At, B0); PG8_MMA(1, 1, At, B1); PG8_MMA_S(); PG8_BAR; PG8_SCHED;
        }
        if (wr == 0) PG8_BAR;
        if constexpr (Sched::SPLIT) {
            int aim = 3, flip = 0;
            if (cur.kh >= 0) {
                const int kh = cur.kh, pair = S.c % S.R;
                const __amdgpu_buffer_rsrc_t rw = __builtin_amdgcn_make_buffer_rsrc((void*)(unsigned char*)(S.wsb + S.xoff + (size_t)(pair * 2 + (1 - kh)) * 147456), 0, 147456, 0x00020000);
                const __amdgpu_buffer_rsrc_t rr = __builtin_amdgcn_make_buffer_rsrc((void*)(unsigned char*)(S.wsb + S.xoff + (size_t)(pair * 2 + kh) * 147456), 0, 147456, 0x00020000);
                int tl = tid; asm volatile("" : "+v"(tl)); const int vo = tl * 16;
#pragma unroll
                for (int j = 0; j < 16; ++j) __builtin_amdgcn_raw_buffer_store_b128(__builtin_bit_cast(u32x4, acc[1][j >> 3][(j >> 1) & 3][j & 1]), rw, vo, j * 8192, 16);
                __builtin_amdgcn_raw_buffer_store_b128(__builtin_bit_cast(u32x4, accS[0]), rw, vo, 16 * 8192, 16); __builtin_amdgcn_raw_buffer_store_b128(__builtin_bit_cast(u32x4, accS[1]), rw, vo, 17 * 8192, 16);
                PG8_WAIT_V(0); PG8_BAR;
                if (tl == 0) { (void)__hip_atomic_fetch_add(&((unsigned*)(S.wsb + S.foff))[(pair * 2 + kh) * 16], 1u, __ATOMIC_RELAXED, __HIP_MEMORY_SCOPE_AGENT);
                    unsigned sp = 0; while (__hip_atomic_load(&((unsigned*)(S.wsb + S.foff))[(pair * 2 + (1 - kh)) * 16], __ATOMIC_RELAXED, __HIP_MEMORY_SCOPE_AGENT) == 0u) { __builtin_amdgcn_s_sleep(1); if (++sp > (1u << 22)) break; } }
                PG8_BAR;
#pragma unroll
                for (int j = 0; j < 16; ++j) acc[0][j >> 3][(j >> 1) & 3][j & 1] += __builtin_bit_cast(f32x4, __builtin_amdgcn_raw_buffer_load_b128(rr, vo, j * 8192, 16));
                accS[0] += __builtin_bit_cast(f32x4, __builtin_amdgcn_raw_buffer_load_b128(rr, vo, 16 * 8192, 16)); accS[1] += __builtin_bit_cast(f32x4, __builtin_amdgcn_raw_buffer_load_b128(rr, vo, 17 * 8192, 16));
                aim = 1; flip = kh;
            }
            E(acc, cur, wr, wc, fr, fq, (const PG8_LAS float*)(pf + par * 8192 + wid * 1024), aim, flip); if (cur.kh <= 0) E.strip(accS, cur, wr, wc, fr, fq);
        } else {
        E(acc, cur, wr, wc, fr, fq, (const PG8_LAS float*)(pf + par * 8192 + wid * 1024)); E.strip(accS, cur, wr, wc, fr, fq); }
        if (!has_next) break;
#pragma unroll
        for (int a = 0; a < 2; ++a)
#pragma unroll
            for (int b = 0; b < 2; ++b)
#pragma unroll
                for (int m = 0; m < 4; ++m)
#pragma unroll
                    for (int n = 0; n < 2; ++n) acc[a][b][m][n] = (f32x4){0.f, 0.f, 0.f, 0.f};
        accS[0] = (f32x4){0.f, 0.f, 0.f, 0.f}; accS[1] = (f32x4){0.f, 0.f, 0.f, 0.f};
        cur = nxt; cA = nA; cB = nB; cS = nS; if constexpr (Sched::SPLIT) hsA = cur.kh > 0 ? -(long)hstepA : (long)hstepA; ++ui; par ^= 1;
        E.prefetch(cur, (PG8_LAS float*)(pf + par * 8192 + wid * 1024), lane, wr, wc);
        if (wr == 1) PG8_BAR;
    }
    PG8_WAIT_V(0);
    PG8_BAR;
#undef PG8_SA
#undef PG8_SB
#undef PG8_STAGE
#undef PG8_STAGE_S
#undef PG8_LDA
#undef PG8_LDB
#undef PG8_LDS_S
#undef PG8_MMA
#undef PG8_MMA_S
#undef PG8_WAIT_V
#undef PG8_WAIT_L
#undef PG8_BAR
#undef PG8_SCHED
#undef PG8_ABASE
#undef PG8_BBASE
#undef PG8_SBASE
#undef PG8_KOFF
#undef PG8_HS
}
}

namespace att {
using s16x4  = __attribute__((ext_vector_type(4))) short;
using f32x16 = __attribute__((ext_vector_type(16))) float;
constexpr int D = 128, NW = 8, QBLK = 32, KVBLK = 64;
constexpr float SCALE = 0.088388347648318440f;
constexpr float THR = 8.f;
constexpr int SHM_V = KVBLK * D * 2, SHM_K = KVBLK * D * 2, SHM_WS = 2 * SHM_V + 2 * SHM_K, SHM_BIAS = SHM_WS + NW * 64 * 4, SHM_ATTN = SHM_BIAS + 2560, OST_HI = 71680  ;
constexpr int NBIAS = 15 * 31, BIAS_PAD = 48;
#define KSWZ(row, colB) ((row) * 256 + ((colB) ^ (((row) & 7) << 4)))
#define SBAR() __builtin_amdgcn_sched_barrier(0)
__device__ __forceinline__ int crow(int r, int hi) { return (r & 3) + 8 * (r >> 2) + 4 * hi; }
__device__ __forceinline__ unsigned cvtpk(float lo, float hi) { unsigned r; asm volatile("v_cvt_pk_bf16_f32 %0, %1, %2" : "=v"(r) : "v"(lo), "v"(hi)); return r; }

constexpr float QSCALE = SCALE * 1.4426950408889634f;
template <bool FIRST>
__device__ __forceinline__ void partialSM(f32x16& p0, f32x16& p1, float& m_reg, float& alpha) {
  constexpr float THRL = THR * 1.4426950408889634f;
  float pmax = p0[0];
#pragma unroll
  for (int r = 1; r < 16; ++r) pmax = fmaxf(pmax, p0[r]);
#pragma unroll
  for (int r = 0; r < 16; ++r) pmax = fmaxf(pmax, p1[r]);
  { auto rr = __builtin_amdgcn_permlane32_swap(__float_as_uint(pmax), __float_as_uint(pmax), false, false);
    pmax = fmaxf(__uint_as_float(rr[0]), __uint_as_float(rr[1])); }
  if (!FIRST && __builtin_expect(__all(pmax <= THRL), 1)) { alpha = 1.f; }
  else { const float delta = FIRST ? pmax : fmaxf(pmax, 0.f); alpha = FIRST ? 1.f : __builtin_amdgcn_exp2f(-delta); m_reg += delta;
#pragma unroll
    for (int r = 0; r < 16; ++r) { p0[r] -= delta; p1[r] -= delta; } }
#pragma unroll
  for (int r = 0; r < 16; ++r) p0[r] = __builtin_amdgcn_exp2f(p0[r]);
}
__device__ __forceinline__ void finishSM(f32x16& p0, f32x16& p1, float alpha, float& l_reg, bf16x8& pa0, bf16x8& pa1, bf16x8& pa2, bf16x8& pa3) {
#pragma unroll
  for (int r = 0; r < 16; ++r) p1[r] = __builtin_amdgcn_exp2f(p1[r]);
  float ps = 0;
#pragma unroll
  for (int r = 0; r < 16; ++r) ps += p0[r];
#pragma unroll
  for (int r = 0; r < 16; ++r) ps += p1[r];
  { auto rr = __builtin_amdgcn_permlane32_swap(__float_as_uint(ps), __float_as_uint(ps), false, false);
    ps = __uint_as_float(rr[0]) + __uint_as_float(rr[1]); }
  l_reg = l_reg * alpha + ps;
#define PK4(P, BASE, OUT) do { unsigned a0 = cvtpk(P[BASE + 0], P[BASE + 1]), a1 = cvtpk(P[BASE + 2], P[BASE + 3]);   \
    unsigned b0 = cvtpk(P[BASE + 4], P[BASE + 5]), b1 = cvtpk(P[BASE + 6], P[BASE + 7]);                              \
    auto r0 = __builtin_amdgcn_permlane32_swap(a0, b0, false, false); auto r1 = __builtin_amdgcn_permlane32_swap(a1, b1, false, false); \
    u32x4 w = {r0[0], r1[0], r0[1], r1[1]}; OUT = *reinterpret_cast<bf16x8*>(&w); } while (0)
  PK4(p0, 0, pa0); PK4(p0, 8, pa1); PK4(p1, 0, pa2); PK4(p1, 8, pa3);
#undef PK4
}
__device__ __forceinline__ void qkt(f32x16& p0, f32x16& p1, const char* Ks, const bf16x8* qr, int r32, int hi, float negm) {
#pragma unroll
  for (int r = 0; r < 16; ++r) { p0[r] = negm; p1[r] = negm; }
#pragma unroll
  for (int d0 = 0; d0 < 8; ++d0) { int cb = (d0 * 16 + hi * 8) * 2;
    bf16x8 b0 = *reinterpret_cast<const bf16x8*>(Ks + KSWZ(r32, cb));
    bf16x8 b1 = *reinterpret_cast<const bf16x8*>(Ks + KSWZ(32 + r32, cb));
    p0 = __builtin_amdgcn_mfma_f32_32x32x16_bf16(b0, qr[d0], p0, 0, 0, 0);
    p1 = __builtin_amdgcn_mfma_f32_32x32x16_bf16(b1, qr[d0], p1, 0, 0, 0); }
}
__device__ __forceinline__ int v_st(int k, int c) { const int kk = (k & ~0xC) | ((k & 4) << 1) | ((k & 8) >> 1); return ((kk >> 3) * 4 + (c >> 5)) * 512 + ((kk & 7) * 32 + (c & 31)) * 2; }
__device__ __forceinline__ int v_rd_base(int lane) { return ((lane & 3) << 3) | (((lane >> 2) & 3) << 6) | (((lane >> 4) & 1) << 5) | (((lane >> 5) & 1) << 8); }
constexpr int v_rd_off(int d0, int ks, int half) { return d0 * 512 + ks * 4096 + half * 2048; }
template <int OFF> __device__ __forceinline__ s16x4 tr_read(int vb) {
  s16x4 r; asm volatile("ds_read_b64_tr_b16 %0, %1 offset:%2" : "=&v"(r) : "v"(vb), "i"(OFF) : "memory"); return r;
}
template <int D0> __device__ __forceinline__ void pv_one(f32x16& od, int vb, bf16x8 pa0, bf16x8 pa1, bf16x8 pa2, bf16x8 pa3) {
  const s16x4 l0 = tr_read<v_rd_off(D0, 0, 0)>(vb), h0 = tr_read<v_rd_off(D0, 0, 1)>(vb), l1 = tr_read<v_rd_off(D0, 1, 0)>(vb), h1 = tr_read<v_rd_off(D0, 1, 1)>(vb);
  const s16x4 l2 = tr_read<v_rd_off(D0, 2, 0)>(vb), h2 = tr_read<v_rd_off(D0, 2, 1)>(vb), l3 = tr_read<v_rd_off(D0, 3, 0)>(vb), h3 = tr_read<v_rd_off(D0, 3, 1)>(vb);
  asm volatile("s_waitcnt lgkmcnt(0)" ::: "memory"); SBAR();
#define PK(L, H) (bf16x8){L[0], L[1], L[2], L[3], H[0], H[1], H[2], H[3]}
  od = __builtin_amdgcn_mfma_f32_32x32x16_bf16(pa0, PK(l0, h0), od, 0, 0, 0);
  od = __builtin_amdgcn_mfma_f32_32x32x16_bf16(pa1, PK(l1, h1), od, 0, 0, 0);
  od = __builtin_amdgcn_mfma_f32_32x32x16_bf16(pa2, PK(l2, h2), od, 0, 0, 0);
  od = __builtin_amdgcn_mfma_f32_32x32x16_bf16(pa3, PK(l3, h3), od, 0, 0, 0);
#undef PK
}
__device__ __forceinline__ void pv_d0(f32x16* o, int vb, bf16x8 pa0, bf16x8 pa1, bf16x8 pa2, bf16x8 pa3) {
  pv_one<0>(o[0], vb, pa0, pa1, pa2, pa3); pv_one<1>(o[1], vb, pa0, pa1, pa2, pa3); pv_one<2>(o[2], vb, pa0, pa1, pa2, pa3); pv_one<3>(o[3], vb, pa0, pa1, pa2, pa3);
}
__device__ __forceinline__ void nat_mask(f32x16& p0, f32x16& p1, const float* blp, unsigned mlo, unsigned mhi) {
#pragma unroll
  for (int r = 0; r < 16; ++r) {
    const int c = (r & 3) + 8 * (r >> 2);
    const float b0 = blp[c], b1 = blp[c + 32];
    p0[r] = ((mlo >> c) & 1u) ? p0[r] + b0 : -1e30f;
    p1[r] = ((mhi >> c) & 1u) ? p1[r] + b1 : -1e30f;
  }
}
template <bool NATM, int QN>
__device__ __forceinline__ void attn_unit(const gb16* __restrict__ Qb, const gb16* __restrict__ Kh, const gb16* __restrict__ Vh, gb16* __restrict__ Ob,
                                          int ldq, int ldk, int ldo, int n1, int off2, int NT, char* lds, int qrow0, int kr_lo, const gf32* qg, const gf32* rope, int qtok0, int wv) {
  const int tid = tid_here(wv), wid = wv, lane = tid & 63, r32 = lane & 31, hi = lane >> 5;
  char* V_lds = lds; char* K_lds = lds + 2 * SHM_V;
  float* ws = (float*)(lds + SHM_WS) + wid * 64; float* li_l = ws; float* al_l = ws + 32;
  const float* bl = (const float*)(lds + SHM_BIAS);
  float m_reg = 0.f, l_reg = 0; f32x16 o[4] = {}; bf16x8 qr[8];
  unsigned kso[2], vso[2];
#pragma unroll
  for (int i = 0; i < 2; ++i) { const int B = i * 8 + wid;
    const int row = 4 * B + (lane >> 4); kso[i] = (unsigned)(row * ldk + (((lane & 15) ^ (row & 7)) << 3)) * 2u;
    const int S = 2 * B + (lane >> 5), kk = (S >> 2) * 8 + ((lane >> 2) & 7), kt = (kk & ~0xC) | ((kk & 4) << 1) | ((kk & 8) >> 1), c = (S & 3) * 32 + (lane & 3) * 8; vso[i] = (unsigned)(kt * ldk + c) * 2u; }
#define KROW(j) ((j) < n1 ? (j) * KVBLK : off2 + ((j) - n1) * KVBLK)
#define KDMA(b, k0) do { const GAS char* _g = (const GAS char*)Kh + (size_t)(k0) * (size_t)ldk * 2; _Pragma("unroll") for (int _i = 0; _i < 2; ++_i) \
    __builtin_amdgcn_global_load_lds((const GAS unsigned*)(_g + kso[_i]), (LAS unsigned*)(K_lds + (b) * SHM_K + (_i * 8 + wid) * 1024), 16, 0, 0); } while (0)
#define VDMA(b, k0) do { const GAS char* _g = (const GAS char*)Vh + (size_t)(k0) * (size_t)ldk * 2; _Pragma("unroll") for (int _i = 0; _i < 2; ++_i) \
    __builtin_amdgcn_global_load_lds((const GAS unsigned*)(_g + vso[_i]), (LAS unsigned*)(V_lds + (b) * SHM_V + (_i * 8 + wid) * 1024), 16, 0, 0); } while (0)
  KDMA(0, KROW(0)); VDMA(0, KROW(0)); KDMA(1, KROW(1));
  const gb16* Qw = Qb + (long)(wid * QBLK + r32) * ldq + hi * 8;
#pragma unroll
  for (int d0 = 0; d0 < 8; ++d0) qr[d0] = *(const gbf16x8*)(Qw + d0 * 16);
  if constexpr (QN != 0) {
    float ss = 0.f;
#pragma unroll
    for (int d0 = 0; d0 < 8; ++d0) { const u32x4 w = *reinterpret_cast<const u32x4*>(&qr[d0]);
      ss += (bf_lo(w.x) * bf_lo(w.x) + bf_hi(w.x) * bf_hi(w.x)) + (bf_lo(w.y) * bf_lo(w.y) + bf_hi(w.y) * bf_hi(w.y)) + (bf_lo(w.z) * bf_lo(w.z) + bf_hi(w.z) * bf_hi(w.z)) + (bf_lo(w.w) * bf_lo(w.w) + bf_hi(w.w) * bf_hi(w.w)); }
    { auto rr = __builtin_amdgcn_permlane32_swap(__float_as_uint(ss), __float_as_uint(ss), false, false); ss = __uint_as_float(rr[0]) + __uint_as_float(rr[1]); }
    const float rstd = QSCALE * __builtin_amdgcn_rsqf(ss * (1.0f / D) + NORM_EPS);
    const int tok = qtok0 + wid * QBLK + r32, pr = tok >> 6, pc = tok & 63;
#pragma unroll
    for (int d0 = 0; d0 < 8; ++d0) { const u32x4 w = *reinterpret_cast<const u32x4*>(&qr[d0]);
      const f32x4 g0 = *(const gf32x4*)(qg + d0 * 16 + hi * 8), g1 = *(const gf32x4*)(qg + d0 * 16 + hi * 8 + 4);
      float y[8] = {bf_lo(w.x) * rstd * g0.x, bf_hi(w.x) * rstd * g0.y, bf_lo(w.y) * rstd * g0.z, bf_hi(w.y) * rstd * g0.w, bf_lo(w.z) * rstd * g1.x, bf_hi(w.z) * rstd * g1.y, bf_lo(w.w) * rstd * g1.z, bf_hi(w.w) * rstd * g1.w};
      if constexpr (QN == 2) { const int pos = d0 < 4 ? pr : pc, f0 = (d0 & 3) * 8 + hi * 4;
        const f32x4 t0 = *(const gf32x4*)(rope + 2 * (pos * 32 + f0)), t1 = *(const gf32x4*)(rope + 2 * (pos * 32 + f0) + 4);
        const float a0 = y[0] * t0.x - y[1] * t0.y, b0 = y[0] * t0.y + y[1] * t0.x, a1 = y[2] * t0.z - y[3] * t0.w, b1 = y[2] * t0.w + y[3] * t0.z;
        const float a2 = y[4] * t1.x - y[5] * t1.y, b2 = y[4] * t1.y + y[5] * t1.x, a3 = y[6] * t1.z - y[7] * t1.w, b3 = y[6] * t1.w + y[7] * t1.z;
        y[0] = a0; y[1] = b0; y[2] = a1; y[3] = b1; y[4] = a2; y[5] = b2; y[6] = a3; y[7] = b3; }
      u32x4 o4; o4.x = cvtpk(y[0], y[1]); o4.y = cvtpk(y[2], y[3]); o4.z = cvtpk(y[4], y[5]); o4.w = cvtpk(y[6], y[7]); qr[d0] = *reinterpret_cast<bf16x8*>(&o4); }
  }
  const int vb0 = (int)(uintptr_t)V_lds + v_rd_base(lane);
  const int nq_row = qrow0 + (wid >> 1), nq_col = 32 * (wid & 1) + r32, nrs = min(max(nq_row - 4, 0), 56);
  const unsigned long long nwin = (0xFFFFull << min(max(nq_col - 8, 0), 48)) >> (4 * hi);
  const unsigned nmlo = (unsigned)nwin, nmhi = (unsigned)(nwin >> 32);
  const float* nbl = bl + BIAS_PAD + 15 - nq_col + 4 * hi;
#define LANDED() do { asm volatile("s_waitcnt vmcnt(0)" ::: "memory"); __syncthreads(); } while (0)
#define RESC(a) do { if (__any((a) < 1.f)) { if (hi == 0) al_l[r32] = (a); asm volatile("s_waitcnt lgkmcnt(0)" ::: "memory"); \
    _Pragma("unroll") for (int d = 0; d < 4; ++d) _Pragma("unroll") for (int r = 0; r < 16; ++r) o[d][r] *= al_l[crow(r, hi)]; } } while (0)
#define NMASK(P0, P1, j) do { if (NATM) { if ((j) >= n1) { const int _kr = kr_lo + ((j) - n1); const bool _ok = (_kr >= nrs) && (_kr < nrs + 8); const int _dr = min(max(_kr - nq_row + 7, 0), 14); \
    nat_mask(P0, P1, nbl + _dr * 31, _ok ? nmlo : 0u, _ok ? nmhi : 0u); } } } while (0)
  f32x16 pA0, pA1, pB0, pB1; float alA, alB; bf16x8 pa0, pa1, pa2, pa3;
  LANDED();
  qkt(pA0, pA1, K_lds, qr, r32, hi, 0.f); NMASK(pA0, pA1, 0); partialSM<true>(pA0, pA1, m_reg, alA);
  __syncthreads();
#define OKT(j) (!NATM || (j) < n1 || (kr_lo + ((j) - n1) >= nrs && kr_lo + ((j) - n1) < nrs + 8))
  bool okA = true, okB;
  for (int j = 1; j + 1 < NT; j += 2) {
    KDMA(0, KROW(j + 1)); VDMA(1, KROW(j));
    okB = OKT(j);
    SBAR(); if (okB) qkt(pB0, pB1, K_lds + SHM_K, qr, r32, hi, -m_reg);
    if (okA) { finishSM(pA0, pA1, alA, l_reg, pa0, pa1, pa2, pa3); SBAR();
      pv_d0(o, vb0, pa0, pa1, pa2, pa3); }
    if (okB) { NMASK(pB0, pB1, j); partialSM<false>(pB0, pB1, m_reg, alB); RESC(alB); }
    LANDED();
    if (j + 2 < NT) KDMA(1, KROW(j + 2)); VDMA(0, KROW(j + 1));
    okA = OKT(j + 1);
    SBAR(); if (okA) qkt(pA0, pA1, K_lds, qr, r32, hi, -m_reg);
    if (okB) { finishSM(pB0, pB1, alB, l_reg, pa0, pa1, pa2, pa3); SBAR();
      pv_d0(o, vb0 + SHM_V, pa0, pa1, pa2, pa3); }
    if (okA) { NMASK(pA0, pA1, j + 1); partialSM<false>(pA0, pA1, m_reg, alA); RESC(alA); }
    LANDED();
  }
  VDMA(1, KROW(NT - 1));
  okB = OKT(NT - 1);
  SBAR(); if (okB) qkt(pB0, pB1, K_lds + SHM_K, qr, r32, hi, -m_reg);
  if (okA) { finishSM(pA0, pA1, alA, l_reg, pa0, pa1, pa2, pa3); SBAR();
    pv_d0(o, vb0, pa0, pa1, pa2, pa3); }
  if (okB) { NMASK(pB0, pB1, NT - 1); partialSM<false>(pB0, pB1, m_reg, alB); RESC(alB); }
  LANDED();
  if (okB) { finishSM(pB0, pB1, alB, l_reg, pa0, pa1, pa2, pa3); SBAR();
    pv_d0(o, vb0 + SHM_V, pa0, pa1, pa2, pa3); }
  if (hi == 0) li_l[r32] = l_reg; asm volatile("s_waitcnt lgkmcnt(0)" ::: "memory");
  float rli[16];
#pragma unroll
  for (int r = 0; r < 16; ++r) rli[r] = __builtin_amdgcn_rcpf(li_l[crow(r, hi)]);
  gb16* Ow = Ob + (long)(wid * QBLK) * ldo;
  { bf16_t* stg = (bf16_t*)(lds + (wid < 4 ? 2 * SHM_V + wid * 8192 : OST_HI + (wid - 4) * 8192));
#pragma unroll
    for (int r = 0; r < 16; ++r) { const int orow = crow(r, hi);
#pragma unroll
      for (int d0 = 0; d0 < 4; ++d0) { const unsigned pk = cvtpk(o[d0][r] * rli[r], 0.f); stg[orow * 128 + d0 * 32 + r32] = (bf16_t)(pk & 0xffffu); } }
    asm volatile("s_waitcnt lgkmcnt(0)" ::: "memory");
#pragma unroll
    for (int i = 0; i < 8; ++i) { const int row = i * 4 + (lane >> 4), ch = lane & 15; const u32x4 v = *(const u32x4*)(stg + row * 128 + ch * 8); *(gu32x4*)(Ow + (long)row * ldo + ch * 8) = v; } }
#undef OKT
#undef KROW
#undef KDMA
#undef VDMA
#undef LANDED
#undef RESC
#undef NMASK
}
}

constexpr size_t MiB = 1u << 20;
constexpr size_t WS_CTL = 0, CTL_ZERO_BYTES = 2 * MiB;
constexpr size_t WS_STATS = 64 * 1024;
constexpr size_t WS_BUP = 384 * 1024;
constexpr size_t WS_BQKV = 912 * 1024;
constexpr size_t WS_ADA = 2 * MiB;
constexpr size_t WS_ROPE = 3 * MiB;
constexpr size_t WS_XS = 4 * MiB;
constexpr size_t WS_H = 72 * MiB;
constexpr size_t WS_PO = 106 * MiB;
constexpr size_t WS_Q = 140 * MiB, WS_K = 174 * MiB, WS_V = 208 * MiB;
constexpr size_t WS_U = 242 * MiB;
constexpr size_t WS_W13 = 336 * MiB;
constexpr size_t WS_W2 = 512 * MiB;
constexpr size_t WS_PW = 600 * MiB;
constexpr size_t WS_GQKV = 604 * MiB, WS_GWO = 616 * MiB, WS_NQKV = 624 * MiB, WS_NWO = 648 * MiB, WS_END = 656 * MiB;
static_assert(WS_STATS + (size_t)9 * MROWS * 4 <= WS_BUP && WS_BUP + (size_t)4 * 3 * 2 * FF * 4 <= WS_BQKV && WS_BQKV + (size_t)2 * 3 * 6144 * 4 <= CTL_ZERO_BYTES, "ctl map");
static_assert(WS_XS + (size_t)MROWS * DM * 4 <= WS_H && WS_U + (size_t)MROWS * FF * 2 <= WS_W13 && WS_W13 + (size_t)4 * 2 * FF * DM * 2 <= WS_W2 && WS_W2 + (size_t)4 * DM * FF * 2 <= WS_PW, "ws map");
constexpr size_t CTL_FINAL_CNT = 49152;
constexpr size_t CTL_SPLIT_FLAGS2 = 0;
constexpr size_t CTL_SPLIT_FLAGS = 32768;
constexpr int CW_BAR = 4096;

constexpr int RING_BYTES = 131072, LDSCTL_OFF = RING_BYTES, MISC_OFF = LDSCTL_OFF + 320, STRIP_OFF = LDSCTL_OFF + 4096  , PF_OFF = 139264  , XK_OFF = 155648  , LDS_BYTES = 163840;

#define XB_TMO      128
#define XB_XCNT(j)  (256  + 64 * (j))
#define XB_XSUB(j)  (1280 + 64 * (j))
#define XB_XGEN(j)  (2304 + 64 * (j))
#define XB_TOP      3328
#define XB_TOPGEN   3392
#define XCD_BAR_WORDS 3456
#define XB_SPIN_CAP (1u << 18)
__device__ __forceinline__ unsigned xb_ld(unsigned* p)              { return __hip_atomic_load(p, __ATOMIC_RELAXED, __HIP_MEMORY_SCOPE_AGENT); }
__device__ __forceinline__ unsigned xb_add(unsigned* p, unsigned v) { return __hip_atomic_fetch_add(p, v, __ATOMIC_RELAXED, __HIP_MEMORY_SCOPE_AGENT); }
__device__ __forceinline__ unsigned xb_xcc_id() { return (unsigned)__builtin_amdgcn_s_getreg((3 << 11) | 20) & 0xFu; }
#define XB_SPIN(cond, bar) do { unsigned _sp = 0; while (cond) { __builtin_amdgcn_s_sleep(1); \
    if ((++_sp & 255u) == 0u) { if (xb_ld(&(bar)[XB_TMO])) break; if (_sp > XB_SPIN_CAP) { atomicAdd(&(bar)[XB_TMO], 1u); break; } } } } while (0)
struct XcdBarrier { unsigned* bar; unsigned x; volatile LAS unsigned* st; };
__device__ __forceinline__ XcdBarrier xcd_barrier_post(unsigned* bar, volatile LAS unsigned* st) {
    XcdBarrier b; b.bar = bar; b.x = xb_xcc_id(); b.st = st;
    if (threadIdx.x == 0) (void)xb_add(&bar[XB_XCNT(b.x)], 1u);
    return b;
}
__device__ __forceinline__ void xcd_barrier_complete(unsigned* bar, unsigned x, unsigned& nloc, unsigned& nx) {
    const unsigned G = gridDim.x * gridDim.y * gridDim.z;
    unsigned sum, cnt, mine, sp = 0u;
    for (;;) {
        sum = 0u; cnt = 0u; mine = 0u;
#pragma unroll
        for (unsigned j = 0; j < 16; ++j) { const unsigned c = xb_ld(&bar[XB_XCNT(j)]); sum += c; cnt += (c > 0u) ? 1u : 0u; mine = (j == x) ? c : mine; }
        if (sum == G) break;
        __builtin_amdgcn_s_sleep(1);
        if ((++sp & 255u) == 0u) { if (xb_ld(&bar[XB_TMO])) break; if (sp > XB_SPIN_CAP) { atomicAdd(&bar[XB_TMO], 1u); break; } }
    }
    nloc = mine > 0u ? mine : 1u; nx = cnt > 0u ? cnt : 1u;
}
__device__ __forceinline__ void xcd_barrier(const XcdBarrier& b, int tid) {
    asm volatile("s_waitcnt vmcnt(0)" ::: "memory");
    __syncthreads();
    if (tid == 0) {
        unsigned* bar = b.bar;
        __builtin_amdgcn_s_waitcnt(0);
        unsigned nloc = b.st[0], nx = b.st[1];
        if (nloc == 0u) { xcd_barrier_complete(bar, b.x, nloc, nx); b.st[0] = nloc; b.st[1] = nx; }
        const unsigned old = xb_add(&bar[XB_XSUB(b.x)], 1u);
        const unsigned gen = old / nloc;
        if (old + 1u == (gen + 1u) * nloc) {
            __builtin_amdgcn_fence(__ATOMIC_RELEASE, "agent");
            asm volatile("s_waitcnt vmcnt(0)" ::: "memory");
            const unsigned og = xb_add(&bar[XB_TOP], 1u);
            const unsigned tg = og / nx;
            if (og + 1u == (tg + 1u) * nx) xb_add(&bar[XB_TOPGEN], 1u);
            else XB_SPIN(xb_ld(&bar[XB_TOPGEN]) == tg, bar);
            __builtin_amdgcn_fence(__ATOMIC_ACQUIRE, "agent");
            xb_add(&bar[XB_XGEN(b.x)], 1u);
            asm volatile("s_waitcnt vmcnt(0)" ::: "memory");
        } else {
            XB_SPIN(xb_ld(&bar[XB_XGEN(b.x)]) == gen, bar);
            __builtin_amdgcn_fence(__ATOMIC_ACQUIRE, "agent");
            asm volatile("s_waitcnt vmcnt(0)" ::: "memory");
        }
    }
    __syncthreads();
}

struct Frame { LAS unsigned char* lds; GAS unsigned char* ws; gf32* out; int tid, lane, wave, vcu, G, bid; };
enum { I_X = 0, I_C, I_CTX, I_CCTX, I_ADAW, I_ADAB, I_NORMG, I_W1, I_W3, I_W2, I_POOLW, I_POOLLS, I_GWQ, I_GWK, I_GWV, I_GWO, I_GQN, I_GKN, I_NWQ, I_NWK, I_NWV, I_NWO, I_RPB, I_FINALG, I_COUNT };
constexpr int PTR_OFF = LDSCTL_OFF + 1024;
__device__ __forceinline__ const gf32* inp(const Frame& F, int k) {
    const unsigned long long v = ((volatile LAS unsigned long long*)(F.lds + PTR_OFF))[k];
    const unsigned lo = __builtin_amdgcn_readfirstlane((unsigned)v), hi = __builtin_amdgcn_readfirstlane((unsigned)(v >> 32));
    return (const gf32*)(((unsigned long long)hi << 32) | lo);
}
#define WSF(off) ((gf32*)(F.ws + (off)))
#define WSB(off) ((gb16*)(F.ws + (off)))
#define WSH(off) ((gh16*)(F.ws + (off)))

struct TrItem { const gf32* src; gb16* dst; int N, K, k0, n0, drow0; const gf32* sh; gf32* bias; int nb; };
__device__ __forceinline__ void tr_load(const TrItem& d, int ks, f32x4 (&a)[8], f32x4 (&b)[8], int lane) {
    const int q = lane >> 4, c = lane & 15;
#pragma unroll
    for (int it = 0; it < 8; ++it) { const int k = ks * 64 + 8 * it + 2 * q;
        a[it] = __builtin_nontemporal_load((const gf32x4*)(d.src + (size_t)(d.k0 + k) * d.N + d.n0 + 4 * c)); b[it] = __builtin_nontemporal_load((const gf32x4*)(d.src + (size_t)(d.k0 + k + 1) * d.N + d.n0 + 4 * c)); }
}
__device__ __forceinline__ void tr_half(const TrItem& d, int ks, const f32x4 (&a)[8], const f32x4 (&b)[8], LAS unsigned char* T, LAS float* SH, int lane) {
    const int q = lane >> 4, c = lane & 15;
    if (d.sh) {
        const gf32* shp = d.sh + ks * 64;
        SH[lane] = shp[lane]; SH[64 + lane] = shp[6 * DM + lane]; SH[128 + lane] = shp[12 * DM + lane];
        LDS_WAIT(); asm volatile("" ::: "memory");
        f32x4 p0 = {0.f, 0.f, 0.f, 0.f}, p1 = p0, p2 = p0;
#pragma unroll
        for (int it = 0; it < 8; ++it) { const f32x2 s0 = *(const LAS f32x2*)(SH + 8 * it + 2 * q), s1 = *(const LAS f32x2*)(SH + 64 + 8 * it + 2 * q), s2 = *(const LAS f32x2*)(SH + 128 + 8 * it + 2 * q);
            p0 += a[it] * s0.x + b[it] * s0.y; p1 += a[it] * s1.x + b[it] * s1.y; p2 += a[it] * s2.x + b[it] * s2.y; }
#pragma unroll
        for (int i = 0; i < 4; ++i) { p0[i] += __shfl_xor(p0[i], 16); p0[i] += __shfl_xor(p0[i], 32); p1[i] += __shfl_xor(p1[i], 16); p1[i] += __shfl_xor(p1[i], 32); p2[i] += __shfl_xor(p2[i], 16); p2[i] += __shfl_xor(p2[i], 32); }
        const float v0 = q == 0 ? p0[0] : q == 1 ? p0[1] : q == 2 ? p0[2] : p0[3], v1 = q == 0 ? p1[0] : q == 1 ? p1[1] : q == 2 ? p1[2] : p1[3], v2 = q == 0 ? p2[0] : q == 1 ? p2[1] : q == 2 ? p2[2] : p2[3];
        gf32* bp = d.bias + d.drow0 + 4 * c + q;
        pg8::atomic_add_f32(bp, v0); pg8::atomic_add_f32(bp + d.nb, v1); pg8::atomic_add_f32(bp + 2 * d.nb, v2);
        asm volatile("" ::: "memory");
    }
#pragma unroll
    for (int it = 0; it < 8; ++it) {
#pragma unroll
        for (int i = 0; i < 4; ++i) { const int n = 4 * c + i; const int byte = n * 256 + (((ks * 8 + it) ^ c) << 4) + q * 4;
            *(LAS unsigned*)(T + byte) = cvt_pk_bf16(a[it][i], b[it][i]); } }
}
__device__ __forceinline__ void tr_flush(const TrItem& d, LAS unsigned char* T, int lane) {
    LDS_WAIT(); asm volatile("" ::: "memory");
#pragma unroll
    for (int it2 = 0; it2 < 16; ++it2) { const int n = 4 * it2 + (lane >> 4), j = lane & 15;
        const u32x4 v = *(const LAS u32x4*)(T + n * 256 + ((j ^ ((n >> 2) & 15)) << 4));
        *(gu32x4*)(d.dst + (size_t)(d.drow0 + n) * d.K + d.k0 + 8 * j) = v; }
    LDS_WAIT(); asm volatile("" ::: "memory");
}
constexpr int TR_I_FF = (DM / 128) * (FF / 64);
constexpr int TR_N_FFN = 12 * TR_I_FF, TR_N_POOL = 8 * 32, TR_N_G = 512 + 128 + 128 + 512, TR_N_N = 4 * 512, TR_NITEMS = TR_N_FFN + TR_N_POOL + TR_N_G + TR_N_N;
__device__ __forceinline__ TrItem tr_decode(Frame& F, int it) {
    TrItem d; int r = it; d.sh = nullptr; d.bias = nullptr; d.nb = 0;
    if (r < TR_N_FFN) { const int m = r / TR_I_FF, rr = r % TR_I_FF, l = m / 3, wch = m % 3;
        if (wch < 2) { const int kb = rr / 88, nb = rr % 88, n0 = nb * 64;
            d.src = inp(F, wch == 0 ? I_W1 : I_W3) + (size_t)l * DM * FF; d.N = FF; d.dst = WSB(WS_W13) + (size_t)l * 2 * FF * DM; d.K = DM; d.k0 = kb * 128; d.n0 = n0; d.drow0 = (n0 / 128) * 256 + (n0 % 128) + wch * 128;
            d.sh = WSF(WS_ADA) + (size_t)(l * 3 * 6 + 3) * DM + d.k0; d.bias = WSF(WS_BUP) + (size_t)l * 3 * 2 * FF; d.nb = 2 * FF; }
        else { const int kb = rr / 32, nb = rr % 32;
            d.src = inp(F, I_W2) + (size_t)l * FF * DM; d.N = DM; d.dst = WSB(WS_W2) + (size_t)l * DM * FF; d.K = FF; d.k0 = kb * 128; d.n0 = nb * 64; d.drow0 = nb * 64; }
        return d; }
    r -= TR_N_FFN;
    if (r < TR_N_POOL) { const int jg = r / 32, rr = r % 32, j = jg / 4, gg = jg % 4, kb = rr / 8, nb = rr % 8;
        d.src = inp(F, I_POOLW) + (size_t)jg * 512 * 512; d.N = 512; d.dst = WSB(WS_PW) + (size_t)j * DM * 512; d.K = 512; d.k0 = kb * 128; d.n0 = nb * 64; d.drow0 = gg * 512 + nb * 64; return d; }
    r -= TR_N_POOL;
    if (r < TR_N_G) {
        if (r < 512) { d.src = inp(F, I_GWQ); d.N = DM; d.dst = WSB(WS_GQKV); d.K = DM; d.k0 = (r / 32) * 128; d.n0 = (r % 32) * 64; d.drow0 = d.n0; d.sh = WSF(WS_ADA) + (size_t)(1 * 3 * 6) * DM + d.k0; d.bias = WSF(WS_BQKV); d.nb = 6144; return d; } r -= 512;
        if (r < 128) { d.src = inp(F, I_GWK); d.N = 512; d.dst = WSB(WS_GQKV); d.K = DM; d.k0 = (r / 8) * 128; d.n0 = (r % 8) * 64; d.drow0 = 2048 + d.n0; d.sh = WSF(WS_ADA) + (size_t)(1 * 3 * 6) * DM + d.k0; d.bias = WSF(WS_BQKV); d.nb = 6144; return d; } r -= 128;
        if (r < 128) { d.src = inp(F, I_GWV); d.N = 512; d.dst = WSB(WS_GQKV); d.K = DM; d.k0 = (r / 8) * 128; d.n0 = (r % 8) * 64; d.drow0 = 2560 + d.n0; d.sh = WSF(WS_ADA) + (size_t)(1 * 3 * 6) * DM + d.k0; d.bias = WSF(WS_BQKV); d.nb = 6144; return d; } r -= 128;
        d.src = inp(F, I_GWO); d.N = DM; d.dst = WSB(WS_GWO); d.K = DM; d.k0 = (r / 32) * 128; d.n0 = (r % 32) * 64; d.drow0 = d.n0; return d; }
    r -= TR_N_G;
    { const int which = r / 512, rr = r % 512; d.N = DM; d.K = DM; d.k0 = (rr / 32) * 128; d.n0 = (rr % 32) * 64;
      if (which == 0) { d.src = inp(F, I_NWQ); d.dst = WSB(WS_NQKV); d.drow0 = d.n0; }
      else if (which == 1) { d.src = inp(F, I_NWK); d.dst = WSB(WS_NQKV); d.drow0 = 2048 + d.n0; }
      else if (which == 2) { d.src = inp(F, I_NWV); d.dst = WSB(WS_NQKV); d.drow0 = 4096 + d.n0; }
      else { d.src = inp(F, I_NWO); d.dst = WSB(WS_NWO); d.drow0 = d.n0; }
      if (which < 3) { d.sh = WSF(WS_ADA) + (size_t)(2 * 3 * 6) * DM + d.k0; d.bias = WSF(WS_BQKV) + (size_t)3 * 6144; d.nb = 6144; } }
    return d;
}

__device__ __forceinline__ void p0a_prologue(Frame& F) {
    {
        const gf32* cvec = inp(F, I_C); const gf32* cctx = inp(F, I_CCTX); const gf32* ada_w = inp(F, I_ADAW); const gf32* ada_b = inp(F, I_ADAB); gf32* ada = WSF(WS_ADA);
        LAS float* S = (LAS float*)(F.lds);
        LAS float* red0 = (LAS float*)(F.lds + 24576);
        int rpar = 0;
        for (int i = F.tid; i < 3 * DM; i += 512) { const int v = i / DM, k = i % DM; const float cv = v < 2 ? cvec[v * DM + k] : cctx[k]; S[i] = cv / (1.0f + __expf(-cv)); }
        __syncthreads();
        const int kq = F.lane >> 4, cq = F.lane & 15;
        for (int u = F.bid; u < DEPTH * 192; u += F.G) {
            const int l = u / 192, n0 = (u % 192) * 64;
            const gf32* Wp = ada_w + (size_t)l * DM * 6 * DM + n0 + 4 * cq;
            f32x4 a0 = {0.f, 0.f, 0.f, 0.f}, a1 = a0, a2 = a0;
            f32x4 wA[8], wB[8];
            const int kb0 = F.wave * 256 + kq;
#define ADA_LD(dst, g) do { _Pragma("unroll") for (int i = 0; i < 8; ++i) dst[i] = __builtin_nontemporal_load((const gf32x4*)(Wp + (size_t)(kb0 + 4 * (8 * (g) + i)) * (6 * DM))); } while (0)
#define ADA_FMA(src, g) do { _Pragma("unroll") for (int i = 0; i < 8; ++i) { const int k = kb0 + 4 * (8 * (g) + i); a0 += src[i] * S[k]; a1 += src[i] * S[DM + k]; a2 += src[i] * S[2 * DM + k]; } } while (0)
            ADA_LD(wA, 0);
#pragma unroll 1
            for (int g = 0; g < 8; g += 2) { ADA_LD(wB, g + 1); ADA_FMA(wA, g); if (g + 2 < 8) ADA_LD(wA, g + 2); ADA_FMA(wB, g + 1); }
#undef ADA_LD
#undef ADA_FMA
#pragma unroll
            for (int i = 0; i < 4; ++i) { a0[i] += __shfl_xor(a0[i], 16); a0[i] += __shfl_xor(a0[i], 32); a1[i] += __shfl_xor(a1[i], 16); a1[i] += __shfl_xor(a1[i], 32); a2[i] += __shfl_xor(a2[i], 16); a2[i] += __shfl_xor(a2[i], 32); }
            LAS float* red = red0 + rpar * 1536; rpar ^= 1;
            if (kq == 0) {
#pragma unroll
                for (int i = 0; i < 4; ++i) { red[(F.wave * 3 + 0) * 64 + 4 * cq + i] = a0[i]; red[(F.wave * 3 + 1) * 64 + 4 * cq + i] = a1[i]; red[(F.wave * 3 + 2) * 64 + 4 * cq + i] = a2[i]; } }
            __syncthreads();
            if (F.tid < 192) { const int v = F.tid / 64, cc = F.tid % 64; float s = ada_b[l * 6 * DM + n0 + cc];
#pragma unroll
                for (int w = 0; w < 8; ++w) s += red[(w * 3 + v) * 64 + cc];
                ada[(size_t)(l * 3 + v) * 6 * DM + n0 + cc] = s; }
        }
    }
    {
        const size_t gt = (size_t)F.bid * 512 + F.tid, NT = (size_t)F.G * 512;
        gf32* rope = WSF(WS_ROPE);
        for (size_t i = gt; i < 64 * 32; i += NT) { const int p = (int)i / 32, j = (int)i % 32; const float inv = powf(10000.0f, -(float)(2 * j) / 64.0f); const float ang = (float)p * inv;
            rope[2 * i] = cosf(ang); rope[2 * i + 1] = sinf(ang); }
    }
}
__device__ __forceinline__ void p0b_prologue(Frame& F) {
    const int gw = F.vcu * 8 + F.wave, NGW = F.G * 8;
    {
        LAS unsigned char* T = F.lds + F.wave * 16384; LAS float* SH = (LAS float*)(F.lds + 139264 + F.wave * 1024);
        for (int it = gw; it < TR_NITEMS; it += NGW) {
            const TrItem d = tr_decode(F, it);
            f32x4 a0[8], b0[8], a1[8], b1[8];
            tr_load(d, 0, a0, b0, F.lane); tr_load(d, 1, a1, b1, F.lane);
            tr_half(d, 0, a0, b0, T, SH, F.lane); tr_half(d, 1, a1, b1, T, SH, F.lane);
            tr_flush(d, T, F.lane);
        }
    }
    {
        const gf32* g = inp(F, I_NORMG); const gf32* xin = inp(F, I_X); const gf32* cin = inp(F, I_CTX); const gf32* adab = WSF(WS_ADA); gb16* H = WSB(WS_H); gf32* stats = WSF(WS_STATS);
        const int gwb = F.bid * 8 + F.wave;
        for (int row = gwb; row < MROWS; row += NGW) {
            const int b = row / RB, rr = row % RB, vec = rr < CTXL ? 2 : b;
            const gf32* sc = adab + (size_t)(vec * 6 + 1) * DM;
            const gf32* xrow = rr < CTXL ? cin + ((size_t)b * CTXL + rr) * DM : xin + ((size_t)b * SEQ + (rr - CTXL)) * DM;
            const gf32x4* xr = (const gf32x4*)xrow + F.lane;
            f32x4 v[8]; float ss = 0.f;
#pragma unroll
            for (int j = 0; j < 8; ++j) { v[j] = xr[64 * j]; ss += (v[j].x * v[j].x + v[j].y * v[j].y) + (v[j].z * v[j].z + v[j].w * v[j].w); }
            ss = wave_sum(ss); if (F.lane == 0) stats[row] = ss;
            gu32x2* x8 = (gu32x2*)(WSH(WS_XS) + (size_t)row * DM) + F.lane;
#pragma unroll
            for (int j = 0; j < 8; ++j) {
                u32x2 xw; xw.x = pk_h16(v[j].x, v[j].y); xw.y = pk_h16(v[j].z, v[j].w); x8[64 * j] = xw; }
        }
    }
}

constexpr int POOL_R = 18, POOL_RL = (SEQ + POOL_R - 1) / POOL_R, POOL_RC = (CTXL + POOL_R - 1) / POOL_R;
template <int HW>
__device__ __forceinline__ void pool_task(const gh16* __restrict__ H, gb16* __restrict__ PO, const gf32* __restrict__ stats, const gf32* __restrict__ gng, const gf32* __restrict__ gsc, int seq0, int n, int t0, int len, int c, int lane) {
    constexpr int NR = POOL_R + 2 * HW;
    const unsigned colb = (unsigned)(c * 64 + lane) * 16u;
    u32x4 v[NR];
#pragma unroll
    for (int i = 0; i < NR; ++i) { const int tt = min(max(t0 - HW + i, 0), n - 1);
        const GAS char* rb = (const GAS char*)(H + (size_t)(seq0 + tt) * DM);
        asm volatile("s_nop 4\n\tglobal_load_dwordx4 %0, %1, %2" : "=v"(v[i]) : "v"(colb), "s"(rb) : "memory"); }
    asm volatile("s_waitcnt vmcnt(0)" ::: "memory");
#pragma unroll
    for (int i = 0; i < NR; ++i) asm volatile("" : "+v"(v[i]));
    float rl = 0.f;
    { const int tt = t0 - HW + lane; if (lane < NR && tt >= 0 && tt < n) rl = pg8::rstd_of(stats[seq0 + tt]); }
    float gmv[8];
    { const f32x4 g0 = *(const gf32x4*)(gng + c * 512 + lane * 8), g1 = *(const gf32x4*)(gng + c * 512 + lane * 8 + 4), s0 = *(const gf32x4*)(gsc + c * 512 + lane * 8), s1 = *(const gf32x4*)(gsc + c * 512 + lane * 8 + 4);
      gmv[0] = g0.x * (s0.x + 1.0f); gmv[1] = g0.y * (s0.y + 1.0f); gmv[2] = g0.z * (s0.z + 1.0f); gmv[3] = g0.w * (s0.w + 1.0f); gmv[4] = g1.x * (s1.x + 1.0f); gmv[5] = g1.y * (s1.y + 1.0f); gmv[6] = g1.z * (s1.z + 1.0f); gmv[7] = g1.w * (s1.w + 1.0f); }
    float a[8];
#pragma unroll
    for (int e = 0; e < 8; ++e) a[e] = 0.f;
#define POOL_ACC(i, sgn) do { const float _r = (sgn) * __uint_as_float(__builtin_amdgcn_readlane(__float_as_uint(rl), (i))); u32x4 _t = v[i]; asm volatile("" : "+v"(_t)); a[0] += _r * h16_lo(_t.x); a[1] += _r * h16_hi(_t.x); a[2] += _r * h16_lo(_t.y); a[3] += _r * h16_hi(_t.y); \
        a[4] += _r * h16_lo(_t.z); a[5] += _r * h16_hi(_t.z); a[6] += _r * h16_lo(_t.w); a[7] += _r * h16_hi(_t.w); } while (0)
#pragma unroll
    for (int i = 0; i < 2 * HW; ++i) POOL_ACC(i, 1.0f);
#pragma unroll
    for (int k = 0; k < POOL_R; ++k) {
        if (k < len) { const int t = t0 + k; const int lo = max(t - HW, 0), hi = min(t + HW, n); const float rc = __builtin_amdgcn_rcpf((float)(hi - lo)), ro = __uint_as_float(__builtin_amdgcn_readlane(__float_as_uint(rl), k + HW));
            u32x4 own = v[k + HW]; asm volatile("" : "+v"(own));
            u32x4 w; w.x = cvt_pk_bf16((a[0] * rc - ro * h16_lo(own.x)) * gmv[0], (a[1] * rc - ro * h16_hi(own.x)) * gmv[1]); w.y = cvt_pk_bf16((a[2] * rc - ro * h16_lo(own.y)) * gmv[2], (a[3] * rc - ro * h16_hi(own.y)) * gmv[3]);
            w.z = cvt_pk_bf16((a[4] * rc - ro * h16_lo(own.z)) * gmv[4], (a[5] * rc - ro * h16_hi(own.z)) * gmv[5]); w.w = cvt_pk_bf16((a[6] * rc - ro * h16_lo(own.w)) * gmv[6], (a[7] * rc - ro * h16_hi(own.w)) * gmv[7]);
            GAS char* ob = (GAS char*)(PO + (size_t)(seq0 + t) * DM); asm volatile("s_nop 4\n\tglobal_store_dwordx4 %0, %1, %2\n\ts_nop 1" :: "v"(colb), "v"(w), "s"(ob) : "memory"); }
        if (k + 1 < POOL_R) { POOL_ACC(k + 2 * HW, 1.0f); POOL_ACC(k, -1.0f); }
    }
#undef POOL_ACC
}
__device__ __forceinline__ void phase_pool(Frame& F, const gf32* stats, bool lat_only, int layer) {
    const gh16* H = WSH(WS_XS); gb16* PO = WSB(WS_PO);
    const gf32* gng = inp(F, I_NORMG) + (size_t)(layer * 2) * DM; const gf32* ada1 = WSF(WS_ADA) + (size_t)layer * 3 * 6 * DM + DM;
    const int gw = F.bid * 8 + F.wave, NGW = F.G * 8;
    const int ntask = (2 * POOL_RL + (lat_only ? 0 : 2 * POOL_RC)) * 4;
    for (int task = gw; task < ntask; task += NGW) {
        const int c = task & 3; int ridx = task >> 2; int seq0, n, t0;
        int vec;
        if (ridx < 2 * POOL_RL) { const int b = ridx / POOL_RL; seq0 = b * RB + CTXL; n = SEQ; t0 = (ridx % POOL_RL) * POOL_R; vec = b; }
        else { ridx -= 2 * POOL_RL; const int b = ridx / POOL_RC; seq0 = b * RB; n = CTXL; t0 = (ridx % POOL_RC) * POOL_R; vec = 2; }
        const gf32* gsc = ada1 + (size_t)vec * 6 * DM;
        const int len = min(POOL_R, n - t0);
        int ln = F.lane; asm volatile("" : "+v"(ln));
        if (c == 0) pool_task<1>(H, PO, stats, gng, gsc, seq0, n, t0, len, c, ln);
        else if (c == 1) pool_task<2>(H, PO, stats, gng, gsc, seq0, n, t0, len, c, ln);
        else if (c == 2) pool_task<4>(H, PO, stats, gng, gsc, seq0, n, t0, len, c, ln);
        else pool_task<8>(H, PO, stats, gng, gsc, seq0, n, t0, len, c, ln);
    }
}
__device__ __forceinline__ void phase_krope(Frame& F) {
    const int gw = F.bid * 8 + F.wave, NGW = F.G * 8;
    const f32x2 gk = *(const gf32x2*)(inp(F, I_GKN) + 2 * F.lane);
    gb16* Kp = WSB(WS_K); const gf32* rope = WSF(WS_ROPE);
    for (int row = gw; row < MROWS; row += NGW) {
        const int rr = row % RB; const bool lat = rr >= CTXL; const int t = rr - CTXL;
        float cs = 1.f, sn = 0.f;
        if (lat) { const int pos = F.lane < 32 ? (t >> 6) : (t & 63); const f32x2 r2 = *(const gf32x2*)(rope + 2 * (pos * 32 + (F.lane & 31))); cs = r2.x; sn = r2.y; }
        unsigned u[KVH];
#pragma unroll
        for (int hh = 0; hh < KVH; ++hh) u[hh] = *((const gu32*)(Kp + (size_t)row * 512 + hh * HD) + F.lane);
#pragma unroll
        for (int hh = 0; hh < KVH; ++hh) { const float x1 = bf_lo(u[hh]), x2 = bf_hi(u[hh]);
            const float rstd = __builtin_amdgcn_rsqf(wave_sum(x1 * x1 + x2 * x2) * (1.0f / HD) + NORM_EPS);
            const float y1 = x1 * rstd * gk.x, y2 = x2 * rstd * gk.y;
            *((gu32*)(Kp + (size_t)row * 512 + hh * HD) + F.lane) = cvt_pk_bf16(y1 * cs - y2 * sn, y1 * sn + y2 * cs); }
    }
}
__device__ __forceinline__ void phase_final(Frame& F) {
    const gh16* xs = WSH(WS_XS); const gf32* fg = inp(F, I_FINALG);
    const int gw = F.bid * 8 + F.wave, NGW = F.G * 8;
    for (int r = gw; r < NB * SEQ; r += NGW) {
        const int b = r / SEQ, t = r % SEQ; const int row = b * RB + CTXL + t;
        const gu32x4* xr = (const gu32x4*)(xs + (size_t)row * DM) + F.lane;
        f32x4 v[8]; float s = 0.f;
#pragma unroll
        for (int j = 0; j < 4; ++j) { const u32x4 h = xr[64 * j]; v[2 * j] = (f32x4){h16_lo(h.x), h16_hi(h.x), h16_lo(h.y), h16_hi(h.y)}; v[2 * j + 1] = (f32x4){h16_lo(h.z), h16_hi(h.z), h16_lo(h.w), h16_hi(h.w)};
            s += (v[2 * j].x * v[2 * j].x + v[2 * j].y * v[2 * j].y) + (v[2 * j].z * v[2 * j].z + v[2 * j].w * v[2 * j].w) + (v[2 * j + 1].x * v[2 * j + 1].x + v[2 * j + 1].y * v[2 * j + 1].y) + (v[2 * j + 1].z * v[2 * j + 1].z + v[2 * j + 1].w * v[2 * j + 1].w); }
        const float rstd = __builtin_amdgcn_rsqf(wave_sum(s) * (1.0f / DM) + NORM_EPS);
        gf32x4* o = (gf32x4*)(F.out + (size_t)r * DM) + 2 * F.lane;
#pragma unroll
        for (int j = 0; j < 4; ++j) { const int d = (F.lane + 64 * j) * 8;
            o[128 * j] = (v[2 * j] * rstd) * *(const gf32x4*)(fg + d); o[128 * j + 1] = (v[2 * j + 1] * rstd) * *(const gf32x4*)(fg + d + 4); }
    }
}
__device__ __forceinline__ void phase_attn_gqa(Frame& F, char* lds) {
    const gb16* Q = WSB(WS_Q); const gb16* Kp = WSB(WS_K); const gb16* Vp = WSB(WS_V); gb16* PO = WSB(WS_PO); const gf32* gqn = inp(F, I_GQN); const gf32* rope = WSF(WS_ROPE);
    for (int u = F.vcu; u < 512 + 32; u += F.G) {
        __syncthreads();
        if (u < 512) { const int b = u >> 8, rem = u & 255, kvh = rem >> 6, gq = (rem >> 4) & 3, qb = rem & 15, h = kvh * 4 + gq;
            const size_t qrow = (size_t)b * RB + CTXL + (size_t)qb * 256;
            att::attn_unit<false, 2>(Q + qrow * DM + h * HD, Kp + (size_t)b * RB * 512 + kvh * HD, Vp + (size_t)b * RB * 512 + kvh * HD, PO + qrow * DM + h * HD, DM, 512, DM, RB / 64, 0, RB / 64, lds, 0, 0, gqn, rope, qb * 256, F.wave); }
        else { const int v = u - 512, b = v >> 4, h = v & 15, kvh = h >> 2; const size_t qrow = (size_t)b * RB;
            att::attn_unit<false, 1>(Q + qrow * DM + h * HD, Kp + (size_t)b * RB * 512 + kvh * HD, Vp + (size_t)b * RB * 512 + kvh * HD, PO + qrow * DM + h * HD, DM, 512, DM, CTXL / 64, 0, CTXL / 64, lds, 0, 0, gqn, rope, 0, F.wave); }
    }
}
__device__ __forceinline__ void phase_attn_nat(Frame& F, char* lds) {
    const gb16* Q = WSB(WS_Q); const gb16* Kp = WSB(WS_K); const gb16* Vp = WSB(WS_V); gb16* PO = WSB(WS_PO); const gf32* rpb = inp(F, I_RPB);
    for (int u = F.vcu; u < 512; u += F.G) {
        __syncthreads();
        { const int b = u >> 8, h = (u >> 4) & 15, qb = u & 15, r0 = 4 * qb;
            const int kr_lo = min(max(r0 - 4, 0), 56), kr_hi = min(max(r0 + 3 - 4, 0), 56) + 8; int n2 = kr_hi - kr_lo; n2 += (n2 & 1);
            { int bt = F.tid; asm volatile("" : "+v"(bt));
              if (bt < att::NBIAS) ((float*)(lds + att::SHM_BIAS))[att::BIAS_PAD + bt] = rpb[h * att::NBIAS + bt] * 1.4426950408889634f; }
            const size_t qrow = (size_t)b * RB + CTXL + (size_t)qb * 256;
            att::attn_unit<true, 0>(Q + qrow * DM + h * HD, Kp + (size_t)b * RB * DM + h * HD, Vp + (size_t)b * RB * DM + h * HD, PO + qrow * DM + h * HD, DM, DM, DM, CTXL / 64, CTXL + kr_lo * 64, CTXL / 64 + n2, lds, r0, kr_lo, nullptr, nullptr, 0, F.wave); }
    }
    int v, vstep;
    if (F.G == 256) { const int e = F.vcu & 15; v = (e == 0 || e == 15) ? (F.vcu >> 4) * 2 + (e == 15 ? 1 : 0) : 32; vstep = 32; } else { v = F.vcu; vstep = F.G; }
    for (; v < 32; v += vstep) {
        __syncthreads();
        const int b = v >> 4, h = v & 15; const size_t qrow = (size_t)b * RB;
        att::attn_unit<false, 0>(Q + qrow * DM + h * HD, Kp + (size_t)b * RB * DM + h * HD, Vp + (size_t)b * RB * DM + h * HD, PO + qrow * DM + h * HD, DM, DM, DM, CTXL / 64, 0, CTXL / 64, lds, 0, 0, nullptr, nullptr, 0, F.wave);
    }
}

struct Args { const float* in[24]; float* out; unsigned char* ws; int gp_lo, gp_hi; };
static_assert(sizeof(Args) == 24 * 8 + 8 + 8 + 8, "Args has no padding");
constexpr int GP_END = 35;

__global__ void __launch_bounds__(512, 2) fwd_kernel(Args args) {
    extern __shared__ __attribute__((aligned(16))) unsigned char lds[];
    Frame F;
    F.lds = (LAS unsigned char*)lds;
    F.tid = threadIdx.x; F.lane = F.tid & 63; F.wave = __builtin_amdgcn_readfirstlane(F.tid >> 6);
    F.G = gridDim.x; { const int bx = blockIdx.x; F.vcu = (F.G % 8 == 0) ? (bx % 8) * (F.G / 8) + bx / 8 : bx; }
    F.out = (gf32*)args.out; F.ws = (GAS unsigned char*)args.ws;
    unsigned char* ws = args.ws;
    for (int u = F.tid; u < (LDS_BYTES - LDSCTL_OFF) / 4; u += 512) ((LAS unsigned*)(F.lds + LDSCTL_OFF))[u] = 0u;
    __syncthreads();
    if (F.tid < I_COUNT) ((LAS unsigned long long*)(F.lds + PTR_OFF))[F.tid] = ((const unsigned long long*)__builtin_amdgcn_kernarg_segment_ptr())[F.tid];
    __syncthreads();
    const int lo = args.gp_lo, hi = args.gp_hi;
    unsigned* barw = (unsigned*)(ws + WS_CTL) + CW_BAR;
    XcdBarrier bar; bar.bar = barw; bar.x = 0; bar.st = nullptr;
    if (hi - lo > 1) bar = xcd_barrier_post(barw, (volatile LAS unsigned*)(F.lds + MISC_OFF) + 8);
    bool first = true;
#define PH_BEGIN(gp) if (lo <= (gp) && (gp) < hi) { if (!first) xcd_barrier(bar, tid_here(F.wave)); first = false; F.bid = blockIdx.x; asm volatile("" : "+s"(F.ws), "+s"(F.G), "+s"(F.vcu), "+s"(F.bid), "+s"(F.wave)); F.tid = tid_here(F.wave); F.lane = F.tid & 63;
#define PH_END }
    constexpr bool AL = true, SP = true;

    PH_BEGIN(0) if (EN & 1) p0a_prologue(F); PH_END
    PH_BEGIN(1) if (EN & 1) p0b_prologue(F); PH_END

    for (int layer = 0; layer < DEPTH; ++layer) {
        const int kind = layer % 3, j = layer / 3, gp0 = 2 + 8 * layer;
        const bool need_ctx = layer < DEPTH - 1;
        const gf32* ada_l = WSF(WS_ADA) + (size_t)layer * 3 * 6 * DM;
        gf32* st1 = WSF(WS_STATS) + (size_t)(2 * layer) * MROWS;
        gf32* st2 = st1 + MROWS;
        if (kind == 0) {
            PH_BEGIN(gp0 + 1) if (EN & 4) phase_pool(F, st1, !need_ctx, layer); PH_END
            PH_BEGIN(gp0 + 2) if (EN & 8) {
                pg8::Gemm g{WSB(WS_PO), WSB(WS_PW) + (size_t)j * DM * 512, MROWS, DM, 512, DM, 2};
                pg8::EpiRes E{WSH(WS_XS), WSH(WS_XS), ada_l, 2, inp(F, I_POOLLS) + (size_t)j * DM, WSB(WS_H), inp(F, I_NORMG) + (size_t)(layer * 2 + 1) * DM, ada_l, 4, st2};
                pg8::LatOrder S; S.init(DM, F.G, F.bid);
                if (need_ctx) pg8::gemm_phase_strip<pg8::EpiRes, pg8::LatOrder>(F.lds, F.lds + STRIP_OFF, F.lds + PF_OFF, g, S, E, F.wave);
                else pg8::gemm_phase<pg8::EpiRes, pg8::LatOrder, AL, SP>(F.lds, F.lds + PF_OFF, g, S, E, F.wave); } PH_END
        } else if (kind == 1) {
            PH_BEGIN(gp0 + 1) if (EN & 16) {
                pg8::Gemm g{WSB(WS_H), WSB(WS_GQKV), MROWS, 3072, DM, DM, 1 << 20}; typedef pg8::LatOrderSplit<WS_U, WS_CTL + CTL_SPLIT_FLAGS2> SplitQKV; SplitQKV S; S.init(3072, F.G, F.bid); S.wsb = F.ws;
                pg8::EpiQKV<true> E{WSB(WS_Q), WSB(WS_K), WSB(WS_V), 2048, 512, DM, 512, st1, WSF(WS_BQKV), 6144, 1.0f, inp(F, I_GKN), WSF(WS_ROPE), (LAS float*)(F.lds + XK_OFF)};
                pg8::gemm_phase_strip<pg8::EpiQKV<true>, SplitQKV>(F.lds, F.lds + STRIP_OFF, F.lds + PF_OFF, g, S, E, F.wave); } PH_END
            PH_BEGIN(gp0 + 3) if (EN & 64) phase_attn_gqa(F, (char*)lds); PH_END
        } else {
            PH_BEGIN(gp0 + 1) if (EN & 256) {
                pg8::Gemm g{WSB(WS_H), WSB(WS_NQKV), MROWS, 6144, DM, DM, 1 << 20}; pg8::LatOrder S; S.init(6144, F.G, F.bid);
                pg8::EpiQKV<true> E{WSB(WS_Q), WSB(WS_K), WSB(WS_V), 2048, 2048, DM, DM, st1, WSF(WS_BQKV) + 3 * 6144, 6144, att::QSCALE, nullptr, nullptr, nullptr};
                pg8::gemm_phase_strip<pg8::EpiQKV<true>, pg8::LatOrder>(F.lds, F.lds + STRIP_OFF, F.lds + PF_OFF, g, S, E, F.wave); } PH_END
            PH_BEGIN(gp0 + 3) if (EN & 512) phase_attn_nat(F, (char*)lds); PH_END
        }
        if (kind != 0) {
            PH_BEGIN(gp0 + 4) if (EN & 128) {
                pg8::Gemm g{WSB(WS_PO), kind == 1 ? WSB(WS_GWO) : WSB(WS_NWO), MROWS, DM, DM, DM, 1 << 20}; pg8::LatOrder S; S.init(DM, F.G, F.bid);
                pg8::EpiRes E{WSH(WS_XS), WSH(WS_XS), ada_l, 2, nullptr, WSB(WS_H), inp(F, I_NORMG) + (size_t)(layer * 2 + 1) * DM, ada_l, 4, st2};
                pg8::gemm_phase_strip<pg8::EpiRes, pg8::LatOrder>(F.lds, F.lds + STRIP_OFF, F.lds + PF_OFF, g, S, E, F.wave); } PH_END
        }
        PH_BEGIN(gp0 + 6) if (EN & 2048) {
            pg8::Gemm g{WSB(WS_H), WSB(WS_W13) + (size_t)layer * 2 * FF * DM, MROWS, 2 * FF, DM, DM, 1 << 20};
            pg8::EpiSwiGLU E{WSB(WS_U), st2, WSF(WS_BUP) + (size_t)layer * 3 * 2 * FF};
            if (need_ctx) { pg8::StaticOrder S; S.init(MROWS, 2 * FF, F.G, F.bid); pg8::gemm_phase<pg8::EpiSwiGLU, pg8::StaticOrder, AL, SP>(F.lds, F.lds + PF_OFF, g, S, E, F.wave); }
            else { typedef pg8::LatOrderSplit<WS_PO, WS_CTL + CTL_SPLIT_FLAGS> SplitUp; SplitUp S; S.init(2 * FF, F.G, F.bid); S.wsb = F.ws;
                pg8::gemm_phase<pg8::EpiSwiGLU, SplitUp, AL, SP>(F.lds, F.lds + PF_OFF, g, S, E, F.wave); } } PH_END
        if (need_ctx) {
            PH_BEGIN(gp0 + 7) if (EN & 4096) {
                pg8::Gemm g{WSB(WS_U), WSB(WS_W2) + (size_t)layer * DM * FF, MROWS, DM, FF, FF, 1 << 20}; pg8::LatOrder S; S.init(DM, F.G, F.bid);
                pg8::EpiRes E{WSH(WS_XS), WSH(WS_XS), ada_l, 5, nullptr, (layer + 1) % 3 == 0 ? (gb16*)nullptr : WSB(WS_H)  , inp(F, I_NORMG) + (size_t)((layer + 1) * 2) * DM, ada_l + (size_t)3 * 6 * DM, 1, st2 + MROWS};
                pg8::gemm_phase_strip<pg8::EpiRes, pg8::LatOrder>(F.lds, F.lds + STRIP_OFF, F.lds + PF_OFF, g, S, E, F.wave); } PH_END
        } else {
            PH_BEGIN(gp0 + 7) if (EN & 4096) {
                pg8::Gemm g{WSB(WS_U), WSB(WS_W2) + (size_t)layer * DM * FF, MROWS, DM, FF, FF, 1 << 20}; pg8::LatOrder S; S.init(DM, F.G, F.bid);
                if (F.G == 256) {
                    pg8::EpiFinal E{WSH(WS_XS), ada_l, 5, WSF(WS_STATS) + (size_t)8 * MROWS, inp(F, I_FINALG), F.out, (unsigned*)(ws + WS_CTL + CTL_FINAL_CNT)};
                    pg8::gemm_phase<pg8::EpiFinal, pg8::LatOrder, AL, SP>(F.lds, F.lds + PF_OFF, g, S, E, F.wave);
                } else {
                pg8::EpiRes E{WSH(WS_XS), WSH(WS_XS), ada_l, 5, nullptr, nullptr, nullptr, nullptr, 1, nullptr};
                pg8::gemm_phase<pg8::EpiRes, pg8::LatOrder, AL, SP>(F.lds, F.lds + PF_OFF, g, S, E, F.wave); } } PH_END
        }
    }
    if (F.G != 256) { PH_BEGIN(34) if (EN & 8192) phase_final(F); PH_END }
#undef PH_BEGIN
#undef PH_END
}

static bool phase_active(int gp) {
    if (gp <= 1 || gp == 34) return true;
    const int layer = (gp - 2) / 8, s = (gp - 2) % 8, kind = layer % 3;
    if (s == 0 || s == 5) return false;
    if (kind == 0) return s == 1 || s == 2 || s >= 6;
    return s != 2;
}
extern "C" void kernel_launch(void* const* d_in, const int* in_sizes, int n_in, void* d_out, int out_size, void* d_ws, size_t ws_size, hipStream_t stream) {
    static int grid = 0;
    if (grid == 0) {
        if (n_in != 24 || in_sizes[0] != NB * SEQ * DM || out_size != NB * SEQ * DM || ws_size < WS_END) {
            fprintf(stderr, "kernel_launch: shape mismatch: n_in %d in0 %d out %d ws %zu (need %zu)\n", n_in, n_in > 0 ? in_sizes[0] : -1, out_size, ws_size, (size_t)WS_END); grid = -1; return; }
        int dev = 0, cus = 0, per_cu = 0;
        if (hipGetDevice(&dev) != hipSuccess || hipDeviceGetAttribute(&cus, hipDeviceAttributeMultiprocessorCount, dev) != hipSuccess) { fprintf(stderr, "kernel_launch: device query failed\n"); grid = -1; return; }
        if (hipFuncSetAttribute((const void*)fwd_kernel, hipFuncAttributeMaxDynamicSharedMemorySize, LDS_BYTES) != hipSuccess) { fprintf(stderr, "kernel_launch: hipFuncSetAttribute failed\n"); grid = -1; return; }
        if (hipOccupancyMaxActiveBlocksPerMultiprocessor(&per_cu, (const void*)fwd_kernel, 512, LDS_BYTES) != hipSuccess || per_cu < 1)
            fprintf(stderr, "kernel_launch: note: occupancy query reports %d workgroups per CU\n", per_cu);
        (void)hipGetLastError();
        grid = cus;
    }
    if (grid < 0) return;
    if (hipMemsetAsync((char*)d_ws + WS_CTL, 0, CTL_ZERO_BYTES, stream) != hipSuccess) { fprintf(stderr, "kernel_launch: memset failed\n"); return; }
    Args a{};
    for (int i = 0; i < 24; ++i) a.in[i] = (const float*)d_in[i];
    a.out = (float*)d_out; a.ws = (unsigned char*)d_ws;
#if MK_ONE_LAUNCH
    a.gp_lo = 0; a.gp_hi = GP_END;
    hipLaunchKernelGGL(fwd_kernel, dim3(grid), dim3(512), LDS_BYTES, stream, a);
#else
    for (int gp = 0; gp < GP_END; ++gp) { if (!phase_active(gp)) continue;
        a.gp_lo = gp; a.gp_hi = gp + 1;
        hipLaunchKernelGGL(fwd_kernel, dim3(grid), dim3(512), LDS_BYTES, stream, a); }
#endif
    const hipError_t le = hipPeekAtLastError();
    if (le != hipSuccess) fprintf(stderr, "kernel_launch: launch failed: %s\n", hipGetErrorName(le));
}
```

```cpp
#include <hip/hip_runtime.h>
#include <cstdio>
#include <cstdint>

#ifndef EN
#define EN 0xffff
#endif
#ifndef MK_ONE_LAUNCH
#define MK_ONE_LAUNCH 1
#endif

constexpr int DM = 2048, NB = 2, SEQ = 4096, CTXL = 256, RB = SEQ + CTXL, MROWS = NB * RB, FF = 5632, HD = 128, NH = 16, KVH = 4, DEPTH = 4;
constexpr int PTILES = RB / 256;
constexpr float NORM_EPS = 1e-6f;
static_assert(RB % 256 == 0 && MROWS == 8704, "row layout");

#define GAS __attribute__((address_space(1)))
#define LAS __attribute__((address_space(3)))
typedef unsigned short bf16_t;
typedef float f32x4 __attribute__((ext_vector_type(4)));
typedef float f32x2 __attribute__((ext_vector_type(2)));
typedef unsigned u32x4 __attribute__((ext_vector_type(4)));
typedef unsigned u32x2 __attribute__((ext_vector_type(2)));
typedef short bf16x8 __attribute__((ext_vector_type(8)));
typedef _Float16 h16x2 __attribute__((ext_vector_type(2)));
typedef GAS _Float16 gh16;
__device__ __forceinline__ unsigned pk_h16(float a, float b) { const h16x2 v = {(_Float16)a, (_Float16)b}; return __builtin_bit_cast(unsigned, v); }
__device__ __forceinline__ float h16_lo(unsigned u) { return (float)__builtin_bit_cast(h16x2, u).x; }
__device__ __forceinline__ float h16_hi(unsigned u) { return (float)__builtin_bit_cast(h16x2, u).y; }
typedef GAS float gf32; typedef GAS bf16_t gb16; typedef GAS f32x4 gf32x4; typedef GAS f32x2 gf32x2; typedef GAS u32x4 gu32x4; typedef GAS u32x2 gu32x2; typedef GAS bf16x8 gbf16x8; typedef GAS unsigned gu32;
#define LDS_WAIT() asm volatile("s_waitcnt lgkmcnt(0)" ::: "memory")
#define VM_WAIT() asm volatile("s_waitcnt vmcnt(0)" ::: "memory")
__device__ __forceinline__ unsigned cvt_pk_bf16(float lo, float hi) { unsigned r; asm volatile("v_cvt_pk_bf16_f32 %0, %1, %2" : "=v"(r) : "v"(lo), "v"(hi)); return r; }
__device__ __forceinline__ float bf_lo(unsigned u) { return __uint_as_float(u << 16); }
__device__ __forceinline__ float bf_hi(unsigned u) { return __uint_as_float(u & 0xffff0000u); }
__device__ __forceinline__ int tid_here(int wave) { int l; asm volatile("v_mbcnt_lo_u32_b32 %0, -1, 0\n\tv_mbcnt_hi_u32_b32 %0, -1, %0" : "=v"(l)); return wave * 64 + l; }
__device__ __forceinline__ float wave_sum(float v) {
#pragma unroll
    for (int o = 1; o < 64; o <<= 1) v += __shfl_xor(v, o);
    return v;
}

namespace pg8 {
#define PG8_LAS __attribute__((address_space(3)))
constexpr int BM = 256, BK = 64, HALF = 128, HTB = HALF * BK * 2, STAGE_BYTES = 8 * HTB, NXCD = 8, WGM = 8;
__host__ __device__ __forceinline__ int lds_byte(int r, int c) { const int st = (r >> 4) * 2 + (c >> 5), rr = r & 15, cc = c & 31, ob = rr * 64 + cc * 2; return st * 1024 + (ob ^ (((ob >> 9) & 1) << 5)); }
__host__ __device__ __forceinline__ void stage_rc(int b, int& R, int& C) { const int st = b / 1024, sb = b % 1024, swz = sb ^ (((sb >> 9) & 1) << 5); R = (st >> 1) * 16 + swz / 64; C = (st & 1) * 32 + (swz % 64) / 2; }
__host__ __device__ __forceinline__ int perm32(int rho) { const int n = rho >> 4, i = rho & 15; return 8 * (i >> 2) + 4 * n + (i & 3); }

struct Unit { int pm, pn, srow, kh; };
struct Gemm { const gb16* A; const gb16* Bt; int M, N, K, lda, a_tpg; };

struct StaticOrder {
    static constexpr bool SPLIT = false;
    int nM, nN, nwg, G, c;
    __host__ __device__ void init(int M, int N, int G_, int c_) { nM = M / BM; nN = N / BM; nwg = nM * nN; G = G_; c = c_; }
    __host__ __device__ bool next(int i, Unit& u) const {
        const long L = (long)i * G + c; if (L >= nwg) return false;
        int wgid = (int)L; { const int q = nwg / NXCD, r = nwg % NXCD, xcd = wgid % NXCD, off = wgid / NXCD; wgid = (xcd < r ? xcd * (q + 1) : r * (q + 1) + (xcd - r) * q) + off; }
        const int nig = WGM * nN, gid = wgid / nig, fm = gid * WGM, gsz = (nM - fm) < WGM ? (nM - fm) : WGM;
        u.pm = fm + ((wgid % nig) % gsz); u.pn = (wgid % nig) / gsz; u.srow = 0; u.kh = -1; return true;
    }
    __device__ __forceinline__ void a_ready(const Unit&) const {}
    __device__ __forceinline__ void done(const Unit&) const {}
};
struct LatOrder {
    static constexpr bool SPLIT = false;
    int nN, nwg, G, c;
    __host__ __device__ void init(int N, int G_, int c_) { nN = N / BM; nwg = 32 * nN; G = G_; c = c_; }
    __host__ __device__ bool next(int i, Unit& u) const {
        const long L = (long)i * G + c; if (L >= nwg) return false;
        int wgid = (int)L; { const int q = nwg / NXCD, r = nwg % NXCD, xcd = wgid % NXCD, off = wgid / NXCD; wgid = (xcd < r ? xcd * (q + 1) : r * (q + 1) + (xcd - r) * q) + off; }
        const int nig = WGM * nN, gid = wgid / nig, fm = gid * WGM;
        const int p = fm + ((wgid % nig) % WGM); u.pn = (wgid % nig) / WGM; u.pm = p + 1 + (p >= 16 ? 1 : 0); u.srow = (p >> 4) * RB + (p & 15) * 16; u.kh = -1; return true;
    }
    __device__ __forceinline__ void a_ready(const Unit&) const {}
    __device__ __forceinline__ void done(const Unit&) const {}
};
template <size_t XOFF, size_t FOFF> struct LatOrderSplit {
    static constexpr bool SPLIT = true;
    int nN, nwg, G, c, full, R; GAS unsigned char* wsb; static constexpr size_t xoff = XOFF, foff = FOFF;
    __device__ __forceinline__ void init(int N, int G_, int c_) { nN = N / BM; nwg = 32 * nN; G = G_; c = c_; R = nwg % G; if (R > 0 && 2 * R <= G && R % NXCD == 0) full = nwg - R; else { full = nwg; R = 0; } }
    __device__ __forceinline__ bool next(int i, Unit& u) const {
        const long L = (long)i * G + c; int wgid, kh = -1;
        if (L < full) wgid = (int)L;
        else { if (R == 0 || L >= full + 2 * R) return false; const int t = (int)(L - full); kh = t >= R ? 1 : 0; wgid = full + (t >= R ? t - R : t); }
        { const int q = nwg / NXCD, r = nwg % NXCD, xcd = wgid % NXCD, off = wgid / NXCD; wgid = (xcd < r ? xcd * (q + 1) : r * (q + 1) + (xcd - r) * q) + off; }
        const int nig = WGM * nN, gid = wgid / nig, fm = gid * WGM;
        const int p = fm + ((wgid % nig) % WGM); u.pn = (wgid % nig) / WGM; u.pm = p + 1 + (p >= 16 ? 1 : 0); u.srow = (p >> 4) * RB + (p & 15) * 16; u.kh = kh; return true;
    }
    __device__ __forceinline__ void a_ready(const Unit&) const {}
    __device__ __forceinline__ void done(const Unit&) const {}
};


__device__ __forceinline__ float rstd_of(float ss) { return __builtin_amdgcn_rsqf(ss * (1.0f / DM) + NORM_EPS); }
__device__ __forceinline__ void atomic_add_f32(gf32* p, float v) { (void)__builtin_amdgcn_global_atomic_fadd_f32(p, v); }

struct EpiRes {
    static constexpr bool PERM = true, AFTER_DRAIN = false;
    const gh16* base; gh16* out; const gf32* ada_l; int chunk; const gf32* ls;
    gb16* An; const gf32* gnext; const gf32* ada_n; int sc_chunk; gf32* stats;
    __device__ __forceinline__ void prefetch(const Unit&, PG8_LAS float*, int, int, int) const {}
    __device__ __forceinline__ void operator()(const f32x4 (&acc)[2][2][4][2], const Unit& u, int wr, int wc, int fr, int fq, const PG8_LAS float*) const {
        const int vec = (u.pm % PTILES == 0) ? 2 : (u.pm / PTILES);
        const GAS char* gate = (const GAS char*)(ada_l + (size_t)(vec * 6 + chunk) * DM + u.pn * BM);
        const GAS char* lsp = (const GAS char*)(ls + u.pn * BM);
        const GAS char* gnp = (const GAS char*)(gnext + u.pn * BM);
        const GAS char* scp = (const GAS char*)(ada_n + (size_t)(vec * 6 + sc_chunk) * DM + u.pn * BM);
        const GAS char* bt = (const GAS char*)(base + (size_t)u.pm * BM * DM + u.pn * BM);
        GAS char* ot = (GAS char*)(out + (size_t)u.pm * BM * DM + u.pn * BM);
        GAS char* at = (GAS char*)(An + (size_t)u.pm * BM * DM + u.pn * BM);
        asm volatile("" : "+v"(fr), "+v"(fq));
        const unsigned lo = (unsigned)((wr * 64 + fr) * DM + wc * 32 + 8 * fq) * 2u, co = (unsigned)(wc * 32 + 8 * fq) * 4u;
        const unsigned so = (unsigned)(wr * 64 + fq * 16 + fr) * 4u;
        float ssq[2][4];
#pragma unroll
        for (int ai = 0; ai < 2; ++ai)
#pragma unroll
            for (int m = 0; m < 4; ++m) ssq[ai][m] = 0.f;
#pragma unroll
        for (int bj = 0; bj < 2; ++bj) {
            f32x4 gv[2], gm[2];
#pragma unroll
            for (int n = 0; n < 2; ++n) { const unsigned c = co + (unsigned)(bj * HALF + n * 4) * 4u;
                gv[n] = *(const gf32x4*)(gate + c); if (ls) gv[n] = gv[n] * *(const gf32x4*)(lsp + c);
                gm[n] = An ? *(const gf32x4*)(gnp + c) * (*(const gf32x4*)(scp + c) + 1.0f) : (f32x4){0.f, 0.f, 0.f, 0.f}; }
            u32x4 bs[2][4];
#pragma unroll
            for (int ai = 0; ai < 2; ++ai)
#pragma unroll
                for (int m = 0; m < 4; ++m) { const unsigned o = lo + (unsigned)((ai * HALF + m * 16) * DM + bj * HALF) * 2u; bs[ai][m] = *(const gu32x4*)(bt + o); }
            asm volatile("" ::: "memory");
#pragma unroll
            for (int ai = 0; ai < 2; ++ai)
#pragma unroll
                for (int m = 0; m < 4; ++m) { const unsigned o = lo + (unsigned)((ai * HALF + m * 16) * DM + bj * HALF) * 2u; const u32x4 b = bs[ai][m];
                    const f32x4 x0 = (f32x4){h16_lo(b.x), h16_hi(b.x), h16_lo(b.y), h16_hi(b.y)} + acc[ai][bj][m][0] * gv[0], x1 = (f32x4){h16_lo(b.z), h16_hi(b.z), h16_lo(b.w), h16_hi(b.w)} + acc[ai][bj][m][1] * gv[1];
                    { u32x4 w; w.x = pk_h16(x0.x, x0.y); w.y = pk_h16(x0.z, x0.w); w.z = pk_h16(x1.x, x1.y); w.w = pk_h16(x1.z, x1.w); *(gu32x4*)(ot + o) = w; }
                    ssq[ai][m] += (x0.x * x0.x + x0.y * x0.y) + (x0.z * x0.z + x0.w * x0.w) + (x1.x * x1.x + x1.y * x1.y) + (x1.z * x1.z + x1.w * x1.w);
                    if (An) { const f32x4 y0 = x0 * gm[0], y1 = x1 * gm[1]; u32x4 w; w.x = cvt_pk_bf16(y0.x, y0.y); w.y = cvt_pk_bf16(y0.z, y0.w); w.z = cvt_pk_bf16(y1.x, y1.y); w.w = cvt_pk_bf16(y1.z, y1.w); *(gu32x4*)(at + o) = w; } }
            asm volatile("" ::: "memory");
        }
        if (stats) {
#pragma unroll
            for (int ai = 0; ai < 2; ++ai) {
#pragma unroll
                for (int m = 0; m < 4; ++m) { ssq[ai][m] += __shfl_xor(ssq[ai][m], 16); ssq[ai][m] += __shfl_xor(ssq[ai][m], 32); }
                const float v = fq == 0 ? ssq[ai][0] : fq == 1 ? ssq[ai][1] : fq == 2 ? ssq[ai][2] : ssq[ai][3];
                atomic_add_f32((gf32*)((GAS char*)(stats + u.pm * BM + ai * HALF) + so), v); }
        }
    }
    __device__ __forceinline__ void strip(const f32x4 (&accS)[2], const Unit& u, int wr, int wc, int fr, int fq) const {
        const GAS char* gate = (const GAS char*)(ada_l + (size_t)(2 * 6 + chunk) * DM + u.pn * BM);
        const GAS char* lsp = (const GAS char*)(ls + u.pn * BM);
        const GAS char* gnp = (const GAS char*)(gnext + u.pn * BM);
        const GAS char* scp = (const GAS char*)(ada_n + (size_t)(2 * 6 + sc_chunk) * DM + u.pn * BM);
        const GAS char* bt = (const GAS char*)(base + (size_t)u.srow * DM + u.pn * BM);
        GAS char* ot = (GAS char*)(out + (size_t)u.srow * DM + u.pn * BM);
        GAS char* at = (GAS char*)(An + (size_t)u.srow * DM + u.pn * BM);
        asm volatile("" : "+v"(fr), "+v"(fq));
        const unsigned co = (unsigned)(wc * 32 + 8 * fq + 4 * wr) * 4u, lo = (unsigned)(fr * DM) * 2u + (co >> 1), so = (unsigned)fr * 4u;
        float q = 0.f;
#pragma unroll
        for (int bj = 0; bj < 2; ++bj) { const unsigned c = co + (unsigned)(bj * HALF) * 4u, o = lo + (unsigned)(bj * HALF) * 2u;
            f32x4 gv = *(const gf32x4*)(gate + c); if (ls) gv = gv * *(const gf32x4*)(lsp + c);
            const u32x2 b = *(const gu32x2*)(bt + o);
            const f32x4 x0 = (f32x4){h16_lo(b.x), h16_hi(b.x), h16_lo(b.y), h16_hi(b.y)} + accS[bj] * gv; { u32x2 w; w.x = pk_h16(x0.x, x0.y); w.y = pk_h16(x0.z, x0.w); *(gu32x2*)(ot + o) = w; }
            q += (x0.x * x0.x + x0.y * x0.y) + (x0.z * x0.z + x0.w * x0.w);
            if (An) { const f32x4 y0 = x0 * (*(const gf32x4*)(gnp + c) * (*(const gf32x4*)(scp + c) + 1.0f));
                u32x2 w; w.x = cvt_pk_bf16(y0.x, y0.y); w.y = cvt_pk_bf16(y0.z, y0.w); *(gu32x2*)(at + o) = w; } }
        if (stats) { q += __shfl_xor(q, 16); q += __shfl_xor(q, 32); if (fq == 0) atomic_add_f32((gf32*)((GAS char*)(stats + u.srow) + so), q); }
    }
};
struct EpiFinal {
    static constexpr bool PERM = true, AFTER_DRAIN = false;
    const gh16* base; const gf32* ada_l; int chunk; gf32* stats; const gf32* fg; gf32* out; unsigned* cnt;
    __device__ __forceinline__ void prefetch(const Unit&, PG8_LAS float*, int, int, int) const {}
    __device__ __forceinline__ void operator()(f32x4 (&acc)[2][2][4][2], const Unit& u, int wr, int wc, int fr, int fq, const PG8_LAS float*) const {
        const int b = u.pm / PTILES;
        const GAS char* gate = (const GAS char*)(ada_l + (size_t)(b * 6 + chunk) * DM + u.pn * BM);
        const GAS char* bt = (const GAS char*)(base + (size_t)u.pm * BM * DM + u.pn * BM);
        asm volatile("" : "+v"(fr), "+v"(fq));
        const unsigned lo = (unsigned)((wr * 64 + fr) * DM + wc * 32 + 8 * fq) * 2u, co = (unsigned)(wc * 32 + 8 * fq) * 4u;
        const unsigned so = (unsigned)(wr * 64 + fq * 16 + fr) * 4u;
        float ssq[2][4];
#pragma unroll
        for (int ai = 0; ai < 2; ++ai)
#pragma unroll
            for (int m = 0; m < 4; ++m) ssq[ai][m] = 0.f;
#pragma unroll
        for (int bj = 0; bj < 2; ++bj) {
            f32x4 gv[2];
#pragma unroll
            for (int n = 0; n < 2; ++n) gv[n] = *(const gf32x4*)(gate + co + (unsigned)(bj * HALF + n * 4) * 4u);
            u32x4 bs[2][4];
#pragma unroll
            for (int ai = 0; ai < 2; ++ai)
#pragma unroll
                for (int m = 0; m < 4; ++m) bs[ai][m] = *(const gu32x4*)(bt + lo + (unsigned)((ai * HALF + m * 16) * DM + bj * HALF) * 2u);
            asm volatile("" ::: "memory");
#pragma unroll
            for (int ai = 0; ai < 2; ++ai)
#pragma unroll
                for (int m = 0; m < 4; ++m) { const u32x4 bb = bs[ai][m];
                    const f32x4 x0 = (f32x4){h16_lo(bb.x), h16_hi(bb.x), h16_lo(bb.y), h16_hi(bb.y)} + acc[ai][bj][m][0] * gv[0], x1 = (f32x4){h16_lo(bb.z), h16_hi(bb.z), h16_lo(bb.w), h16_hi(bb.w)} + acc[ai][bj][m][1] * gv[1];
                    acc[ai][bj][m][0] = x0; acc[ai][bj][m][1] = x1;
                    ssq[ai][m] += (x0.x * x0.x + x0.y * x0.y) + (x0.z * x0.z + x0.w * x0.w) + (x1.x * x1.x + x1.y * x1.y) + (x1.z * x1.z + x1.w * x1.w); }
        }
#pragma unroll
        for (int ai = 0; ai < 2; ++ai) {
#pragma unroll
            for (int m = 0; m < 4; ++m) { ssq[ai][m] += __shfl_xor(ssq[ai][m], 16); ssq[ai][m] += __shfl_xor(ssq[ai][m], 32); }
            const float v = fq == 0 ? ssq[ai][0] : fq == 1 ? ssq[ai][1] : fq == 2 ? ssq[ai][2] : ssq[ai][3];
            atomic_add_f32((gf32*)((GAS char*)(stats + u.pm * BM + ai * HALF) + so), v); }
        asm volatile("s_waitcnt vmcnt(0)" ::: "memory"); __builtin_amdgcn_s_barrier();
        if ((wr | wc | fr | fq) == 0) { unsigned* cp = cnt + u.pm * 16; (void)__hip_atomic_fetch_add(cp, 1u, __ATOMIC_RELAXED, __HIP_MEMORY_SCOPE_AGENT);
            unsigned sp = 0; while (__hip_atomic_load(cp, __ATOMIC_RELAXED, __HIP_MEMORY_SCOPE_AGENT) < (unsigned)(DM / BM)) { __builtin_amdgcn_s_sleep(1); if (++sp > (1u << 22)) break; } }
        __builtin_amdgcn_s_barrier(); asm volatile("" ::: "memory");
        float rs[2][4];
#pragma unroll
        for (int ai = 0; ai < 2; ++ai)
#pragma unroll
            for (int m = 0; m < 4; ++m) rs[ai][m] = rstd_of(__hip_atomic_load(stats + u.pm * BM + ai * HALF + wr * 64 + m * 16 + fr, __ATOMIC_RELAXED, __HIP_MEMORY_SCOPE_AGENT));
        GAS char* ob = (GAS char*)(out + ((size_t)b * SEQ + (size_t)(u.pm % PTILES - 1) * BM) * DM + u.pn * BM);
        const unsigned oo = (unsigned)((wr * 64 + fr) * DM + wc * 32 + 8 * fq) * 4u;
#pragma unroll
        for (int bj = 0; bj < 2; ++bj) {
            const f32x4 f0 = *(const gf32x4*)((const GAS char*)(fg + u.pn * BM) + co + (unsigned)(bj * HALF) * 4u), f1 = *(const gf32x4*)((const GAS char*)(fg + u.pn * BM) + co + (unsigned)(bj * HALF + 4) * 4u);
#pragma unroll
            for (int ai = 0; ai < 2; ++ai)
#pragma unroll
                for (int m = 0; m < 4; ++m) { const unsigned o = oo + (unsigned)((ai * HALF + m * 16) * DM + bj * HALF) * 4u;
                    *(gf32x4*)(ob + o) = (acc[ai][bj][m][0] * rs[ai][m]) * f0; *(gf32x4*)(ob + o + 16) = (acc[ai][bj][m][1] * rs[ai][m]) * f1; }
        }
    }
};
template <bool PF> struct EpiQKV {
    static constexpr bool PERM = true, AFTER_DRAIN = false;
    gb16* P0; gb16* P1; gb16* P2; int n0, n1, ld0, ld1; const gf32* stats; const gf32* bias; int nb; float qscale;
    const gf32* gk; const gf32* rope; PG8_LAS float* xk;
    __device__ __forceinline__ void prefetch(const Unit& u, PG8_LAS float* area, int lane, int wr, int wc) const {
        if constexpr (!PF) return;
        asm volatile("" : "+v"(lane));
        const int vec = (u.pm % PTILES == 0) ? 2 : (u.pm / PTILES);
        const gf32* sp = stats + u.pm * BM + wr * 64 + lane;
        __builtin_amdgcn_global_load_lds((const GAS unsigned*)sp, (PG8_LAS unsigned*)area, 4, 0, 0);
        __builtin_amdgcn_global_load_lds((const GAS unsigned*)(sp + HALF), (PG8_LAS unsigned*)(area + 64), 4, 0, 0);
        __builtin_amdgcn_global_load_lds((const GAS unsigned*)(bias + (size_t)vec * nb + u.pn * BM + (lane >> 5) * HALF + wc * 32 + (lane & 31)), (PG8_LAS unsigned*)(area + 128), 4, 0, 0);
    }
    __device__ __forceinline__ void operator()(const f32x4 (&acc)[2][2][4][2], const Unit& u, int wr, int wc, int fr, int fq, const PG8_LAS float* area, int aim = 3, int flip = 0) const {
        asm volatile("" : "+v"(fr), "+v"(fq));
        const int row0 = u.pm * BM + wr * 64 + fr;
        int colt = u.pn * BM; gb16* base = P0; int ldc = ld0; float qs = qscale;
        if (colt >= n0 + n1) { base = P2; ldc = ld1; colt -= n0 + n1; qs = 1.f; } else if (colt >= n0) { base = P1; ldc = ld1; colt -= n0; qs = 1.f; }
        const int col0 = colt + wc * 32 + 8 * fq;
        if (gk && base == P1) { ktile(acc, u, wr, wc, fr, fq, area, P1 + (size_t)row0 * ld1 + col0, aim, flip); return; }
        f32x4 bv[2][2];
#pragma unroll
        for (int bj = 0; bj < 2; ++bj)
#pragma unroll
            for (int n = 0; n < 2; ++n) bv[bj][n] = PF ? *(const PG8_LAS f32x4*)(area + 128 + bj * 32 + 8 * fq + 4 * n) : *(const gf32x4*)(bias + (size_t)((u.pm % PTILES == 0) ? 2 : (u.pm / PTILES)) * nb + u.pn * BM + wc * 32 + 8 * fq + bj * HALF + 4 * n);
#pragma unroll
        for (int ai = 0; ai < 2; ++ai) { if (!((aim >> ai) & 1)) continue; const int h = ai ^ flip;
#pragma unroll
            for (int m = 0; m < 4; ++m) { const int row = row0 + h * HALF + m * 16; const float rs = rstd_of(PF ? area[h * 64 + m * 16 + fr] : stats[row]); gb16* rowp = base + (size_t)row * ldc + col0;
#pragma unroll
                for (int bj = 0; bj < 2; ++bj) { const f32x4 v0 = (acc[ai][bj][m][0] * rs + bv[bj][0]) * qs, v1 = (acc[ai][bj][m][1] * rs + bv[bj][1]) * qs;
                    u32x4 w; w.x = cvt_pk_bf16(v0[0], v0[1]); w.y = cvt_pk_bf16(v0[2], v0[3]); w.z = cvt_pk_bf16(v1[0], v1[1]); w.w = cvt_pk_bf16(v1[2], v1[3]);
                    *(gu32x4*)(rowp + bj * HALF) = w; } } }
    }
    __device__ __forceinline__ void ktile(const f32x4 (&acc)[2][2][4][2], const Unit& u, int wr, int wc, int fr, int fq, const PG8_LAS float* area, gb16* rowp0, int aim, int flip) const {
        f32x4 bv[2][2];
#pragma unroll
        for (int bj = 0; bj < 2; ++bj)
#pragma unroll
            for (int n = 0; n < 2; ++n) bv[bj][n] = *(const PG8_LAS f32x4*)(area + 128 + bj * 32 + 8 * fq + 4 * n);
        float rs[2][4];
#pragma unroll
        for (int ai = 0; ai < 2; ++ai) { if (!((aim >> ai) & 1)) continue; const int h = ai ^ flip;
#pragma unroll
            for (int m = 0; m < 4; ++m) { rs[ai][m] = rstd_of(area[h * 64 + m * 16 + fr]);
#pragma unroll
                for (int bj = 0; bj < 2; ++bj) { const f32x4 v0 = acc[ai][bj][m][0] * rs[ai][m] + bv[bj][0], v1 = acc[ai][bj][m][1] * rs[ai][m] + bv[bj][1];
                    float q = (v0.x * v0.x + v0.y * v0.y) + (v0.z * v0.z + v0.w * v0.w) + (v1.x * v1.x + v1.y * v1.y) + (v1.z * v1.z + v1.w * v1.w);
                    q += __shfl_xor(q, 16); q += __shfl_xor(q, 32);
                    if (fq == 0) xk[(bj * BM + h * HALF + wr * 64 + m * 16 + fr) * 4 + wc] = q; } } }
        asm volatile("s_waitcnt lgkmcnt(0)" ::: "memory"); __builtin_amdgcn_s_barrier(); asm volatile("" ::: "memory");
        const f32x4 g0 = *(const gf32x4*)(gk + wc * 32 + 8 * fq), g1 = *(const gf32x4*)(gk + wc * 32 + 8 * fq + 4);
        const bool lat = (u.pm % PTILES) != 0;
        const int f0 = 16 * (wc & 1) + 4 * fq;
#pragma unroll
        for (int ai = 0; ai < 2; ++ai) { if (!((aim >> ai) & 1)) continue;
#pragma unroll
            for (int m = 0; m < 4; ++m) { const int rl = (ai ^ flip) * HALF + wr * 64 + m * 16 + fr; const int t = ((u.pm % PTILES) - 1) * BM + rl; const int pos = wc < 2 ? (t >> 6) : (t & 63);
                f32x4 t0 = {1.f, 0.f, 1.f, 0.f}, t1 = t0;
                if (lat) { t0 = *(const gf32x4*)(rope + 2 * (pos * 32 + f0)); t1 = *(const gf32x4*)(rope + 2 * (pos * 32 + f0 + 2)); }
#pragma unroll
                for (int bj = 0; bj < 2; ++bj) { const f32x4 pq = *(const PG8_LAS f32x4*)(xk + (bj * BM + rl) * 4);
                    const float rh = __builtin_amdgcn_rsqf(((pq.x + pq.y) + (pq.z + pq.w)) * (1.0f / 128.0f) + NORM_EPS);
                    const f32x4 y0 = (acc[ai][bj][m][0] * rs[ai][m] + bv[bj][0]) * rh * g0, y1 = (acc[ai][bj][m][1] * rs[ai][m] + bv[bj][1]) * rh * g1;
                    u32x4 w; w.x = cvt_pk_bf16(y0.x * t0.x - y0.y * t0.y, y0.x * t0.y + y0.y * t0.x); w.y = cvt_pk_bf16(y0.z * t0.z - y0.w * t0.w, y0.z * t0.w + y0.w * t0.z);
                    w.z = cvt_pk_bf16(y1.x * t1.x - y1.y * t1.y, y1.x * t1.y + y1.y * t1.x); w.w = cvt_pk_bf16(y1.z * t1.z - y1.w * t1.w, y1.z * t1.w + y1.w * t1.z);
                    *(gu32x4*)(rowp0 + (size_t)((ai ^ flip) * HALF + m * 16) * ld1 + bj * HALF) = w; } } }
    }
    __device__ __forceinline__ void strip(const f32x4 (&accS)[2], const Unit& u, int wr, int wc, int fr, int fq) const {
        asm volatile("" : "+v"(fr), "+v"(fq));
        int colt = u.pn * BM; gb16* base = P0; int ldc = ld0; float qs = qscale;
        if (colt >= n0 + n1) { base = P2; ldc = ld1; colt -= n0 + n1; qs = 1.f; } else if (colt >= n0) { base = P1; ldc = ld1; colt -= n0; qs = 1.f; }
        const int row = u.srow + fr; const float rs = rstd_of(stats[row]);
        gb16* rowp = base + (size_t)row * ldc + colt + wc * 32 + 8 * fq + 4 * wr; const gf32* bp = bias + (size_t)2 * nb + u.pn * BM + wc * 32 + 8 * fq + 4 * wr;
        if (gk && base == P1) {
            f32x4 v[2];
            __builtin_amdgcn_s_barrier();
#pragma unroll
            for (int bj = 0; bj < 2; ++bj) { v[bj] = accS[bj] * rs + *(const gf32x4*)(bp + bj * HALF);
                float q = (v[bj].x * v[bj].x + v[bj].y * v[bj].y) + (v[bj].z * v[bj].z + v[bj].w * v[bj].w); q += __shfl_xor(q, 16); q += __shfl_xor(q, 32);
                if (fq == 0) xk[(bj * 16 + fr) * 8 + wr * 4 + wc] = q; }
            asm volatile("s_waitcnt lgkmcnt(0)" ::: "memory"); __builtin_amdgcn_s_barrier(); asm volatile("" ::: "memory");
            const f32x4 g = *(const gf32x4*)(gk + wc * 32 + 8 * fq + 4 * wr);
#pragma unroll
            for (int bj = 0; bj < 2; ++bj) { const f32x4 p0 = *(const PG8_LAS f32x4*)(xk + (bj * 16 + fr) * 8), p1 = *(const PG8_LAS f32x4*)(xk + (bj * 16 + fr) * 8 + 4);
                const float rh = __builtin_amdgcn_rsqf((((p0.x + p0.y) + (p0.z + p0.w)) + ((p1.x + p1.y) + (p1.z + p1.w))) * (1.0f / 128.0f) + NORM_EPS);
                const f32x4 y = v[bj] * rh * g; u32x2 w; w.x = cvt_pk_bf16(y[0], y[1]); w.y = cvt_pk_bf16(y[2], y[3]); *(gu32x2*)(rowp + bj * HALF) = w; }
            return; }
#pragma unroll
        for (int bj = 0; bj < 2; ++bj) { const f32x4 v = (accS[bj] * rs + *(const gf32x4*)(bp + bj * HALF)) * qs; u32x2 w; w.x = cvt_pk_bf16(v[0], v[1]); w.y = cvt_pk_bf16(v[2], v[3]); *(gu32x2*)(rowp + bj * HALF) = w; }
    }
};
__device__ __forceinline__ float silu_mul(float g, float u) { return g * u * __builtin_amdgcn_rcpf(1.0f + __builtin_amdgcn_exp2f(-1.4426950408889634f * g)); }
__device__ __forceinline__ unsigned silu_mul_pk(f32x2 g, f32x2 u) {
    const f32x2 t = g * (-1.4426950408889634f); f32x2 e; e.x = __builtin_amdgcn_exp2f(t.x); e.y = __builtin_amdgcn_exp2f(t.y);
    const f32x2 d = e + 1.0f; f32x2 r; r.x = __builtin_amdgcn_rcpf(d.x); r.y = __builtin_amdgcn_rcpf(d.y);
    const f32x2 o = (g * u) * r; return cvt_pk_bf16(o.x, o.y);
}
struct EpiSwiGLU {
    static constexpr bool PERM = true, AFTER_DRAIN = false;
    gb16* U; const gf32* stats; const gf32* bias;
    __device__ __forceinline__ void prefetch(const Unit& u, PG8_LAS float* area, int lane, int wr, int wc) const {
        asm volatile("" : "+v"(lane));
        const int vec = (u.pm % PTILES == 0) ? 2 : (u.pm / PTILES);
        const gf32* sp = stats + u.pm * BM + wr * 64 + lane;
        __builtin_amdgcn_global_load_lds((const GAS unsigned*)sp, (PG8_LAS unsigned*)area, 4, 0, 0);
        __builtin_amdgcn_global_load_lds((const GAS unsigned*)(sp + HALF), (PG8_LAS unsigned*)(area + 64), 4, 0, 0);
        __builtin_amdgcn_global_load_lds((const GAS unsigned*)(bias + (size_t)vec * (2 * FF) + u.pn * BM + (lane >> 5) * HALF + wc * 32 + (lane & 31)), (PG8_LAS unsigned*)(area + 128), 4, 0, 0);
    }
    __device__ __forceinline__ void operator()(const f32x4 (&acc)[2][2][4][2], const Unit& u, int wr, int wc, int fr, int fq, const PG8_LAS float* area, int aim = 3, int flip = 0) const {
        asm volatile("" : "+v"(fr), "+v"(fq));
        const int row0 = u.pm * BM + wr * 64 + fr;
        const int col0 = u.pn * HALF + wc * 32 + 8 * fq;
        const f32x4 bg0 = *(const PG8_LAS f32x4*)(area + 128 + 8 * fq), bg1 = *(const PG8_LAS f32x4*)(area + 128 + 8 * fq + 4), bu0 = *(const PG8_LAS f32x4*)(area + 160 + 8 * fq), bu1 = *(const PG8_LAS f32x4*)(area + 160 + 8 * fq + 4);
#pragma unroll
        for (int ai = 0; ai < 2; ++ai) { if (!((aim >> ai) & 1)) continue;
#pragma unroll
            for (int m = 0; m < 4; ++m) { const int h = ai ^ flip; const int row = row0 + h * HALF + m * 16; const float rs = rstd_of(area[h * 64 + m * 16 + fr]); gb16* rowp = U + (size_t)row * FF + col0;
                const f32x4 g0 = acc[ai][0][m][0] * rs + bg0, g1 = acc[ai][0][m][1] * rs + bg1, u0 = acc[ai][1][m][0] * rs + bu0, u1 = acc[ai][1][m][1] * rs + bu1;
                u32x4 w; w.x = silu_mul_pk((f32x2){g0[0], g0[1]}, (f32x2){u0[0], u0[1]}); w.y = silu_mul_pk((f32x2){g0[2], g0[3]}, (f32x2){u0[2], u0[3]});
                w.z = silu_mul_pk((f32x2){g1[0], g1[1]}, (f32x2){u1[0], u1[1]}); w.w = silu_mul_pk((f32x2){g1[2], g1[3]}, (f32x2){u1[2], u1[3]});
                *(gu32x4*)rowp = w; } }
    }
};

template <class Epi, class Sched, bool ALIGN_EPI = false, bool SP2 = false>
__device__ __forceinline__ void gemm_phase(PG8_LAS unsigned char* lds, PG8_LAS unsigned char* pf, const Gemm g, const Sched& S, const Epi& E, int wv) {
    const int tid = tid_here(wv), wid = wv, lane = tid & 63, wr = wid >> 2, wc = wid & 3, fr = lane & 15, fq = lane >> 4;
    const int K = g.K, nt = K / BK, lda = g.lda;
    unsigned voffA[2], voffB[2];
#pragma unroll
    for (int i = 0; i < 2; ++i) { int R, C; stage_rc(tid * 16 + i * 8192, R, C); const int Rb = Epi::PERM ? ((R & ~31) + perm32(R & 31)) : R;
        voffA[i] = (unsigned)(R * lda + C) * 2u; voffB[i] = (unsigned)(Rb * K + C) * 2u; }
    const size_t kstep = (size_t)(BK * 2);
    const size_t hstepA = (size_t)HALF * lda * 2, hstepB = (size_t)HALF * K * 2;
    const size_t tstepA = 2 * hstepA, tstepB = 2 * hstepB;
    const unsigned ldsw = (unsigned)wid * 1024u;
    const int aoff = lds_byte(wr * 64 + fr, fq * 8), boff = lds_byte(wc * 32 + fr, fq * 8);
#define PG8_SA(b, h) (((b) * 2 + (h)) * HTB)
#define PG8_SB(b, h) ((4 + (b) * 2 + (h)) * HTB)
#define PG8_STAGE(bufoff, gbase, voff) do { _Pragma("unroll") for (int _i = 0; _i < 2; ++_i) \
        __builtin_amdgcn_global_load_lds((const GAS unsigned*)((const GAS char*)(gbase) + (voff)[_i]), (PG8_LAS unsigned*)(lds + (bufoff) + ldsw + _i * 8192), 16, 0, 0); } while (0)
#define PG8_LDA(dst, b, h) do { _Pragma("unroll") for (int m = 0; m < 4; ++m) _Pragma("unroll") for (int k = 0; k < 2; ++k) dst[m][k] = *(const PG8_LAS bf16x8*)(lds + PG8_SA(b, h) + aoff + m * 2048 + k * 1024); } while (0)
#define PG8_LDB(dst, b, h) do { _Pragma("unroll") for (int n = 0; n < 2; ++n) _Pragma("unroll") for (int k = 0; k < 2; ++k) dst[n][k] = *(const PG8_LAS bf16x8*)(lds + PG8_SB(b, h) + boff + n * 2048 + k * 1024); } while (0)
#define PG8_MMA(ai, bj, At, Bt) do { __builtin_amdgcn_s_setprio(1); _Pragma("unroll") for (int m = 0; m < 4; ++m) _Pragma("unroll") for (int n = 0; n < 2; ++n) _Pragma("unroll") for (int k = 0; k < 2; ++k) \
        acc[ai][bj][m][n] = __builtin_amdgcn_mfma_f32_16x16x32_bf16(Bt[n][k], At[m][k], acc[ai][bj][m][n], 0, 0, 0); __builtin_amdgcn_s_setprio(0); } while (0)
#define PG8_WAIT_V(n) asm volatile("s_waitcnt vmcnt(" #n ")" ::: "memory")
#define PG8_WAIT_L(n) asm volatile("s_waitcnt lgkmcnt(" #n ")" ::: "memory")
#define PG8_BAR __builtin_amdgcn_s_barrier()
#define PG8_SCHED __builtin_amdgcn_sched_barrier(0)
#define PG8_KOFF(u) ((Sched::SPLIT && (u).kh > 0) ? (size_t)K : (size_t)0)
#define PG8_ABASE(u) ((const GAS char*)g.A + (size_t)(u).pm * tstepA + (size_t)((u).pn / g.a_tpg) * (size_t)K * 2 + PG8_KOFF(u))
#define PG8_BBASE(u) ((const GAS char*)g.Bt + (size_t)(u).pn * tstepB + PG8_KOFF(u))
    Unit cur, nxt; int ui = 0;
    if (!S.next(0, cur)) return;
    f32x4 acc[2][2][4][2];
#pragma unroll
    for (int a = 0; a < 2; ++a)
#pragma unroll
        for (int b = 0; b < 2; ++b)
#pragma unroll
            for (int m = 0; m < 4; ++m)
#pragma unroll
                for (int n = 0; n < 2; ++n) acc[a][b][m][n] = (f32x4){0.f, 0.f, 0.f, 0.f};
    bf16x8 At[4][2], B0[2][2], B1[2][2];
    const GAS char* cA = PG8_ABASE(cur); const GAS char* cB = PG8_BBASE(cur);
    long hsA = (long)hstepA;
    if constexpr (Sched::SPLIT) { if (cur.kh > 0) { cA += hstepA; hsA = -(long)hstepA; } }
    S.a_ready(cur);
    int par = 0;
    E.prefetch(cur, (PG8_LAS float*)(pf + wid * 768), lane, wr, wc);
    if constexpr (SP2) {
        PG8_STAGE(PG8_SB(0, 0), cB, voffB); PG8_STAGE(PG8_SB(0, 1), cB + hstepB, voffB); PG8_STAGE(PG8_SA(0, 0), cA, voffA); PG8_STAGE(PG8_SA(0, 1), cA + (Sched::SPLIT ? hsA : (long)hstepA), voffA);
        if (wr == 1) PG8_BAR;
        PG8_WAIT_V(2); PG8_BAR;
        PG8_STAGE(PG8_SB(1, 0), cB + kstep, voffB); PG8_STAGE(PG8_SA(1, 0), cA + kstep, voffA); PG8_STAGE(PG8_SB(1, 1), cB + hstepB + kstep, voffB);
        PG8_WAIT_V(6); PG8_BAR;
    } else {
        PG8_STAGE(PG8_SB(0, 0), cB, voffB); PG8_STAGE(PG8_SA(0, 0), cA, voffA); PG8_STAGE(PG8_SB(0, 1), cB + hstepB, voffB); PG8_STAGE(PG8_SA(0, 1), cA + hstepA, voffA);
        if (wr == 1) PG8_BAR;
        PG8_WAIT_V(4); PG8_BAR;
        PG8_STAGE(PG8_SB(1, 0), cB + kstep, voffB); PG8_STAGE(PG8_SA(1, 0), cA + kstep, voffA); PG8_STAGE(PG8_SB(1, 1), cB + hstepB + kstep, voffB);
        PG8_WAIT_V(6); PG8_BAR;
    }
    for (;;) {
        const bool has_next = S.next(ui + 1, nxt);
        const GAS char* nA = has_next ? PG8_ABASE(nxt) : cA; const GAS char* nB = has_next ? PG8_BBASE(nxt) : cB;
        if constexpr (Sched::SPLIT) { if (has_next && nxt.kh > 0) nA += hstepA; }
        int ntu = nt; if constexpr (Sched::SPLIT) { if (cur.kh >= 0) ntu = nt >> 1; }
        for (int t = 0; t < ntu; t += 2) {
            const bool last = (t == ntu - 2);
            const GAS char* a1 = cA + (size_t)(t + 1) * kstep;
            const GAS char* a2 = last ? nA : cA + (size_t)(t + 2) * kstep; const GAS char* b2 = last ? nB : cB + (size_t)(t + 2) * kstep;
            const GAS char* a3 = a2 + kstep; const GAS char* b3 = b2 + kstep;
            if (last && has_next) S.a_ready(nxt);
            if constexpr (SP2) {
            PG8_LDB(B0, 0, 0); PG8_LDB(B1, 0, 1); PG8_SCHED; PG8_LDA(At, 0, 0); PG8_STAGE(PG8_SA(1, 1), a1 + (Sched::SPLIT ? hsA : (long)hstepA), voffA);
            PG8_WAIT_V(8); PG8_WAIT_L(0); PG8_BAR; PG8_MMA(0, 0, At, B0); PG8_MMA(0, 1, At, B1); PG8_BAR; PG8_SCHED;
            PG8_LDA(At, 0, 1); PG8_STAGE(PG8_SB(0, 0), b2, voffB); PG8_STAGE(PG8_SB(0, 1), b2 + hstepB, voffB); PG8_STAGE(PG8_SA(0, 0), a2, voffA);
            PG8_WAIT_V(8); PG8_WAIT_L(0); PG8_BAR; PG8_MMA(1, 0, At, B0); PG8_MMA(1, 1, At, B1); PG8_BAR; PG8_SCHED;
            PG8_LDB(B0, 1, 0); PG8_LDB(B1, 1, 1); PG8_SCHED; PG8_LDA(At, 1, 0); PG8_STAGE(PG8_SA(0, 1), a2 + (Sched::SPLIT ? ((last && has_next) ? (nxt.kh > 0 ? -(long)hstepA : (long)hstepA) : hsA) : (long)hstepA), voffA);
            PG8_WAIT_V(8); PG8_WAIT_L(0); PG8_BAR; PG8_MMA(0, 0, At, B0); PG8_MMA(0, 1, At, B1); PG8_BAR; PG8_SCHED;
            PG8_LDA(At, 1, 1); PG8_STAGE(PG8_SB(1, 0), b3, voffB); PG8_STAGE(PG8_SB(1, 1), b3 + hstepB, voffB); PG8_STAGE(PG8_SA(1, 0), a3, voffA);
            PG8_WAIT_V(8); PG8_WAIT_L(0); PG8_BAR; PG8_MMA(1, 0, At, B0); PG8_MMA(1, 1, At, B1); PG8_BAR; PG8_SCHED;
            } else {
            PG8_LDB(B0, 0, 0); PG8_SCHED; PG8_LDA(At, 0, 0); PG8_STAGE(PG8_SA(1, 1), a1 + hstepA, voffA);
            PG8_WAIT_L(8); PG8_BAR; PG8_WAIT_L(0); PG8_MMA(0, 0, At, B0); PG8_BAR; PG8_SCHED;
            PG8_LDB(B1, 0, 1); PG8_STAGE(PG8_SB(0, 0), b2, voffB);
            PG8_BAR; PG8_WAIT_L(0); PG8_MMA(0, 1, At, B1); PG8_BAR;
            PG8_LDA(At, 0, 1); PG8_STAGE(PG8_SA(0, 0), a2, voffA);
            PG8_BAR; PG8_WAIT_L(0); PG8_MMA(1, 0, At, B0); PG8_BAR; PG8_SCHED;
            PG8_STAGE(PG8_SB(0, 1), b2 + hstepB, voffB);
            PG8_WAIT_V(6); PG8_BAR; PG8_MMA(1, 1, At, B1); PG8_BAR;
            PG8_LDB(B0, 1, 0); PG8_SCHED; PG8_LDA(At, 1, 0); PG8_STAGE(PG8_SA(0, 1), a2 + hstepA, voffA);
            PG8_WAIT_L(8); PG8_BAR; PG8_WAIT_L(0); PG8_MMA(0, 0, At, B0); PG8_BAR; PG8_SCHED;
            PG8_LDB(B1, 1, 1); PG8_STAGE(PG8_SB(1, 0), b3, voffB);
            PG8_BAR; PG8_WAIT_L(0); PG8_MMA(0, 1, At, B1); PG8_BAR;
            PG8_LDA(At, 1, 1); PG8_STAGE(PG8_SA(1, 0), a3, voffA);
            PG8_BAR; PG8_WAIT_L(0); PG8_MMA(1, 0, At, B0); PG8_BAR; PG8_SCHED;
            PG8_STAGE(PG8_SB(1, 1), b3 + hstepB, voffB);
            PG8_WAIT_V(6); PG8_BAR; PG8_MMA(1, 1, At, B1); PG8_BAR;
            }
        }
        if constexpr (ALIGN_EPI) { if (wr == 0) PG8_BAR; }
        if constexpr (Sched::SPLIT) {
            int aim = 3, flip = 0;
            if (cur.kh >= 0) {
                const int kh = cur.kh, pair = S.c % S.R;
                const __amdgpu_buffer_rsrc_t rw = __builtin_amdgcn_make_buffer_rsrc((void*)(unsigned char*)(S.wsb + S.xoff + (size_t)(pair * 2 + (1 - kh)) * 131072), 0, 131072, 0x00020000);
                const __amdgpu_buffer_rsrc_t rr = __builtin_amdgcn_make_buffer_rsrc((void*)(unsigned char*)(S.wsb + S.xoff + (size_t)(pair * 2 + kh) * 131072), 0, 131072, 0x00020000);
                int tl = tid; asm volatile("" : "+v"(tl)); const int vo = tl * 16;
#pragma unroll
                for (int j = 0; j < 16; ++j) __builtin_amdgcn_raw_buffer_store_b128(__builtin_bit_cast(u32x4, acc[1][j >> 3][(j >> 1) & 3][j & 1]), rw, vo, j * 8192, 16);
                PG8_WAIT_V(0); PG8_BAR;
                if (tl == 0) { (void)__hip_atomic_fetch_add(&((unsigned*)(S.wsb + S.foff))[(pair * 2 + kh) * 16], 1u, __ATOMIC_RELAXED, __HIP_MEMORY_SCOPE_AGENT);
                    unsigned sp = 0; while (__hip_atomic_load(&((unsigned*)(S.wsb + S.foff))[(pair * 2 + (1 - kh)) * 16], __ATOMIC_RELAXED, __HIP_MEMORY_SCOPE_AGENT) == 0u) { __builtin_amdgcn_s_sleep(1); if (++sp > (1u << 22)) break; } }
                PG8_BAR;
#pragma unroll
                for (int j = 0; j < 16; ++j) acc[0][j >> 3][(j >> 1) & 3][j & 1] += __builtin_bit_cast(f32x4, __builtin_amdgcn_raw_buffer_load_b128(rr, vo, j * 8192, 16));
                aim = 1; flip = kh;
            }
            E(acc, cur, wr, wc, fr, fq, (const PG8_LAS float*)(pf + par * 6144 + wid * 768), aim, flip); S.done(cur);
        } else
        if constexpr (!Epi::AFTER_DRAIN) { E(acc, cur, wr, wc, fr, fq, (const PG8_LAS float*)(pf + par * 6144 + wid * 768)); S.done(cur); }
        if (!has_next) break;
#pragma unroll
        for (int a = 0; a < 2; ++a)
#pragma unroll
            for (int b = 0; b < 2; ++b)
#pragma unroll
                for (int m = 0; m < 4; ++m)
#pragma unroll
                    for (int n = 0; n < 2; ++n) acc[a][b][m][n] = (f32x4){0.f, 0.f, 0.f, 0.f};
        cur = nxt; cA = nA; cB = nB; if constexpr (Sched::SPLIT) hsA = cur.kh > 0 ? -(long)hstepA : (long)hstepA; ++ui; par ^= 1;
        E.prefetch(cur, (PG8_LAS float*)(pf + par * 6144 + wid * 768), lane, wr, wc);
        if constexpr (ALIGN_EPI) { if (wr == 1) PG8_BAR; }
    }
    PG8_WAIT_V(0);
    if constexpr (!ALIGN_EPI) { if (wr == 0) PG8_BAR; }
    PG8_BAR;
#undef PG8_SA
#undef PG8_SB
#undef PG8_STAGE
#undef PG8_LDA
#undef PG8_LDB
#undef PG8_MMA
#undef PG8_WAIT_V
#undef PG8_WAIT_L
#undef PG8_BAR
#undef PG8_SCHED
#undef PG8_KOFF
#undef PG8_ABASE
#undef PG8_BBASE
}

template <class Epi, class Sched>
__device__ __forceinline__ void gemm_phase_strip(PG8_LAS unsigned char* lds, PG8_LAS unsigned char* slds, PG8_LAS unsigned char* pf, const Gemm g, const Sched& S, const Epi& E, int wv) {
    const int tid = tid_here(wv), wid = wv, lane = tid & 63, wr = wid >> 2, wc = wid & 3, fr = lane & 15, fq = lane >> 4;
    const int K = g.K, nt = K / BK, lda = g.lda;
    unsigned voffA[2], voffB[2], voffS;
#pragma unroll
    for (int i = 0; i < 2; ++i) { int R, C; stage_rc(tid * 16 + i * 8192, R, C); const int Rb = Epi::PERM ? ((R & ~31) + perm32(R & 31)) : R;
        voffA[i] = (unsigned)(R * lda + C) * 2u; voffB[i] = (unsigned)(Rb * K + C) * 2u; }
    { const int l5 = lane & 31, r = (wid & 3) * 4 + (l5 >> 3), c = (l5 & 7) ^ (r & 7); voffS = (unsigned)(r * lda + c * 8 + (wid >> 2) * BK) * 2u; }
    const size_t kstep = (size_t)(BK * 2);
    const size_t hstepA = (size_t)HALF * lda * 2, hstepB = (size_t)HALF * K * 2;
    const size_t tstepA = 2 * hstepA, tstepB = 2 * hstepB;
    const unsigned ldsw = (unsigned)wid * 1024u, ldss = (unsigned)wid * 512u;
    const int aoff = lds_byte(wr * 64 + fr, fq * 8), boff = lds_byte(wc * 32 + fr, fq * 8);
    const int soff0 = fr * 128 + ((fq ^ (fr & 7)) << 4);
#define PG8_SA(b, h) (((b) * 2 + (h)) * HTB)
#define PG8_SB(b, h) ((4 + (b) * 2 + (h)) * HTB)
#define PG8_STAGE(bufoff, gbase, voff) do { _Pragma("unroll") for (int _i = 0; _i < 2; ++_i) \
        __builtin_amdgcn_global_load_lds((const GAS unsigned*)((const GAS char*)(gbase) + (voff)[_i]), (PG8_LAS unsigned*)(lds + (bufoff) + ldsw + _i * 8192), 16, 0, 0); } while (0)
#define PG8_STAGE_S(poff, gbase) do { unsigned _vs = voffS; asm volatile("" : "+v"(_vs));        \
        if (lane < 32) __builtin_amdgcn_global_load_lds((const GAS unsigned*)((const GAS char*)(gbase) + _vs), (PG8_LAS unsigned*)(slds + (poff) + ldss), 16, 0, 0); } while (0)
#define PG8_LDA(dst, b, h) do { _Pragma("unroll") for (int m = 0; m < 4; ++m) _Pragma("unroll") for (int k = 0; k < 2; ++k) dst[m][k] = *(const PG8_LAS bf16x8*)(lds + PG8_SA(b, h) + aoff + m * 2048 + k * 1024); } while (0)
#define PG8_LDB(dst, b, h) do { _Pragma("unroll") for (int n = 0; n < 2; ++n) _Pragma("unroll") for (int k = 0; k < 2; ++k) dst[n][k] = *(const PG8_LAS bf16x8*)(lds + PG8_SB(b, h) + boff + n * 2048 + k * 1024); } while (0)
#define PG8_LDS_S(dst, boffs) do { dst[0] = *(const PG8_LAS bf16x8*)(slds + (boffs) + soff0); dst[1] = *(const PG8_LAS bf16x8*)(slds + (boffs) + (soff0 ^ 64)); } while (0)
#define PG8_MMA(ai, bj, At, Bt) do { __builtin_amdgcn_s_setprio(1); _Pragma("unroll") for (int m = 0; m < 4; ++m) _Pragma("unroll") for (int n = 0; n < 2; ++n) _Pragma("unroll") for (int k = 0; k < 2; ++k) \
        acc[ai][bj][m][n] = __builtin_amdgcn_mfma_f32_16x16x32_bf16(Bt[n][k], At[m][k], acc[ai][bj][m][n], 0, 0, 0); __builtin_amdgcn_s_setprio(0); } while (0)
#define PG8_MMA_S() do { __builtin_amdgcn_s_setprio(1); if (wr == 0) { _Pragma("unroll") for (int k = 0; k < 2; ++k) { accS[0] = __builtin_amdgcn_mfma_f32_16x16x32_bf16(B0[0][k], As[k], accS[0], 0, 0, 0); accS[1] = __builtin_amdgcn_mfma_f32_16x16x32_bf16(B1[0][k], As[k], accS[1], 0, 0, 0); } } \
        else { _Pragma("unroll") for (int k = 0; k < 2; ++k) { accS[0] = __builtin_amdgcn_mfma_f32_16x16x32_bf16(B0[1][k], As[k], accS[0], 0, 0, 0); accS[1] = __builtin_amdgcn_mfma_f32_16x16x32_bf16(B1[1][k], As[k], accS[1], 0, 0, 0); } } __builtin_amdgcn_s_setprio(0); } while (0)
#define PG8_WAIT_V(n) asm volatile("s_waitcnt vmcnt(" #n ")" ::: "memory")
#define PG8_WAIT_L(n) asm volatile("s_waitcnt lgkmcnt(" #n ")" ::: "memory")
#define PG8_BAR __builtin_amdgcn_s_barrier()
#define PG8_SCHED __builtin_amdgcn_sched_barrier(0)
#define PG8_KOFF(u) ((Sched::SPLIT && (u).kh > 0) ? (size_t)K : (size_t)0)
#define PG8_ABASE(u) ((const GAS char*)g.A + (size_t)(u).pm * tstepA + (size_t)((u).pn / g.a_tpg) * (size_t)K * 2 + PG8_KOFF(u))
#define PG8_BBASE(u) ((const GAS char*)g.Bt + (size_t)(u).pn * tstepB + PG8_KOFF(u))
#define PG8_SBASE(u) ((const GAS char*)g.A + (size_t)(u).srow * (size_t)lda * 2 + (size_t)((u).pn / g.a_tpg) * (size_t)K * 2 + PG8_KOFF(u))
#define PG8_HS (Sched::SPLIT ? hsA : (long)hstepA)
    Unit cur, nxt; int ui = 0;
    if (!S.next(0, cur)) return;
    f32x4 acc[2][2][4][2]; f32x4 accS[2];
#pragma unroll
    for (int a = 0; a < 2; ++a)
#pragma unroll
        for (int b = 0; b < 2; ++b)
#pragma unroll
            for (int m = 0; m < 4; ++m)
#pragma unroll
                for (int n = 0; n < 2; ++n) acc[a][b][m][n] = (f32x4){0.f, 0.f, 0.f, 0.f};
    accS[0] = (f32x4){0.f, 0.f, 0.f, 0.f}; accS[1] = (f32x4){0.f, 0.f, 0.f, 0.f};
    bf16x8 At[4][2], B0[2][2], B1[2][2], As[2];
    const GAS char* cA = PG8_ABASE(cur); const GAS char* cB = PG8_BBASE(cur); const GAS char* cS = PG8_SBASE(cur);
    long hsA = (long)hstepA;
    if constexpr (Sched::SPLIT) { if (cur.kh > 0) { cA += hstepA; hsA = -(long)hstepA; } }
    int par = 0; unsigned sq = 0;
    E.prefetch(cur, (PG8_LAS float*)(pf + wid * 768), lane, wr, wc);
    PG8_STAGE(PG8_SB(0, 0), cB, voffB); PG8_STAGE(PG8_SB(0, 1), cB + hstepB, voffB); PG8_STAGE(PG8_SA(0, 0), cA, voffA); PG8_STAGE(PG8_SA(0, 1), cA + PG8_HS, voffA); PG8_STAGE_S(0, cS);
    if (wr == 1) PG8_BAR;
    PG8_WAIT_V(3); PG8_BAR;
    PG8_STAGE(PG8_SB(1, 0), cB + kstep, voffB); PG8_STAGE(PG8_SA(1, 0), cA + kstep, voffA); PG8_STAGE(PG8_SB(1, 1), cB + hstepB + kstep, voffB);
    PG8_WAIT_V(6); PG8_BAR;
    for (;;) {
        const bool has_next = S.next(ui + 1, nxt);
        const GAS char* nA = has_next ? PG8_ABASE(nxt) : cA; const GAS char* nB = has_next ? PG8_BBASE(nxt) : cB; const GAS char* nS = has_next ? PG8_SBASE(nxt) : cS;
        if constexpr (Sched::SPLIT) { if (has_next && nxt.kh > 0) nA += hstepA; }
        int ntu = nt; if constexpr (Sched::SPLIT) { if (cur.kh >= 0) ntu = nt >> 1; }
        for (int t = 0; t < ntu; t += 2) {
            const bool last = (t == ntu - 2);
            const GAS char* a1 = cA + (size_t)(t + 1) * kstep;
            const GAS char* a2 = last ? nA : cA + (size_t)(t + 2) * kstep; const GAS char* b2 = last ? nB : cB + (size_t)(t + 2) * kstep; const GAS char* s2 = last ? nS : cS + (size_t)(t + 2) * kstep;
            const GAS char* a3 = a2 + kstep; const GAS char* b3 = b2 + kstep;
            PG8_LDB(B0, 0, 0); PG8_LDB(B1, 0, 1); PG8_SCHED; PG8_LDA(At, 0, 0); PG8_STAGE(PG8_SA(1, 1), a1 + PG8_HS, voffA);
            PG8_WAIT_V(8); PG8_WAIT_L(0); PG8_BAR; PG8_MMA(0, 0, At, B0); PG8_MMA(0, 1, At, B1); PG8_BAR; PG8_SCHED;
            PG8_LDA(At, 0, 1); PG8_LDS_S(As, sq); PG8_STAGE(PG8_SB(0, 0), b2, voffB); PG8_STAGE(PG8_SB(0, 1), b2 + hstepB, voffB); PG8_STAGE(PG8_SA(0, 0), a2, voffA);
            PG8_WAIT_V(8); PG8_WAIT_L(0); PG8_BAR; PG8_MMA(1, 0, At, B0); PG8_MMA(1, 1, At, B1); PG8_MMA_S(); PG8_BAR; PG8_SCHED;
            PG8_LDB(B0, 1, 0); PG8_LDB(B1, 1, 1); PG8_SCHED; PG8_LDA(At, 1, 0); PG8_STAGE(PG8_SA(0, 1), a2 + (Sched::SPLIT ? ((last && has_next) ? (nxt.kh > 0 ? -(long)hstepA : (long)hstepA) : hsA) : (long)hstepA), voffA); PG8_STAGE_S(sq ^ 4096u, s2);
            PG8_WAIT_V(9); PG8_WAIT_L(0); PG8_BAR; PG8_MMA(0, 0, At, B0); PG8_MMA(0, 1, At, B1); PG8_BAR; PG8_SCHED;
            PG8_LDA(At, 1, 1); PG8_LDS_S(As, sq + 2048u); PG8_STAGE(PG8_SB(1, 0), b3, voffB); PG8_STAGE(PG8_SB(1, 1), b3 + hstepB, voffB); PG8_STAGE(PG8_SA(1, 0), a3, voffA);
            PG8_WAIT_V(9); PG8_WAIT_L(0); PG8_BAR; PG8_MMA(1, 0, At, B0); PG8_MMA(1, 1, At, B1); PG8_MMA_S(); PG8_BAR; PG8_SCHED;
            sq ^= 4096u;
        }
        if (wr == 0) PG8_BAR;
        if constexpr (Sched::SPLIT) {
            int aim = 3, flip = 0;
            if (cur.kh >= 0) {
                const int kh = cur.kh, pair = S.c % S.R;
                const __amdgpu_buffer_rsrc_t rw = __builtin_amdgcn_make_buffer_rsrc((void*)(unsigned char*)(S.wsb + S.xoff + (size_t)(pair * 2 + (1 - kh)) * 147456), 0, 147456, 0x00020000);
                const __amdgpu_buffer_rsrc_t rr = __builtin_amdgcn_make_buffer_rsrc((void*)(unsigned char*)(S.wsb + S.xoff + (size_t)(pair * 2 + kh) * 147456), 0, 147456, 0x00020000);
                int tl = tid; asm volatile("" : "+v"(tl)); const int vo = tl * 16;
#pragma unroll
                for (int j = 0; j < 16; ++j) __builtin_amdgcn_raw_buffer_store_b128(__builtin_bit_cast(u32x4, acc[1][j >> 3][(j >> 1) & 3][j & 1]), rw, vo, j * 8192, 16);
                __builtin_amdgcn_raw_buffer_store_b128(__builtin_bit_cast(u32x4, accS[0]), rw, vo, 16 * 8192, 16); __builtin_amdgcn_raw_buffer_store_b128(__builtin_bit_cast(u32x4, accS[1]), rw, vo, 17 * 8192, 16);
                PG8_WAIT_V(0); PG8_BAR;
                if (tl == 0) { (void)__hip_atomic_fetch_add(&((unsigned*)(S.wsb + S.foff))[(pair * 2 + kh) * 16], 1u, __ATOMIC_RELAXED, __HIP_MEMORY_SCOPE_AGENT);
                    unsigned sp = 0; while (__hip_atomic_load(&((unsigned*)(S.wsb + S.foff))[(pair * 2 + (1 - kh)) * 16], __ATOMIC_RELAXED, __HIP_MEMORY_SCOPE_AGENT) == 0u) { __builtin_amdgcn_s_sleep(1); if (++sp > (1u << 22)) break; } }
                PG8_BAR;
#pragma unroll
                for (int j = 0; j < 16; ++j) acc[0][j >> 3][(j >> 1) & 3][j & 1] += __builtin_bit_cast(f32x4, __builtin_amdgcn_raw_buffer_load_b128(rr, vo, j * 8192, 16));
                accS[0] += __builtin_bit_cast(f32x4, __builtin_amdgcn_raw_buffer_load_b128(rr, vo, 16 * 8192, 16)); accS[1] += __builtin_bit_cast(f32x4, __builtin_amdgcn_raw_buffer_load_b128(rr, vo, 17 * 8192, 16));
                aim = 1; flip = kh;
            }
            E(acc, cur, wr, wc, fr, fq, (const PG8_LAS float*)(pf + par * 6144 + wid * 768), aim, flip); if (cur.kh <= 0) E.strip(accS, cur, wr, wc, fr, fq);
        } else {
        E(acc, cur, wr, wc, fr, fq, (const PG8_LAS float*)(pf + par * 6144 + wid * 768)); E.strip(accS, cur, wr, wc, fr, fq); }
        if (!has_next) break;
#pragma unroll
        for (int a = 0; a < 2; ++a)
#pragma unroll
            for (int b = 0; b < 2; ++b)
#pragma unroll
                for (int m = 0; m < 4; ++m)
#pragma unroll
                    for (int n = 0; n < 2; ++n) acc[a][b][m][n] = (f32x4){0.f, 0.f, 0.f, 0.f};
        accS[0] = (f32x4){0.f, 0.f, 0.f, 0.f}; accS[1] = (f32x4){0.f, 0.f, 0.f, 0.f};
        cur = nxt; cA = nA; cB = nB; cS = nS; if constexpr (Sched::SPLIT) hsA = cur.kh > 0 ? -(long)hstepA : (long)hstepA; ++ui; par ^= 1;
        E.prefetch(cur, (PG8_LAS float*)(pf + par * 6144 + wid * 768), lane, wr, wc);
        if (wr == 1) PG8_BAR;
    }
    PG8_WAIT_V(0);
    PG8_BAR;
#undef PG8_SA
#undef PG8_SB
#undef PG8_STAGE
#undef PG8_STAGE_S
#undef PG8_LDA
#undef PG8_LDB
#undef PG8_LDS_S
#undef PG8_MMA
#undef PG8_MMA_S
#undef PG8_WAIT_V
#undef PG8_WAIT_L
#undef PG8_BAR
#undef PG8_SCHED
#undef PG8_ABASE
#undef PG8_BBASE
#undef PG8_SBASE
#undef PG8_KOFF
#undef PG8_HS
}
}

namespace att {
using s16x4  = __attribute__((ext_vector_type(4))) short;
using f32x16 = __attribute__((ext_vector_type(16))) float;
constexpr int D = 128, NW = 8, QBLK = 32, KVBLK = 64;
constexpr float SCALE = 0.088388347648318440f;
constexpr float THR = 8.f;
constexpr int SHM_V = KVBLK * D * 2, SHM_K = KVBLK * D * 2, SHM_WS = 2 * SHM_V + 2 * SHM_K, SHM_BIAS = SHM_WS + NW * 64 * 4, SHM_ATTN = SHM_BIAS + 2560, OST_HI = 71680  ;
constexpr int NBIAS = 15 * 31, BIAS_PAD = 48;
#define KSWZ(row, colB) ((row) * 256 + ((colB) ^ (((row) & 7) << 4)))
#define SBAR() __builtin_amdgcn_sched_barrier(0)
__device__ __forceinline__ int crow(int r, int hi) { return (r & 3) + 8 * (r >> 2) + 4 * hi; }
__device__ __forceinline__ unsigned cvtpk(float lo, float hi) { unsigned r; asm volatile("v_cvt_pk_bf16_f32 %0, %1, %2" : "=v"(r) : "v"(lo), "v"(hi)); return r; }

constexpr float QSCALE = SCALE * 1.4426950408889634f;
template <bool FIRST>
__device__ __forceinline__ void partialSM(f32x16& p0, f32x16& p1, float& m_reg, float& alpha) {
  constexpr float THRL = THR * 1.4426950408889634f;
  float pmax = p0[0];
#pragma unroll
  for (int r = 1; r < 16; ++r) pmax = fmaxf(pmax, p0[r]);
#pragma unroll
  for (int r = 0; r < 16; ++r) pmax = fmaxf(pmax, p1[r]);
  { auto rr = __builtin_amdgcn_permlane32_swap(__float_as_uint(pmax), __float_as_uint(pmax), false, false);
    pmax = fmaxf(__uint_as_float(rr[0]), __uint_as_float(rr[1])); }
  if (!FIRST && __builtin_expect(__all(pmax <= THRL), 1)) { alpha = 1.f; }
  else { const float delta = FIRST ? pmax : fmaxf(pmax, 0.f); alpha = FIRST ? 1.f : __builtin_amdgcn_exp2f(-delta); m_reg += delta;
#pragma unroll
    for (int r = 0; r < 16; ++r) { p0[r] -= delta; p1[r] -= delta; } }
#pragma unroll
  for (int r = 0; r < 16; ++r) p0[r] = __builtin_amdgcn_exp2f(p0[r]);
}
__device__ __forceinline__ void finishSM(f32x16& p0, f32x16& p1, float alpha, float& l_reg, bf16x8& pa0, bf16x8& pa1, bf16x8& pa2, bf16x8& pa3) {
#pragma unroll
  for (int r = 0; r < 16; ++r) p1[r] = __builtin_amdgcn_exp2f(p1[r]);
  float ps = 0;
#pragma unroll
  for (int r = 0; r < 16; ++r) ps += p0[r];
#pragma unroll
  for (int r = 0; r < 16; ++r) ps += p1[r];
  { auto rr = __builtin_amdgcn_permlane32_swap(__float_as_uint(ps), __float_as_uint(ps), false, false);
    ps = __uint_as_float(rr[0]) + __uint_as_float(rr[1]); }
  l_reg = l_reg * alpha + ps;
#define PK4(P, BASE, OUT) do { unsigned a0 = cvtpk(P[BASE + 0], P[BASE + 1]), a1 = cvtpk(P[BASE + 2], P[BASE + 3]);   \
    unsigned b0 = cvtpk(P[BASE + 4], P[BASE + 5]), b1 = cvtpk(P[BASE + 6], P[BASE + 7]);                              \
    auto r0 = __builtin_amdgcn_permlane32_swap(a0, b0, false, false); auto r1 = __builtin_amdgcn_permlane32_swap(a1, b1, false, false); \
    u32x4 w = {r0[0], r1[0], r0[1], r1[1]}; OUT = *reinterpret_cast<bf16x8*>(&w); } while (0)
  PK4(p0, 0, pa0); PK4(p0, 8, pa1); PK4(p1, 0, pa2); PK4(p1, 8, pa3);
#undef PK4
}
__device__ __forceinline__ void qkt(f32x16& p0, f32x16& p1, const char* Ks, const bf16x8* qr, int r32, int hi, float negm) {
#pragma unroll
  for (int r = 0; r < 16; ++r) { p0[r] = negm; p1[r] = negm; }
#pragma unroll
  for (int d0 = 0; d0 < 8; ++d0) { int cb = (d0 * 16 + hi * 8) * 2;
    bf16x8 b0 = *reinterpret_cast<const bf16x8*>(Ks + KSWZ(r32, cb));
    bf16x8 b1 = *reinterpret_cast<const bf16x8*>(Ks + KSWZ(32 + r32, cb));
    p0 = __builtin_amdgcn_mfma_f32_32x32x16_bf16(b0, qr[d0], p0, 0, 0, 0);
    p1 = __builtin_amdgcn_mfma_f32_32x32x16_bf16(b1, qr[d0], p1, 0, 0, 0); }
}
__device__ __forceinline__ int v_st(int k, int c) { const int kk = (k & ~0xC) | ((k & 4) << 1) | ((k & 8) >> 1); return ((kk >> 3) * 4 + (c >> 5)) * 512 + ((kk & 7) * 32 + (c & 31)) * 2; }
__device__ __forceinline__ int v_rd_base(int lane) { return ((lane & 3) << 3) | (((lane >> 2) & 3) << 6) | (((lane >> 4) & 1) << 5) | (((lane >> 5) & 1) << 8); }
constexpr int v_rd_off(int d0, int ks, int half) { return d0 * 512 + ks * 4096 + half * 2048; }
template <int OFF> __device__ __forceinline__ s16x4 tr_read(int vb) {
  s16x4 r; asm volatile("ds_read_b64_tr_b16 %0, %1 offset:%2" : "=&v"(r) : "v"(vb), "i"(OFF) : "memory"); return r;
}
template <int D0> __device__ __forceinline__ void pv_one(f32x16& od, int vb, bf16x8 pa0, bf16x8 pa1, bf16x8 pa2, bf16x8 pa3) {
  const s16x4 l0 = tr_read<v_rd_off(D0, 0, 0)>(vb), h0 = tr_read<v_rd_off(D0, 0, 1)>(vb), l1 = tr_read<v_rd_off(D0, 1, 0)>(vb), h1 = tr_read<v_rd_off(D0, 1, 1)>(vb);
  const s16x4 l2 = tr_read<v_rd_off(D0, 2, 0)>(vb), h2 = tr_read<v_rd_off(D0, 2, 1)>(vb), l3 = tr_read<v_rd_off(D0, 3, 0)>(vb), h3 = tr_read<v_rd_off(D0, 3, 1)>(vb);
  asm volatile("s_waitcnt lgkmcnt(0)" ::: "memory"); SBAR();
#define PK(L, H) (bf16x8){L[0], L[1], L[2], L[3], H[0], H[1], H[2], H[3]}
  od = __builtin_amdgcn_mfma_f32_32x32x16_bf16(pa0, PK(l0, h0), od, 0, 0, 0);
  od = __builtin_amdgcn_mfma_f32_32x32x16_bf16(pa1, PK(l1, h1), od, 0, 0, 0);
  od = __builtin_amdgcn_mfma_f32_32x32x16_bf16(pa2, PK(l2, h2), od, 0, 0, 0);
  od = __builtin_amdgcn_mfma_f32_32x32x16_bf16(pa3, PK(l3, h3), od, 0, 0, 0);
#undef PK
}
__device__ __forceinline__ void pv_d0(f32x16* o, int vb, bf16x8 pa0, bf16x8 pa1, bf16x8 pa2, bf16x8 pa3) {
  pv_one<0>(o[0], vb, pa0, pa1, pa2, pa3); pv_one<1>(o[1], vb, pa0, pa1, pa2, pa3); pv_one<2>(o[2], vb, pa0, pa1, pa2, pa3); pv_one<3>(o[3], vb, pa0, pa1, pa2, pa3);
}
__device__ __forceinline__ void nat_mask(f32x16& p0, f32x16& p1, const float* blp, unsigned mlo, unsigned mhi) {
#pragma unroll
  for (int r = 0; r < 16; ++r) {
    const int c = (r & 3) + 8 * (r >> 2);
    const float b0 = blp[c], b1 = blp[c + 32];
    p0[r] = ((mlo >> c) & 1u) ? p0[r] + b0 : -1e30f;
    p1[r] = ((mhi >> c) & 1u) ? p1[r] + b1 : -1e30f;
  }
}
template <bool NATM, int QN>
__device__ __forceinline__ void attn_unit(const gb16* __restrict__ Qb, const gb16* __restrict__ Kh, const gb16* __restrict__ Vh, gb16* __restrict__ Ob,
                                          int ldq, int ldk, int ldo, int n1, int off2, int NT, char* lds, int qrow0, int kr_lo, const gf32* qg, const gf32* rope, int qtok0, int wv) {
  const int tid = tid_here(wv), wid = wv, lane = tid & 63, r32 = lane & 31, hi = lane >> 5;
  char* V_lds = lds; char* K_lds = lds + 2 * SHM_V;
  float* ws = (float*)(lds + SHM_WS) + wid * 64; float* li_l = ws; float* al_l = ws + 32;
  const float* bl = (const float*)(lds + SHM_BIAS);
  float m_reg = 0.f, l_reg = 0; f32x16 o[4] = {}; bf16x8 qr[8];
  unsigned kso[2], vso[2];
#pragma unroll
  for (int i = 0; i < 2; ++i) { const int B = i * 8 + wid;
    const int row = 4 * B + (lane >> 4); kso[i] = (unsigned)(row * ldk + (((lane & 15) ^ (row & 7)) << 3)) * 2u;
    const int S = 2 * B + (lane >> 5), kk = (S >> 2) * 8 + ((lane >> 2) & 7), kt = (kk & ~0xC) | ((kk & 4) << 1) | ((kk & 8) >> 1), c = (S & 3) * 32 + (lane & 3) * 8; vso[i] = (unsigned)(kt * ldk + c) * 2u; }
#define KROW(j) ((j) < n1 ? (j) * KVBLK : off2 + ((j) - n1) * KVBLK)
#define KDMA(b, k0) do { const GAS char* _g = (const GAS char*)Kh + (size_t)(k0) * (size_t)ldk * 2; _Pragma("unroll") for (int _i = 0; _i < 2; ++_i) \
    __builtin_amdgcn_global_load_lds((const GAS unsigned*)(_g + kso[_i]), (LAS unsigned*)(K_lds + (b) * SHM_K + (_i * 8 + wid) * 1024), 16, 0, 0); } while (0)
#define VDMA(b, k0) do { const GAS char* _g = (const GAS char*)Vh + (size_t)(k0) * (size_t)ldk * 2; _Pragma("unroll") for (int _i = 0; _i < 2; ++_i) \
    __builtin_amdgcn_global_load_lds((const GAS unsigned*)(_g + vso[_i]), (LAS unsigned*)(V_lds + (b) * SHM_V + (_i * 8 + wid) * 1024), 16, 0, 0); } while (0)
  KDMA(0, KROW(0)); VDMA(0, KROW(0)); KDMA(1, KROW(1));
  const gb16* Qw = Qb + (long)(wid * QBLK + r32) * ldq + hi * 8;
#pragma unroll
  for (int d0 = 0; d0 < 8; ++d0) qr[d0] = *(const gbf16x8*)(Qw + d0 * 16);
  if constexpr (QN != 0) {
    float ss = 0.f;
#pragma unroll
    for (int d0 = 0; d0 < 8; ++d0) { const u32x4 w = *reinterpret_cast<const u32x4*>(&qr[d0]);
      ss += (bf_lo(w.x) * bf_lo(w.x) + bf_hi(w.x) * bf_hi(w.x)) + (bf_lo(w.y) * bf_lo(w.y) + bf_hi(w.y) * bf_hi(w.y)) + (bf_lo(w.z) * bf_lo(w.z) + bf_hi(w.z) * bf_hi(w.z)) + (bf_lo(w.w) * bf_lo(w.w) + bf_hi(w.w) * bf_hi(w.w)); }
    { auto rr = __builtin_amdgcn_permlane32_swap(__float_as_uint(ss), __float_as_uint(ss), false, false); ss = __uint_as_float(rr[0]) + __uint_as_float(rr[1]); }
    const float rstd = QSCALE * __builtin_amdgcn_rsqf(ss * (1.0f / D) + NORM_EPS);
    const int tok = qtok0 + wid * QBLK + r32, pr = tok >> 6, pc = tok & 63;
#pragma unroll
    for (int d0 = 0; d0 < 8; ++d0) { const u32x4 w = *reinterpret_cast<const u32x4*>(&qr[d0]);
      const f32x4 g0 = *(const gf32x4*)(qg + d0 * 16 + hi * 8), g1 = *(const gf32x4*)(qg + d0 * 16 + hi * 8 + 4);
      float y[8] = {bf_lo(w.x) * rstd * g0.x, bf_hi(w.x) * rstd * g0.y, bf_lo(w.y) * rstd * g0.z, bf_hi(w.y) * rstd * g0.w, bf_lo(w.z) * rstd * g1.x, bf_hi(w.z) * rstd * g1.y, bf_lo(w.w) * rstd * g1.z, bf_hi(w.w) * rstd * g1.w};
      if constexpr (QN == 2) { const int pos = d0 < 4 ? pr : pc, f0 = (d0 & 3) * 8 + hi * 4;
        const f32x4 t0 = *(const gf32x4*)(rope + 2 * (pos * 32 + f0)), t1 = *(const gf32x4*)(rope + 2 * (pos * 32 + f0) + 4);
        const float a0 = y[0] * t0.x - y[1] * t0.y, b0 = y[0] * t0.y + y[1] * t0.x, a1 = y[2] * t0.z - y[3] * t0.w, b1 = y[2] * t0.w + y[3] * t0.z;
        const float a2 = y[4] * t1.x - y[5] * t1.y, b2 = y[4] * t1.y + y[5] * t1.x, a3 = y[6] * t1.z - y[7] * t1.w, b3 = y[6] * t1.w + y[7] * t1.z;
        y[0] = a0; y[1] = b0; y[2] = a1; y[3] = b1; y[4] = a2; y[5] = b2; y[6] = a3; y[7] = b3; }
      u32x4 o4; o4.x = cvtpk(y[0], y[1]); o4.y = cvtpk(y[2], y[3]); o4.z = cvtpk(y[4], y[5]); o4.w = cvtpk(y[6], y[7]); qr[d0] = *reinterpret_cast<bf16x8*>(&o4); }
  }
  const int vb0 = (int)(uintptr_t)V_lds + v_rd_base(lane);
  const int nq_row = qrow0 + (wid >> 1), nq_col = 32 * (wid & 1) + r32, nrs = min(max(nq_row - 4, 0), 56);
  const unsigned long long nwin = (0xFFFFull << min(max(nq_col - 8, 0), 48)) >> (4 * hi);
  const unsigned nmlo = (unsigned)nwin, nmhi = (unsigned)(nwin >> 32);
  const float* nbl = bl + BIAS_PAD + 15 - nq_col + 4 * hi;
#define LANDED() do { asm volatile("s_waitcnt vmcnt(0)" ::: "memory"); __syncthreads(); } while (0)
#define RESC(a) do { if (__any((a) < 1.f)) { if (hi == 0) al_l[r32] = (a); asm volatile("s_waitcnt lgkmcnt(0)" ::: "memory"); \
    _Pragma("unroll") for (int d = 0; d < 4; ++d) _Pragma("unroll") for (int r = 0; r < 16; ++r) o[d][r] *= al_l[crow(r, hi)]; } } while (0)
#define NMASK(P0, P1, j) do { if (NATM) { if ((j) >= n1) { const int _kr = kr_lo + ((j) - n1); const bool _ok = (_kr >= nrs) && (_kr < nrs + 8); const int _dr = min(max(_kr - nq_row + 7, 0), 14); \
    nat_mask(P0, P1, nbl + _dr * 31, _ok ? nmlo : 0u, _ok ? nmhi : 0u); } } } while (0)
  f32x16 pA0, pA1, pB0, pB1; float alA, alB; bf16x8 pa0, pa1, pa2, pa3;
  LANDED();
  qkt(pA0, pA1, K_lds, qr, r32, hi, 0.f); NMASK(pA0, pA1, 0); partialSM<true>(pA0, pA1, m_reg, alA);
  __syncthreads();
#define OKT(j) (!NATM || (j) < n1 || (kr_lo + ((j) - n1) >= nrs && kr_lo + ((j) - n1) < nrs + 8))
  bool okA = true, okB;
  for (int j = 1; j + 1 < NT; j += 2) {
    KDMA(0, KROW(j + 1)); VDMA(1, KROW(j));
    okB = OKT(j);
    SBAR(); if (okB) qkt(pB0, pB1, K_lds + SHM_K, qr, r32, hi, -m_reg);
    if (okA) { finishSM(pA0, pA1, alA, l_reg, pa0, pa1, pa2, pa3); SBAR();
      pv_d0(o, vb0, pa0, pa1, pa2, pa3); }
    if (okB) { NMASK(pB0, pB1, j); partialSM<false>(pB0, pB1, m_reg, alB); RESC(alB); }
    LANDED();
    if (j + 2 < NT) KDMA(1, KROW(j + 2)); VDMA(0, KROW(j + 1));
    okA = OKT(j + 1);
    SBAR(); if (okA) qkt(pA0, pA1, K_lds, qr, r32, hi, -m_reg);
    if (okB) { finishSM(pB0, pB1, alB, l_reg, pa0, pa1, pa2, pa3); SBAR();
      pv_d0(o, vb0 + SHM_V, pa0, pa1, pa2, pa3); }
    if (okA) { NMASK(pA0, pA1, j + 1); partialSM<false>(pA0, pA1, m_reg, alA); RESC(alA); }
    LANDED();
  }
  VDMA(1, KROW(NT - 1));
  okB = OKT(NT - 1);
  SBAR(); if (okB) qkt(pB0, pB1, K_lds + SHM_K, qr, r32, hi, -m_reg);
  if (okA) { finishSM(pA0, pA1, alA, l_reg, pa0, pa1, pa2, pa3); SBAR();
    pv_d0(o, vb0, pa0, pa1, pa2, pa3); }
  if (okB) { NMASK(pB0, pB1, NT - 1); partialSM<false>(pB0, pB1, m_reg, alB); RESC(alB); }
  LANDED();
  if (okB) { finishSM(pB0, pB1, alB, l_reg, pa0, pa1, pa2, pa3); SBAR();
    pv_d0(o, vb0 + SHM_V, pa0, pa1, pa2, pa3); }
  if (hi == 0) li_l[r32] = l_reg; asm volatile("s_waitcnt lgkmcnt(0)" ::: "memory");
  float rli[16];
#pragma unroll
  for (int r = 0; r < 16; ++r) rli[r] = __builtin_amdgcn_rcpf(li_l[crow(r, hi)]);
  gb16* Ow = Ob + (long)(wid * QBLK) * ldo;
  { bf16_t* stg = (bf16_t*)(lds + (wid < 4 ? 2 * SHM_V + wid * 8192 : OST_HI + (wid - 4) * 8192));
#pragma unroll
    for (int r = 0; r < 16; ++r) { const int orow = crow(r, hi);
#pragma unroll
      for (int d0 = 0; d0 < 4; ++d0) { const unsigned pk = cvtpk(o[d0][r] * rli[r], 0.f); stg[orow * 128 + d0 * 32 + r32] = (bf16_t)(pk & 0xffffu); } }
    asm volatile("s_waitcnt lgkmcnt(0)" ::: "memory");
#pragma unroll
    for (int i = 0; i < 8; ++i) { const int row = i * 4 + (lane >> 4), ch = lane & 15; const u32x4 v = *(const u32x4*)(stg + row * 128 + ch * 8); *(gu32x4*)(Ow + (long)row * ldo + ch * 8) = v; } }
#undef OKT
#undef KROW
#undef KDMA
#undef VDMA
#undef LANDED
#undef RESC
#undef NMASK
}
}

constexpr size_t MiB = 1u << 20;
constexpr size_t WS_CTL = 0, CTL_ZERO_BYTES = 2 * MiB;
constexpr size_t WS_STATS = 64 * 1024;
constexpr size_t WS_BUP = 384 * 1024;
constexpr size_t WS_BQKV = 912 * 1024;
constexpr size_t WS_ADA = 2 * MiB;
constexpr size_t WS_ROPE = 3 * MiB;
constexpr size_t WS_XS = 4 * MiB;
constexpr size_t WS_H = 72 * MiB;
constexpr size_t WS_PO = 106 * MiB;
constexpr size_t WS_Q = 140 * MiB, WS_K = 174 * MiB, WS_V = 208 * MiB;
constexpr size_t WS_U = 242 * MiB;
constexpr size_t WS_W13 = 336 * MiB;
constexpr size_t WS_W2 = 512 * MiB;
constexpr size_t WS_PW = 600 * MiB;
constexpr size_t WS_GQKV = 604 * MiB, WS_GWO = 616 * MiB, WS_NQKV = 624 * MiB, WS_NWO = 648 * MiB, WS_END = 656 * MiB;
static_assert(WS_STATS + (size_t)9 * MROWS * 4 <= WS_BUP && WS_BUP + (size_t)4 * 3 * 2 * FF * 4 <= WS_BQKV && WS_BQKV + (size_t)2 * 3 * 6144 * 4 <= CTL_ZERO_BYTES, "ctl map");
static_assert(WS_XS + (size_t)MROWS * DM * 4 <= WS_H && WS_U + (size_t)MROWS * FF * 2 <= WS_W13 && WS_W13 + (size_t)4 * 2 * FF * DM * 2 <= WS_W2 && WS_W2 + (size_t)4 * DM * FF * 2 <= WS_PW, "ws map");
constexpr size_t CTL_FINAL_CNT = 49152;
constexpr size_t CTL_SPLIT_FLAGS2 = 0;
constexpr size_t CTL_SPLIT_FLAGS = 32768;
constexpr int CW_BAR = 4096;

constexpr int RING_BYTES = 131072, LDSCTL_OFF = RING_BYTES, MISC_OFF = LDSCTL_OFF + 320, STRIP_OFF = LDSCTL_OFF + 4096  , PF_OFF = 143360  , XK_OFF = 155648  , LDS_BYTES = 163840;

#define XB_TMO      128
#define XB_XCNT(j)  (256  + 64 * (j))
#define XB_XSUB(j)  (1280 + 64 * (j))
#define XB_XGEN(j)  (2304 + 64 * (j))
#define XB_TOP      3328
#define XB_TOPGEN   3392
#define XCD_BAR_WORDS 3456
#define XB_SPIN_CAP (1u << 18)
__device__ __forceinline__ unsigned xb_ld(unsigned* p)              { return __hip_atomic_load(p, __ATOMIC_RELAXED, __HIP_MEMORY_SCOPE_AGENT); }
__device__ __forceinline__ unsigned xb_add(unsigned* p, unsigned v) { return __hip_atomic_fetch_add(p, v, __ATOMIC_RELAXED, __HIP_MEMORY_SCOPE_AGENT); }
__device__ __forceinline__ unsigned xb_xcc_id() { return (unsigned)__builtin_amdgcn_s_getreg((3 << 11) | 20) & 0xFu; }
#define XB_SPIN(cond, bar) do { unsigned _sp = 0; while (cond) { __builtin_amdgcn_s_sleep(1); \
    if ((++_sp & 255u) == 0u) { if (xb_ld(&(bar)[XB_TMO])) break; if (_sp > XB_SPIN_CAP) { atomicAdd(&(bar)[XB_TMO], 1u); break; } } } } while (0)
struct XcdBarrier { unsigned* bar; unsigned x; volatile LAS unsigned* st; };
__device__ __forceinline__ XcdBarrier xcd_barrier_post(unsigned* bar, volatile LAS unsigned* st) {
    XcdBarrier b; b.bar = bar; b.x = xb_xcc_id(); b.st = st;
    if (threadIdx.x == 0) (void)xb_add(&bar[XB_XCNT(b.x)], 1u);
    return b;
}
__device__ __forceinline__ void xcd_barrier_complete(unsigned* bar, unsigned x, unsigned& nloc, unsigned& nx) {
    const unsigned G = gridDim.x * gridDim.y * gridDim.z;
    unsigned sum, cnt, mine, sp = 0u;
    for (;;) {
        sum = 0u; cnt = 0u; mine = 0u;
#pragma unroll
        for (unsigned j = 0; j < 16; ++j) { const unsigned c = xb_ld(&bar[XB_XCNT(j)]); sum += c; cnt += (c > 0u) ? 1u : 0u; mine = (j == x) ? c : mine; }
        if (sum == G) break;
        __builtin_amdgcn_s_sleep(1);
        if ((++sp & 255u) == 0u) { if (xb_ld(&bar[XB_TMO])) break; if (sp > XB_SPIN_CAP) { atomicAdd(&bar[XB_TMO], 1u); break; } }
    }
    nloc = mine > 0u ? mine : 1u; nx = cnt > 0u ? cnt : 1u;
}
__device__ __forceinline__ void xcd_barrier(const XcdBarrier& b, int tid) {
    asm volatile("s_waitcnt vmcnt(0)" ::: "memory");
    __syncthreads();
    if (tid == 0) {
        unsigned* bar = b.bar;
        __builtin_amdgcn_s_waitcnt(0);
        unsigned nloc = b.st[0], nx = b.st[1];
        if (nloc == 0u) { xcd_barrier_complete(bar, b.x, nloc, nx); b.st[0] = nloc; b.st[1] = nx; }
        const unsigned old = xb_add(&bar[XB_XSUB(b.x)], 1u);
        const unsigned gen = old / nloc;
        if (old + 1u == (gen + 1u) * nloc) {
            __builtin_amdgcn_fence(__ATOMIC_RELEASE, "agent");
            asm volatile("s_waitcnt vmcnt(0)" ::: "memory");
            const unsigned og = xb_add(&bar[XB_TOP], 1u);
            const unsigned tg = og / nx;
            if (og + 1u == (tg + 1u) * nx) xb_add(&bar[XB_TOPGEN], 1u);
            else XB_SPIN(xb_ld(&bar[XB_TOPGEN]) == tg, bar);
            __builtin_amdgcn_fence(__ATOMIC_ACQUIRE, "agent");
            xb_add(&bar[XB_XGEN(b.x)], 1u);
            asm volatile("s_waitcnt vmcnt(0)" ::: "memory");
        } else {
            XB_SPIN(xb_ld(&bar[XB_XGEN(b.x)]) == gen, bar);
            __builtin_amdgcn_fence(__ATOMIC_ACQUIRE, "agent");
            asm volatile("s_waitcnt vmcnt(0)" ::: "memory");
        }
    }
    __syncthreads();
}

struct Frame { LAS unsigned char* lds; GAS unsigned char* ws; gf32* out; int tid, lane, wave, vcu, G, bid; };
enum { I_X = 0, I_C, I_CTX, I_CCTX, I_ADAW, I_ADAB, I_NORMG, I_W1, I_W3, I_W2, I_POOLW, I_POOLLS, I_GWQ, I_GWK, I_GWV, I_GWO, I_GQN, I_GKN, I_NWQ, I_NWK, I_NWV, I_NWO, I_RPB, I_FINALG, I_COUNT };
constexpr int PTR_OFF = LDSCTL_OFF + 1024;
__device__ __forceinline__ const gf32* inp(const Frame& F, int k) {
    const unsigned long long v = ((volatile LAS unsigned long long*)(F.lds + PTR_OFF))[k];
    const unsigned lo = __builtin_amdgcn_readfirstlane((unsigned)v), hi = __builtin_amdgcn_readfirstlane((unsigned)(v >> 32));
    return (const gf32*)(((unsigned long long)hi << 32) | lo);
}
#define WSF(off) ((gf32*)(F.ws + (off)))
#define WSB(off) ((gb16*)(F.ws + (off)))
#define WSH(off) ((gh16*)(F.ws + (off)))

struct TrItem { const gf32* src; gb16* dst; int N, K, k0, n0, drow0; const gf32* sh; gf32* bias; int nb; };
__device__ __forceinline__ void tr_load(const TrItem& d, int ks, f32x4 (&a)[8], f32x4 (&b)[8], int lane) {
    const int q = lane >> 4, c = lane & 15;
#pragma unroll
    for (int it = 0; it < 8; ++it) { const int k = ks * 64 + 8 * it + 2 * q;
        a[it] = __builtin_nontemporal_load((const gf32x4*)(d.src + (size_t)(d.k0 + k) * d.N + d.n0 + 4 * c)); b[it] = __builtin_nontemporal_load((const gf32x4*)(d.src + (size_t)(d.k0 + k + 1) * d.N + d.n0 + 4 * c)); }
}
__device__ __forceinline__ void tr_half(const TrItem& d, int ks, const f32x4 (&a)[8], const f32x4 (&b)[8], LAS unsigned char* T, LAS float* SH, int lane) {
    const int q = lane >> 4, c = lane & 15;
    if (d.sh) {
        const gf32* shp = d.sh + ks * 64;
        SH[lane] = shp[lane]; SH[64 + lane] = shp[6 * DM + lane]; SH[128 + lane] = shp[12 * DM + lane];
        LDS_WAIT(); asm volatile("" ::: "memory");
        f32x4 p0 = {0.f, 0.f, 0.f, 0.f}, p1 = p0, p2 = p0;
#pragma unroll
        for (int it = 0; it < 8; ++it) { const f32x2 s0 = *(const LAS f32x2*)(SH + 8 * it + 2 * q), s1 = *(const LAS f32x2*)(SH + 64 + 8 * it + 2 * q), s2 = *(const LAS f32x2*)(SH + 128 + 8 * it + 2 * q);
            p0 += a[it] * s0.x + b[it] * s0.y; p1 += a[it] * s1.x + b[it] * s1.y; p2 += a[it] * s2.x + b[it] * s2.y; }
#pragma unroll
        for (int i = 0; i < 4; ++i) { p0[i] += __shfl_xor(p0[i], 16); p0[i] += __shfl_xor(p0[i], 32); p1[i] += __shfl_xor(p1[i], 16); p1[i] += __shfl_xor(p1[i], 32); p2[i] += __shfl_xor(p2[i], 16); p2[i] += __shfl_xor(p2[i], 32); }
        const float v0 = q == 0 ? p0[0] : q == 1 ? p0[1] : q == 2 ? p0[2] : p0[3], v1 = q == 0 ? p1[0] : q == 1 ? p1[1] : q == 2 ? p1[2] : p1[3], v2 = q == 0 ? p2[0] : q == 1 ? p2[1] : q == 2 ? p2[2] : p2[3];
        gf32* bp = d.bias + d.drow0 + 4 * c + q;
        pg8::atomic_add_f32(bp, v0); pg8::atomic_add_f32(bp + d.nb, v1); pg8::atomic_add_f32(bp + 2 * d.nb, v2);
        asm volatile("" ::: "memory");
    }
#pragma unroll
    for (int it = 0; it < 8; ++it) {
#pragma unroll
        for (int i = 0; i < 4; ++i) { const int n = 4 * c + i; const int byte = n * 256 + (((ks * 8 + it) ^ c) << 4) + q * 4;
            *(LAS unsigned*)(T + byte) = cvt_pk_bf16(a[it][i], b[it][i]); } }
}
__device__ __forceinline__ void tr_flush(const TrItem& d, LAS unsigned char* T, int lane) {
    LDS_WAIT(); asm volatile("" ::: "memory");
#pragma unroll
    for (int it2 = 0; it2 < 16; ++it2) { const int n = 4 * it2 + (lane >> 4), j = lane & 15;
        const u32x4 v = *(const LAS u32x4*)(T + n * 256 + ((j ^ ((n >> 2) & 15)) << 4));
        *(gu32x4*)(d.dst + (size_t)(d.drow0 + n) * d.K + d.k0 + 8 * j) = v; }
    LDS_WAIT(); asm volatile("" ::: "memory");
}
constexpr int TR_I_FF = (DM / 128) * (FF / 64);
constexpr int TR_N_FFN = 12 * TR_I_FF, TR_N_POOL = 8 * 32, TR_N_G = 512 + 128 + 128 + 512, TR_N_N = 4 * 512, TR_NITEMS = TR_N_FFN + TR_N_POOL + TR_N_G + TR_N_N;
__device__ __forceinline__ TrItem tr_decode(Frame& F, int it) {
    TrItem d; int r = it; d.sh = nullptr; d.bias = nullptr; d.nb = 0;
    if (r < TR_N_FFN) { const int m = r / TR_I_FF, rr = r % TR_I_FF, l = m / 3, wch = m % 3;
        if (wch < 2) { const int kb = rr / 88, nb = rr % 88, n0 = nb * 64;
            d.src = inp(F, wch == 0 ? I_W1 : I_W3) + (size_t)l * DM * FF; d.N = FF; d.dst = WSB(WS_W13) + (size_t)l * 2 * FF * DM; d.K = DM; d.k0 = kb * 128; d.n0 = n0; d.drow0 = (n0 / 128) * 256 + (n0 % 128) + wch * 128;
            d.sh = WSF(WS_ADA) + (size_t)(l * 3 * 6 + 3) * DM + d.k0; d.bias = WSF(WS_BUP) + (size_t)l * 3 * 2 * FF; d.nb = 2 * FF; }
        else { const int kb = rr / 32, nb = rr % 32;
            d.src = inp(F, I_W2) + (size_t)l * FF * DM; d.N = DM; d.dst = WSB(WS_W2) + (size_t)l * DM * FF; d.K = FF; d.k0 = kb * 128; d.n0 = nb * 64; d.drow0 = nb * 64; }
        return d; }
    r -= TR_N_FFN;
    if (r < TR_N_POOL) { const int jg = r / 32, rr = r % 32, j = jg / 4, gg = jg % 4, kb = rr / 8, nb = rr % 8;
        d.src = inp(F, I_POOLW) + (size_t)jg * 512 * 512; d.N = 512; d.dst = WSB(WS_PW) + (size_t)j * DM * 512; d.K = 512; d.k0 = kb * 128; d.n0 = nb * 64; d.drow0 = gg * 512 + nb * 64; return d; }
    r -= TR_N_POOL;
    if (r < TR_N_G) {
        if (r < 512) { d.src = inp(F, I_GWQ); d.N = DM; d.dst = WSB(WS_GQKV); d.K = DM; d.k0 = (r / 32) * 128; d.n0 = (r % 32) * 64; d.drow0 = d.n0; d.sh = WSF(WS_ADA) + (size_t)(1 * 3 * 6) * DM + d.k0; d.bias = WSF(WS_BQKV); d.nb = 6144; return d; } r -= 512;
        if (r < 128) { d.src = inp(F, I_GWK); d.N = 512; d.dst = WSB(WS_GQKV); d.K = DM; d.k0 = (r / 8) * 128; d.n0 = (r % 8) * 64; d.drow0 = 2048 + d.n0; d.sh = WSF(WS_ADA) + (size_t)(1 * 3 * 6) * DM + d.k0; d.bias = WSF(WS_BQKV); d.nb = 6144; return d; } r -= 128;
        if (r < 128) { d.src = inp(F, I_GWV); d.N = 512; d.dst = WSB(WS_GQKV); d.K = DM; d.k0 = (r / 8) * 128; d.n0 = (r % 8) * 64; d.drow0 = 2560 + d.n0; d.sh = WSF(WS_ADA) + (size_t)(1 * 3 * 6) * DM + d.k0; d.bias = WSF(WS_BQKV); d.nb = 6144; return d; } r -= 128;
        d.src = inp(F, I_GWO); d.N = DM; d.dst = WSB(WS_GWO); d.K = DM; d.k0 = (r / 32) * 128; d.n0 = (r % 32) * 64; d.drow0 = d.n0; return d; }
    r -= TR_N_G;
    { const int which = r / 512, rr = r % 512; d.N = DM; d.K = DM; d.k0 = (rr / 32) * 128; d.n0 = (rr % 32) * 64;
      if (which == 0) { d.src = inp(F, I_NWQ); d.dst = WSB(WS_NQKV); d.drow0 = d.n0; }
      else if (which == 1) { d.src = inp(F, I_NWK); d.dst = WSB(WS_NQKV); d.drow0 = 2048 + d.n0; }
      else if (which == 2) { d.src = inp(F, I_NWV); d.dst = WSB(WS_NQKV); d.drow0 = 4096 + d.n0; }
      else { d.src = inp(F, I_NWO); d.dst = WSB(WS_NWO); d.drow0 = d.n0; }
      if (which < 3) { d.sh = WSF(WS_ADA) + (size_t)(2 * 3 * 6) * DM + d.k0; d.bias = WSF(WS_BQKV) + (size_t)3 * 6144; d.nb = 6144; } }
    return d;
}

__device__ __forceinline__ void p0a_prologue(Frame& F) {
    {
        const gf32* cvec = inp(F, I_C); const gf32* cctx = inp(F, I_CCTX); const gf32* ada_w = inp(F, I_ADAW); const gf32* ada_b = inp(F, I_ADAB); gf32* ada = WSF(WS_ADA);
        LAS float* S = (LAS float*)(F.lds);
        LAS float* red0 = (LAS float*)(F.lds + 24576);
        int rpar = 0;
        for (int i = F.tid; i < 3 * DM; i += 512) { const int v = i / DM, k = i % DM; const float cv = v < 2 ? cvec[v * DM + k] : cctx[k]; S[i] = cv / (1.0f + __expf(-cv)); }
        __syncthreads();
        const int kq = F.lane >> 4, cq = F.lane & 15;
        for (int u = F.bid; u < DEPTH * 192; u += F.G) {
            const int l = u / 192, n0 = (u % 192) * 64;
            const gf32* Wp = ada_w + (size_t)l * DM * 6 * DM + n0 + 4 * cq;
            f32x4 a0 = {0.f, 0.f, 0.f, 0.f}, a1 = a0, a2 = a0;
            f32x4 wA[8], wB[8];
            const int kb0 = F.wave * 256 + kq;
#define ADA_LD(dst, g) do { _Pragma("unroll") for (int i = 0; i < 8; ++i) dst[i] = __builtin_nontemporal_load((const gf32x4*)(Wp + (size_t)(kb0 + 4 * (8 * (g) + i)) * (6 * DM))); } while (0)
#define ADA_FMA(src, g) do { _Pragma("unroll") for (int i = 0; i < 8; ++i) { const int k = kb0 + 4 * (8 * (g) + i); a0 += src[i] * S[k]; a1 += src[i] * S[DM + k]; a2 += src[i] * S[2 * DM + k]; } } while (0)
            ADA_LD(wA, 0);
#pragma unroll 1
            for (int g = 0; g < 8; g += 2) { ADA_LD(wB, g + 1); ADA_FMA(wA, g); if (g + 2 < 8) ADA_LD(wA, g + 2); ADA_FMA(wB, g + 1); }
#undef ADA_LD
#undef ADA_FMA
#pragma unroll
            for (int i = 0; i < 4; ++i) { a0[i] += __shfl_xor(a0[i], 16); a0[i] += __shfl_xor(a0[i], 32); a1[i] += __shfl_xor(a1[i], 16); a1[i] += __shfl_xor(a1[i], 32); a2[i] += __shfl_xor(a2[i], 16); a2[i] += __shfl_xor(a2[i], 32); }
            LAS float* red = red0 + rpar * 1536; rpar ^= 1;
            if (kq == 0) {
#pragma unroll
                for (int i = 0; i < 4; ++i) { red[(F.wave * 3 + 0) * 64 + 4 * cq + i] = a0[i]; red[(F.wave * 3 + 1) * 64 + 4 * cq + i] = a1[i]; red[(F.wave * 3 + 2) * 64 + 4 * cq + i] = a2[i]; } }
            __syncthreads();
            if (F.tid < 192) { const int v = F.tid / 64, cc = F.tid % 64; float s = ada_b[l * 6 * DM + n0 + cc];
#pragma unroll
                for (int w = 0; w < 8; ++w) s += red[(w * 3 + v) * 64 + cc];
                ada[(size_t)(l * 3 + v) * 6 * DM + n0 + cc] = s; }
        }
    }
    {
        const size_t gt = (size_t)F.bid * 512 + F.tid, NT = (size_t)F.G * 512;
        gf32* rope = WSF(WS_ROPE);
        for (size_t i = gt; i < 64 * 32; i += NT) { const int p = (int)i / 32, j = (int)i % 32; const float inv = powf(10000.0f, -(float)(2 * j) / 64.0f); const float ang = (float)p * inv;
            rope[2 * i] = cosf(ang); rope[2 * i + 1] = sinf(ang); }
    }
}
__device__ __forceinline__ void p0b_prologue(Frame& F) {
    const int gw = F.vcu * 8 + F.wave, NGW = F.G * 8;
    {
        LAS unsigned char* T = F.lds + F.wave * 16384; LAS float* SH = (LAS float*)(F.lds + PF_OFF + F.wave * 768);
        for (int it = gw; it < TR_NITEMS; it += NGW) {
            const TrItem d = tr_decode(F, it);
            f32x4 a0[8], b0[8], a1[8], b1[8];
            tr_load(d, 0, a0, b0, F.lane); tr_load(d, 1, a1, b1, F.lane);
            tr_half(d, 0, a0, b0, T, SH, F.lane); tr_half(d, 1, a1, b1, T, SH, F.lane);
            tr_flush(d, T, F.lane);
        }
    }
    {
        const gf32* g = inp(F, I_NORMG); const gf32* xin = inp(F, I_X); const gf32* cin = inp(F, I_CTX); const gf32* adab = WSF(WS_ADA); gb16* H = WSB(WS_H); gf32* stats = WSF(WS_STATS);
        const int gwb = F.bid * 8 + F.wave;
        for (int row = gwb; row < MROWS; row += NGW) {
            const int b = row / RB, rr = row % RB, vec = rr < CTXL ? 2 : b;
            const gf32* sc = adab + (size_t)(vec * 6 + 1) * DM;
            const gf32* xrow = rr < CTXL ? cin + ((size_t)b * CTXL + rr) * DM : xin + ((size_t)b * SEQ + (rr - CTXL)) * DM;
            const gf32x4* xr = (const gf32x4*)xrow + F.lane;
            f32x4 v[8]; float ss = 0.f;
#pragma unroll
            for (int j = 0; j < 8; ++j) { v[j] = xr[64 * j]; ss += (v[j].x * v[j].x + v[j].y * v[j].y) + (v[j].z * v[j].z + v[j].w * v[j].w); }
            ss = wave_sum(ss); if (F.lane == 0) stats[row] = ss;
            gu32x2* x8 = (gu32x2*)(WSH(WS_XS) + (size_t)row * DM) + F.lane;
#pragma unroll
            for (int j = 0; j < 8; ++j) {
                u32x2 xw; xw.x = pk_h16(v[j].x, v[j].y); xw.y = pk_h16(v[j].z, v[j].w); x8[64 * j] = xw; }
        }
    }
}

constexpr int POOL_R = 18, POOL_RL = (SEQ + POOL_R - 1) / POOL_R, POOL_RC = (CTXL + POOL_R - 1) / POOL_R;
template <int HW>
__device__ __forceinline__ void pool_task(const gh16* __restrict__ H, gb16* __restrict__ PO, const gf32* __restrict__ stats, const gf32* __restrict__ gng, const gf32* __restrict__ gsc, int seq0, int n, int t0, int len, int c, int lane) {
    constexpr int NR = POOL_R + 2 * HW;
    const unsigned colb = (unsigned)(c * 64 + lane) * 16u;
    u32x4 v[NR];
#pragma unroll
    for (int i = 0; i < NR; ++i) { const int tt = min(max(t0 - HW + i, 0), n - 1);
        const GAS char* rb = (const GAS char*)(H + (size_t)(seq0 + tt) * DM);
        asm volatile("s_nop 4\n\tglobal_load_dwordx4 %0, %1, %2" : "=v"(v[i]) : "v"(colb), "s"(rb) : "memory"); }
    asm volatile("s_waitcnt vmcnt(0)" ::: "memory");
#pragma unroll
    for (int i = 0; i < NR; ++i) asm volatile("" : "+v"(v[i]));
    float rl = 0.f;
    { const int tt = t0 - HW + lane; if (lane < NR && tt >= 0 && tt < n) rl = pg8::rstd_of(stats[seq0 + tt]); }
    float gmv[8];
    { const f32x4 g0 = *(const gf32x4*)(gng + c * 512 + lane * 8), g1 = *(const gf32x4*)(gng + c * 512 + lane * 8 + 4), s0 = *(const gf32x4*)(gsc + c * 512 + lane * 8), s1 = *(const gf32x4*)(gsc + c * 512 + lane * 8 + 4);
      gmv[0] = g0.x * (s0.x + 1.0f); gmv[1] = g0.y * (s0.y + 1.0f); gmv[2] = g0.z * (s0.z + 1.0f); gmv[3] = g0.w * (s0.w + 1.0f); gmv[4] = g1.x * (s1.x + 1.0f); gmv[5] = g1.y * (s1.y + 1.0f); gmv[6] = g1.z * (s1.z + 1.0f); gmv[7] = g1.w * (s1.w + 1.0f); }
    float a[8];
#pragma unroll
    for (int e = 0; e < 8; ++e) a[e] = 0.f;
#define POOL_ACC(i, sgn) do { const float _r = (sgn) * __uint_as_float(__builtin_amdgcn_readlane(__float_as_uint(rl), (i))); u32x4 _t = v[i]; asm volatile("" : "+v"(_t)); a[0] += _r * h16_lo(_t.x); a[1] += _r * h16_hi(_t.x); a[2] += _r * h16_lo(_t.y); a[3] += _r * h16_hi(_t.y); \
        a[4] += _r * h16_lo(_t.z); a[5] += _r * h16_hi(_t.z); a[6] += _r * h16_lo(_t.w); a[7] += _r * h16_hi(_t.w); } while (0)
#pragma unroll
    for (int i = 0; i < 2 * HW; ++i) POOL_ACC(i, 1.0f);
#pragma unroll
    for (int k = 0; k < POOL_R; ++k) {
        if (k < len) { const int t = t0 + k; const int lo = max(t - HW, 0), hi = min(t + HW, n); const float rc = __builtin_amdgcn_rcpf((float)(hi - lo)), ro = __uint_as_float(__builtin_amdgcn_readlane(__float_as_uint(rl), k + HW));
            u32x4 own = v[k + HW]; asm volatile("" : "+v"(own));
            u32x4 w; w.x = cvt_pk_bf16((a[0] * rc - ro * h16_lo(own.x)) * gmv[0], (a[1] * rc - ro * h16_hi(own.x)) * gmv[1]); w.y = cvt_pk_bf16((a[2] * rc - ro * h16_lo(own.y)) * gmv[2], (a[3] * rc - ro * h16_hi(own.y)) * gmv[3]);
            w.z = cvt_pk_bf16((a[4] * rc - ro * h16_lo(own.z)) * gmv[4], (a[5] * rc - ro * h16_hi(own.z)) * gmv[5]); w.w = cvt_pk_bf16((a[6] * rc - ro * h16_lo(own.w)) * gmv[6], (a[7] * rc - ro * h16_hi(own.w)) * gmv[7]);
            GAS char* ob = (GAS char*)(PO + (size_t)(seq0 + t) * DM); asm volatile("s_nop 4\n\tglobal_store_dwordx4 %0, %1, %2\n\ts_nop 1" :: "v"(colb), "v"(w), "s"(ob) : "memory"); }
        if (k + 1 < POOL_R) { POOL_ACC(k + 2 * HW, 1.0f); POOL_ACC(k, -1.0f); }
    }
#undef POOL_ACC
}
__device__ __forceinline__ void phase_pool(Frame& F, const gf32* stats, bool lat_only, int layer) {
    const gh16* H = WSH(WS_XS); gb16* PO = WSB(WS_PO);
    const gf32* gng = inp(F, I_NORMG) + (size_t)(layer * 2) * DM; const gf32* ada1 = WSF(WS_ADA) + (size_t)layer * 3 * 6 * DM + DM;
    const int gw = F.bid * 8 + F.wave, NGW = F.G * 8;
    const int ntask = (2 * POOL_RL + (lat_only ? 0 : 2 * POOL_RC)) * 4;
    for (int task = gw; task < ntask; task += NGW) {
        const int c = task & 3; int ridx = task >> 2; int seq0, n, t0;
        int vec;
        if (ridx < 2 * POOL_RL) { const int b = ridx / POOL_RL; seq0 = b * RB + CTXL; n = SEQ; t0 = (ridx % POOL_RL) * POOL_R; vec = b; }
        else { ridx -= 2 * POOL_RL; const int b = ridx / POOL_RC; seq0 = b * RB; n = CTXL; t0 = (ridx % POOL_RC) * POOL_R; vec = 2; }
        const gf32* gsc = ada1 + (size_t)vec * 6 * DM;
        const int len = min(POOL_R, n - t0);
        int ln = F.lane; asm volatile("" : "+v"(ln));
        if (c == 0) pool_task<1>(H, PO, stats, gng, gsc, seq0, n, t0, len, c, ln);
        else if (c == 1) pool_task<2>(H, PO, stats, gng, gsc, seq0, n, t0, len, c, ln);
        else if (c == 2) pool_task<4>(H, PO, stats, gng, gsc, seq0, n, t0, len, c, ln);
        else pool_task<8>(H, PO, stats, gng, gsc, seq0, n, t0, len, c, ln);
    }
}
__device__ __forceinline__ void phase_krope(Frame& F) {
    const int gw = F.bid * 8 + F.wave, NGW = F.G * 8;
    const f32x2 gk = *(const gf32x2*)(inp(F, I_GKN) + 2 * F.lane);
    gb16* Kp = WSB(WS_K); const gf32* rope = WSF(WS_ROPE);
    for (int row = gw; row < MROWS; row += NGW) {
        const int rr = row % RB; const bool lat = rr >= CTXL; const int t = rr - CTXL;
        float cs = 1.f, sn = 0.f;
        if (lat) { const int pos = F.lane < 32 ? (t >> 6) : (t & 63); const f32x2 r2 = *(const gf32x2*)(rope + 2 * (pos * 32 + (F.lane & 31))); cs = r2.x; sn = r2.y; }
        unsigned u[KVH];
#pragma unroll
        for (int hh = 0; hh < KVH; ++hh) u[hh] = *((const gu32*)(Kp + (size_t)row * 512 + hh * HD) + F.lane);
#pragma unroll
        for (int hh = 0; hh < KVH; ++hh) { const float x1 = bf_lo(u[hh]), x2 = bf_hi(u[hh]);
            const float rstd = __builtin_amdgcn_rsqf(wave_sum(x1 * x1 + x2 * x2) * (1.0f / HD) + NORM_EPS);
            const float y1 = x1 * rstd * gk.x, y2 = x2 * rstd * gk.y;
            *((gu32*)(Kp + (size_t)row * 512 + hh * HD) + F.lane) = cvt_pk_bf16(y1 * cs - y2 * sn, y1 * sn + y2 * cs); }
    }
}
__device__ __forceinline__ void phase_final(Frame& F) {
    const gh16* xs = WSH(WS_XS); const gf32* fg = inp(F, I_FINALG);
    const int gw = F.bid * 8 + F.wave, NGW = F.G * 8;
    for (int r = gw; r < NB * SEQ; r += NGW) {
        const int b = r / SEQ, t = r % SEQ; const int row = b * RB + CTXL + t;
        const gu32x4* xr = (const gu32x4*)(xs + (size_t)row * DM) + F.lane;
        f32x4 v[8]; float s = 0.f;
#pragma unroll
        for (int j = 0; j < 4; ++j) { const u32x4 h = xr[64 * j]; v[2 * j] = (f32x4){h16_lo(h.x), h16_hi(h.x), h16_lo(h.y), h16_hi(h.y)}; v[2 * j + 1] = (f32x4){h16_lo(h.z), h16_hi(h.z), h16_lo(h.w), h16_hi(h.w)};
            s += (v[2 * j].x * v[2 * j].x + v[2 * j].y * v[2 * j].y) + (v[2 * j].z * v[2 * j].z + v[2 * j].w * v[2 * j].w) + (v[2 * j + 1].x * v[2 * j + 1].x + v[2 * j + 1].y * v[2 * j + 1].y) + (v[2 * j + 1].z * v[2 * j + 1].z + v[2 * j + 1].w * v[2 * j + 1].w); }
        const float rstd = __builtin_amdgcn_rsqf(wave_sum(s) * (1.0f / DM) + NORM_EPS);
        gf32x4* o = (gf32x4*)(F.out + (size_t)r * DM) + 2 * F.lane;
#pragma unroll
        for (int j = 0; j < 4; ++j) { const int d = (F.lane + 64 * j) * 8;
            o[128 * j] = (v[2 * j] * rstd) * *(const gf32x4*)(fg + d); o[128 * j + 1] = (v[2 * j + 1] * rstd) * *(const gf32x4*)(fg + d + 4); }
    }
}
__device__ __forceinline__ void phase_attn_gqa(Frame& F, char* lds) {
    const gb16* Q = WSB(WS_Q); const gb16* Kp = WSB(WS_K); const gb16* Vp = WSB(WS_V); gb16* PO = WSB(WS_PO); const gf32* gqn = inp(F, I_GQN); const gf32* rope = WSF(WS_ROPE);
    for (int u = F.vcu; u < 512 + 32; u += F.G) {
        __syncthreads();
        if (u < 512) { const int b = u >> 8, rem = u & 255, kvh = rem >> 6, gq = (rem >> 4) & 3, qb = rem & 15, h = kvh * 4 + gq;
            const size_t qrow = (size_t)b * RB + CTXL + (size_t)qb * 256;
            att::attn_unit<false, 2>(Q + qrow * DM + h * HD, Kp + (size_t)b * RB * 512 + kvh * HD, Vp + (size_t)b * RB * 512 + kvh * HD, PO + qrow * DM + h * HD, DM, 512, DM, RB / 64, 0, RB / 64, lds, 0, 0, gqn, rope, qb * 256, F.wave); }
        else { const int v = u - 512, b = v >> 4, h = v & 15, kvh = h >> 2; const size_t qrow = (size_t)b * RB;
            att::attn_unit<false, 1>(Q + qrow * DM + h * HD, Kp + (size_t)b * RB * 512 + kvh * HD, Vp + (size_t)b * RB * 512 + kvh * HD, PO + qrow * DM + h * HD, DM, 512, DM, CTXL / 64, 0, CTXL / 64, lds, 0, 0, gqn, rope, 0, F.wave); }
    }
}
__device__ __forceinline__ void phase_attn_nat(Frame& F, char* lds) {
    const gb16* Q = WSB(WS_Q); const gb16* Kp = WSB(WS_K); const gb16* Vp = WSB(WS_V); gb16* PO = WSB(WS_PO); const gf32* rpb = inp(F, I_RPB);
    for (int u = F.vcu; u < 512; u += F.G) {
        __syncthreads();
        { const int b = u >> 8, h = (u >> 4) & 15, qb = u & 15, r0 = 4 * qb;
            const int kr_lo = min(max(r0 - 4, 0), 56), kr_hi = min(max(r0 + 3 - 4, 0), 56) + 8; int n2 = kr_hi - kr_lo; n2 += (n2 & 1);
            { int bt = F.tid; asm volatile("" : "+v"(bt));
              if (bt < att::NBIAS) ((float*)(lds + att::SHM_BIAS))[att::BIAS_PAD + bt] = rpb[h * att::NBIAS + bt] * 1.4426950408889634f; }
            const size_t qrow = (size_t)b * RB + CTXL + (size_t)qb * 256;
            att::attn_unit<true, 0>(Q + qrow * DM + h * HD, Kp + (size_t)b * RB * DM + h * HD, Vp + (size_t)b * RB * DM + h * HD, PO + qrow * DM + h * HD, DM, DM, DM, CTXL / 64, CTXL + kr_lo * 64, CTXL / 64 + n2, lds, r0, kr_lo, nullptr, nullptr, 0, F.wave); }
    }
    int v, vstep;
    if (F.G == 256) { const int e = F.vcu & 15; v = (e == 0 || e == 15) ? (F.vcu >> 4) * 2 + (e == 15 ? 1 : 0) : 32; vstep = 32; } else { v = F.vcu; vstep = F.G; }
    for (; v < 32; v += vstep) {
        __syncthreads();
        const int b = v >> 4, h = v & 15; const size_t qrow = (size_t)b * RB;
        att::attn_unit<false, 0>(Q + qrow * DM + h * HD, Kp + (size_t)b * RB * DM + h * HD, Vp + (size_t)b * RB * DM + h * HD, PO + qrow * DM + h * HD, DM, DM, DM, CTXL / 64, 0, CTXL / 64, lds, 0, 0, nullptr, nullptr, 0, F.wave);
    }
}

struct Args { const float* in[24]; float* out; unsigned char* ws; int gp_lo, gp_hi; };
static_assert(sizeof(Args) == 24 * 8 + 8 + 8 + 8, "Args has no padding");
constexpr int GP_END = 35;

__global__ void __launch_bounds__(512, 2) fwd_kernel(Args args) {
    extern __shared__ __attribute__((aligned(16))) unsigned char lds[];
    Frame F;
    F.lds = (LAS unsigned char*)lds;
    F.tid = threadIdx.x; F.lane = F.tid & 63; F.wave = __builtin_amdgcn_readfirstlane(F.tid >> 6);
    F.G = gridDim.x; { const int bx = blockIdx.x; F.vcu = (F.G % 8 == 0) ? (bx % 8) * (F.G / 8) + bx / 8 : bx; }
    F.out = (gf32*)args.out; F.ws = (GAS unsigned char*)args.ws;
    unsigned char* ws = args.ws;
    for (int u = F.tid; u < (LDS_BYTES - LDSCTL_OFF) / 4; u += 512) ((LAS unsigned*)(F.lds + LDSCTL_OFF))[u] = 0u;
    __syncthreads();
    if (F.tid < I_COUNT) ((LAS unsigned long long*)(F.lds + PTR_OFF))[F.tid] = ((const unsigned long long*)__builtin_amdgcn_kernarg_segment_ptr())[F.tid];
    __syncthreads();
    const int lo = args.gp_lo, hi = args.gp_hi;
    unsigned* barw = (unsigned*)(ws + WS_CTL) + CW_BAR;
    XcdBarrier bar; bar.bar = barw; bar.x = 0; bar.st = nullptr;
    if (hi - lo > 1) bar = xcd_barrier_post(barw, (volatile LAS unsigned*)(F.lds + MISC_OFF) + 8);
    bool first = true;
#define PH_BEGIN(gp) if (lo <= (gp) && (gp) < hi) { if (!first) xcd_barrier(bar, tid_here(F.wave)); first = false; F.bid = blockIdx.x; asm volatile("" : "+s"(F.ws), "+s"(F.G), "+s"(F.vcu), "+s"(F.bid), "+s"(F.wave)); F.tid = tid_here(F.wave); F.lane = F.tid & 63;
#define PH_END }
    constexpr bool AL = true, SP = true;

    PH_BEGIN(0) if (EN & 1) p0a_prologue(F); PH_END
    PH_BEGIN(1) if (EN & 1) p0b_prologue(F); PH_END

    for (int layer = 0; layer < DEPTH; ++layer) {
        const int kind = layer % 3, j = layer / 3, gp0 = 2 + 8 * layer;
        const bool need_ctx = layer < DEPTH - 1;
        const gf32* ada_l = WSF(WS_ADA) + (size_t)layer * 3 * 6 * DM;
        gf32* st1 = WSF(WS_STATS) + (size_t)(2 * layer) * MROWS;
        gf32* st2 = st1 + MROWS;
        if (kind == 0) {
            PH_BEGIN(gp0 + 1) if (EN & 4) phase_pool(F, st1, !need_ctx, layer); PH_END
            PH_BEGIN(gp0 + 2) if (EN & 8) {
                pg8::Gemm g{WSB(WS_PO), WSB(WS_PW) + (size_t)j * DM * 512, MROWS, DM, 512, DM, 2};
                pg8::EpiRes E{WSH(WS_XS), WSH(WS_XS), ada_l, 2, inp(F, I_POOLLS) + (size_t)j * DM, WSB(WS_H), inp(F, I_NORMG) + (size_t)(layer * 2 + 1) * DM, ada_l, 4, st2};
                pg8::LatOrder S; S.init(DM, F.G, F.bid);
                if (need_ctx) pg8::gemm_phase_strip<pg8::EpiRes, pg8::LatOrder>(F.lds, F.lds + STRIP_OFF, F.lds + PF_OFF, g, S, E, F.wave);
                else pg8::gemm_phase<pg8::EpiRes, pg8::LatOrder, AL, SP>(F.lds, F.lds + PF_OFF, g, S, E, F.wave); } PH_END
        } else if (kind == 1) {
            PH_BEGIN(gp0 + 1) if (EN & 16) {
                pg8::Gemm g{WSB(WS_H), WSB(WS_GQKV), MROWS, 3072, DM, DM, 1 << 20}; typedef pg8::LatOrderSplit<WS_U, WS_CTL + CTL_SPLIT_FLAGS2> SplitQKV; SplitQKV S; S.init(3072, F.G, F.bid); S.wsb = F.ws;
                pg8::EpiQKV<true> E{WSB(WS_Q), WSB(WS_K), WSB(WS_V), 2048, 512, DM, 512, st1, WSF(WS_BQKV), 6144, 1.0f, inp(F, I_GKN), WSF(WS_ROPE), (LAS float*)(F.lds + XK_OFF)};
                pg8::gemm_phase_strip<pg8::EpiQKV<true>, SplitQKV>(F.lds, F.lds + STRIP_OFF, F.lds + PF_OFF, g, S, E, F.wave); } PH_END
            PH_BEGIN(gp0 + 3) if (EN & 64) phase_attn_gqa(F, (char*)lds); PH_END
        } else {
            PH_BEGIN(gp0 + 1) if (EN & 256) {
                pg8::Gemm g{WSB(WS_H), WSB(WS_NQKV), MROWS, 6144, DM, DM, 1 << 20}; pg8::LatOrder S; S.init(6144, F.G, F.bid);
                pg8::EpiQKV<true> E{WSB(WS_Q), WSB(WS_K), WSB(WS_V), 2048, 2048, DM, DM, st1, WSF(WS_BQKV) + 3 * 6144, 6144, att::QSCALE, nullptr, nullptr, nullptr};
                pg8::gemm_phase_strip<pg8::EpiQKV<true>, pg8::LatOrder>(F.lds, F.lds + STRIP_OFF, F.lds + PF_OFF, g, S, E, F.wave); } PH_END
            PH_BEGIN(gp0 + 3) if (EN & 512) phase_attn_nat(F, (char*)lds); PH_END
        }
        if (kind != 0) {
            PH_BEGIN(gp0 + 4) if (EN & 128) {
                pg8::Gemm g{WSB(WS_PO), kind == 1 ? WSB(WS_GWO) : WSB(WS_NWO), MROWS, DM, DM, DM, 1 << 20}; pg8::LatOrder S; S.init(DM, F.G, F.bid);
                pg8::EpiRes E{WSH(WS_XS), WSH(WS_XS), ada_l, 2, nullptr, WSB(WS_H), inp(F, I_NORMG) + (size_t)(layer * 2 + 1) * DM, ada_l, 4, st2};
                pg8::gemm_phase_strip<pg8::EpiRes, pg8::LatOrder>(F.lds, F.lds + STRIP_OFF, F.lds + PF_OFF, g, S, E, F.wave); } PH_END
        }
        PH_BEGIN(gp0 + 6) if (EN & 2048) {
            pg8::Gemm g{WSB(WS_H), WSB(WS_W13) + (size_t)layer * 2 * FF * DM, MROWS, 2 * FF, DM, DM, 1 << 20};
            pg8::EpiSwiGLU E{WSB(WS_U), st2, WSF(WS_BUP) + (size_t)layer * 3 * 2 * FF};
            if (need_ctx) { pg8::StaticOrder S; S.init(MROWS, 2 * FF, F.G, F.bid); pg8::gemm_phase<pg8::EpiSwiGLU, pg8::StaticOrder, AL, SP>(F.lds, F.lds + PF_OFF, g, S, E, F.wave); }
            else { typedef pg8::LatOrderSplit<WS_PO, WS_CTL + CTL_SPLIT_FLAGS> SplitUp; SplitUp S; S.init(2 * FF, F.G, F.bid); S.wsb = F.ws;
                pg8::gemm_phase<pg8::EpiSwiGLU, SplitUp, AL, SP>(F.lds, F.lds + PF_OFF, g, S, E, F.wave); } } PH_END
        if (need_ctx) {
            PH_BEGIN(gp0 + 7) if (EN & 4096) {
                pg8::Gemm g{WSB(WS_U), WSB(WS_W2) + (size_t)layer * DM * FF, MROWS, DM, FF, FF, 1 << 20}; pg8::LatOrder S; S.init(DM, F.G, F.bid);
                pg8::EpiRes E{WSH(WS_XS), WSH(WS_XS), ada_l, 5, nullptr, (layer + 1) % 3 == 0 ? (gb16*)nullptr : WSB(WS_H)  , inp(F, I_NORMG) + (size_t)((layer + 1) * 2) * DM, ada_l + (size_t)3 * 6 * DM, 1, st2 + MROWS};
                pg8::gemm_phase_strip<pg8::EpiRes, pg8::LatOrder>(F.lds, F.lds + STRIP_OFF, F.lds + PF_OFF, g, S, E, F.wave); } PH_END
        } else {
            PH_BEGIN(gp0 + 7) if (EN & 4096) {
                pg8::Gemm g{WSB(WS_U), WSB(WS_W2) + (size_t)layer * DM * FF, MROWS, DM, FF, FF, 1 << 20}; pg8::LatOrder S; S.init(DM, F.G, F.bid);
                if (F.G == 256) {
                    pg8::EpiFinal E{WSH(WS_XS), ada_l, 5, WSF(WS_STATS) + (size_t)8 * MROWS, inp(F, I_FINALG), F.out, (unsigned*)(ws + WS_CTL + CTL_FINAL_CNT)};
                    pg8::gemm_phase<pg8::EpiFinal, pg8::LatOrder, AL, SP>(F.lds, F.lds + PF_OFF, g, S, E, F.wave);
                } else {
                pg8::EpiRes E{WSH(WS_XS), WSH(WS_XS), ada_l, 5, nullptr, nullptr, nullptr, nullptr, 1, nullptr};
                pg8::gemm_phase<pg8::EpiRes, pg8::LatOrder, AL, SP>(F.lds, F.lds + PF_OFF, g, S, E, F.wave); } } PH_END
        }
    }
    if (F.G != 256) { PH_BEGIN(34) if (EN & 8192) phase_final(F); PH_END }
#undef PH_BEGIN
#undef PH_END
}

static bool phase_active(int gp) {
    if (gp <= 1 || gp == 34) return true;
    const int layer = (gp - 2) / 8, s = (gp - 2) % 8, kind = layer % 3;
    if (s == 0 || s == 5) return false;
    if (kind == 0) return s == 1 || s == 2 || s >= 6;
    return s != 2;
}
extern "C" void kernel_launch(void* const* d_in, const int* in_sizes, int n_in, void* d_out, int out_size, void* d_ws, size_t ws_size, hipStream_t stream) {
    static int grid = 0;
    if (grid == 0) {
        if (n_in != 24 || in_sizes[0] != NB * SEQ * DM || out_size != NB * SEQ * DM || ws_size < WS_END) {
            fprintf(stderr, "kernel_launch: shape mismatch: n_in %d in0 %d out %d ws %zu (need %zu)\n", n_in, n_in > 0 ? in_sizes[0] : -1, out_size, ws_size, (size_t)WS_END); grid = -1; return; }
        int dev = 0, cus = 0, per_cu = 0;
        if (hipGetDevice(&dev) != hipSuccess || hipDeviceGetAttribute(&cus, hipDeviceAttributeMultiprocessorCount, dev) != hipSuccess) { fprintf(stderr, "kernel_launch: device query failed\n"); grid = -1; return; }
        if (hipFuncSetAttribute((const void*)fwd_kernel, hipFuncAttributeMaxDynamicSharedMemorySize, LDS_BYTES) != hipSuccess) { fprintf(stderr, "kernel_launch: hipFuncSetAttribute failed\n"); grid = -1; return; }
        if (hipOccupancyMaxActiveBlocksPerMultiprocessor(&per_cu, (const void*)fwd_kernel, 512, LDS_BYTES) != hipSuccess || per_cu < 1)
            fprintf(stderr, "kernel_launch: note: occupancy query reports %d workgroups per CU\n", per_cu);
        (void)hipGetLastError();
        grid = cus;
    }
    if (grid < 0) return;
    if (hipMemsetAsync((char*)d_ws + WS_CTL, 0, CTL_ZERO_BYTES, stream) != hipSuccess) { fprintf(stderr, "kernel_launch: memset failed\n"); return; }
    Args a{};
    for (int i = 0; i < 24; ++i) a.in[i] = (const float*)d_in[i];
    a.out = (float*)d_out; a.ws = (unsigned char*)d_ws;
#if MK_ONE_LAUNCH
    a.gp_lo = 0; a.gp_hi = GP_END;
    hipLaunchKernelGGL(fwd_kernel, dim3(grid), dim3(512), LDS_BYTES, stream, a);
#else
    for (int gp = 0; gp < GP_END; ++gp) { if (!phase_active(gp)) continue;
        a.gp_lo = gp; a.gp_hi = gp + 1;
        hipLaunchKernelGGL(fwd_kernel, dim3(grid), dim3(512), LDS_BYTES, stream, a); }
#endif
    const hipError_t le = hipPeekAtLastError();
    if (le != hipSuccess) fprintf(stderr, "kernel_launch: launch failed: %s\n", hipGetErrorName(le));
}
```
